# Optimizing an MI355X kernel written in HIP

```python
import math
import jax
import jax.numpy as jnp
from jax import lax
import numpy as np

D_MODEL = 1024
BATCH = 2
SEQ = 8192
DEPTH = 4

GRID_W = 64
CTX_LEN = 256
N_BRANCH = 4
BRANCH_W = 256
ML_HEADS = 4
ML_DH = 64
ML_CHUNK = 128
CONV_W = 3
DA_HEADS = 4
DA_DK = 32
DA_DV = 64
Q_BLOCK = 128
ROPE_BASE = 10000.0
FN_GROUPS = 4
FN_GD = 64
SG_GROUPS = 4
SG_GD = 64
SG_CHUNK = 128
D_FF = 2816
EPS = 1e-6

COL_SIZES = (2 * ML_HEADS * ML_DH, ML_HEADS * ML_DH, ML_HEADS * ML_DH, 4 * ML_HEADS,
             2 * DA_HEADS * DA_DK, 2 * DA_HEADS * DA_DK, DA_HEADS * DA_DV,
             FN_GROUPS * FN_GD, SG_GROUPS * SG_GD, SG_GROUPS * SG_GD, N_BRANCH * D_MODEL)
IN_WIDTH = sum(COL_SIZES)

kernel_name = 'hybrid_mlstm_diffattn_fnet_sgu_dit_trunk'


def rmsnorm(x, g):
    xf = x.astype(jnp.float32)
    y = xf * lax.rsqrt(jnp.mean(xf * xf, axis=-1, keepdims=True) + EPS)
    return (y * g.astype(jnp.float32)).astype(x.dtype)


def layernorm(x, g):
    xf = x.astype(jnp.float32)
    xf = xf - jnp.mean(xf, axis=-1, keepdims=True)
    y = xf * lax.rsqrt(jnp.mean(xf * xf, axis=-1, keepdims=True) + EPS)
    return (y * g.astype(jnp.float32)).astype(x.dtype)


def dwconv(x, w, b):
    r = w.shape[0] // 2
    S = x.shape[1]
    xp = jnp.pad(x, ((0, 0), (r, r), (0, 0)))
    return sum(xp[:, j:j + S] * w[j] for j in range(w.shape[0])) + b


def split_cols(p):
    idx = []
    acc = 0
    for s in COL_SIZES[:-1]:
        acc += s
        idx.append(acc)
    return jnp.split(p, idx, axis=-1)


def rope_2d(x, rows, cols):
    n = DA_DK // 4
    freqs = ROPE_BASE ** (-jnp.arange(n, dtype=jnp.float32) / n)
    ang = jnp.stack([rows[:, None] * freqs, cols[:, None] * freqs], axis=1)
    cos = jnp.cos(ang)[None, :, None, None]
    sin = jnp.sin(ang)[None, :, None, None]
    xr = x.astype(jnp.float32).reshape(x.shape[:-1] + (2, 2, n))
    x1, x2 = xr[..., 0, :], xr[..., 1, :]
    out = jnp.stack([x1 * cos - x2 * sin, x2 * cos + x1 * sin], axis=-2)
    return out.reshape(x.shape).astype(x.dtype)


def mlstm_scan(q, k, v, ig, lf, state):
    B, H, S, Dh = q.shape
    nc = S // ML_CHUNK
    tril = jnp.tril(jnp.ones((ML_CHUNK, ML_CHUNK), dtype=bool))

    def chunks(t):
        return jnp.moveaxis(t.reshape(t.shape[:2] + (nc, ML_CHUNK) + t.shape[3:]), 2, 0)

    def step(carry, inp):
        C, n, m = carry
        qc, kc, vc, ic, fc = inp
        b = jnp.cumsum(fc, axis=-1)
        dmat = jnp.where(tril, b[..., :, None] - b[..., None, :] + ic[..., None, :], -jnp.inf)
        inter = b + m[..., None]
        m_t = jnp.maximum(inter, jnp.max(dmat, axis=-1))
        wt = jnp.exp(dmat - m_t[..., None])
        a = jnp.exp(inter - m_t)
        s = jnp.einsum('bhtd,bhsd->bhts', qc, kc) * wt
        num = a[..., None] * jnp.einsum('bhvk,bhtk->bhtv', C, qc) + jnp.einsum('bhts,bhsv->bhtv', s, vc)
        den = a * jnp.einsum('bhk,bhtk->bht', n, qc) + jnp.sum(s, axis=-1)
        h = num / jnp.maximum(jnp.abs(den), jnp.exp(-m_t))[..., None]
        b_end = b[..., -1]
        g = b_end[..., None] - b + ic
        m_new = jnp.maximum(b_end + m, jnp.max(g, axis=-1))
        decay = jnp.exp(b_end + m - m_new)
        wk = jnp.exp(g - m_new[..., None])[..., None] * kc
        C_new = decay[..., None, None] * C + jnp.einsum('bhsv,bhsk->bhvk', vc, wk)
        n_new = decay[..., None] * n + jnp.sum(wk, axis=2)
        return (C_new, n_new, m_new), h

    state, h = lax.scan(step, state, (chunks(q), chunks(k), chunks(v), chunks(ig), chunks(lf)))
    h = jnp.moveaxis(h, 0, 2).reshape(B, H, S, Dh)
    return state, h


def mlstm_branch(qk, v, o, g, qk_c, v_c, o_c, g_c, conv_w, conv_b, gate_b, norm_w, with_ctx):
    def prep(qk_s, v_s, g_s):
        B, S, _ = v_s.shape
        qk_s = jax.nn.silu(dwconv(qk_s, conv_w, conv_b))
        q, k = jnp.split(qk_s, 2, axis=-1)

        def heads(t):
            return t.astype(jnp.float32).reshape(B, S, ML_HEADS, ML_DH).transpose(0, 2, 1, 3)

        gg = (g_s.reshape(B, S, 2, 2, ML_HEADS) + gate_b).astype(jnp.float32).transpose(2, 3, 0, 4, 1)
        return heads(q) * ML_DH ** -0.5, heads(k), heads(v_s), gg[:, 0], jax.nn.log_sigmoid(gg[:, 1])

    lat = prep(qk, v, g)
    ctx = prep(qk_c, v_c, g_c)
    B = v.shape[0]
    zero = (jnp.zeros((B, ML_HEADS, ML_DH, ML_DH), jnp.float32),
            jnp.zeros((B, ML_HEADS, ML_DH), jnp.float32),
            jnp.zeros((B, ML_HEADS), jnp.float32))
    hs, hcs = [], []
    for d in range(2):
        fl = (lambda t: jnp.flip(t, axis=2)) if d else (lambda t: t)
        st, hc_d = mlstm_scan(fl(ctx[0]), fl(ctx[1]), fl(ctx[2]), fl(ctx[3][d]), fl(ctx[4][d]), zero)
        _, h_d = mlstm_scan(fl(lat[0]), fl(lat[1]), fl(lat[2]), fl(lat[3][d]), fl(lat[4][d]), st)
        hs.append(fl(h_d))
        hcs.append(fl(hc_d))

    def finish(h, o_s):
        Bn, H, S, Dh = h.shape
        h = rmsnorm(h.transpose(0, 2, 1, 3), norm_w.reshape(H, Dh)).reshape(Bn, S, H * Dh)
        return h.astype(o_s.dtype) * jax.nn.sigmoid(o_s)

    out = finish(hs[0] + hs[1], o)
    out_c = finish(hcs[0] + hcs[1], o_c) if with_ctx else None
    return out, out_c


def diff_attend(q, k, v, lam):
    s = jnp.einsum('bhcqd,bhckd->bhcqk', q, k).astype(jnp.float32) * DA_DK ** -0.5
    p = jax.nn.softmax(s, axis=-1)
    a = p[:, :, 0] - lam * p[:, :, 1]
    return jnp.einsum('bhqk,bhkv->bhqv', a.astype(v.dtype), v)


def diff_branch(q, k, v, qc, kc, vc, lam_p, subln_w, lam_init, rows, cols, with_ctx):
    B, T, _ = q.shape
    Lc = qc.shape[1]

    def qk_heads(t, S):
        return t.reshape(B, S, DA_HEADS, 2, DA_DK)

    def to_bhc(t):
        return t.transpose(0, 2, 3, 1, 4)

    q_l = to_bhc(rope_2d(qk_heads(q, T), rows, cols))
    k_l = to_bhc(rope_2d(qk_heads(k, T), rows, cols))
    q_c = to_bhc(qk_heads(qc, Lc))
    k_c = to_bhc(qk_heads(kc, Lc))
    v_l = v.reshape(B, T, DA_HEADS, DA_DV).transpose(0, 2, 1, 3)
    v_c = vc.reshape(B, Lc, DA_HEADS, DA_DV).transpose(0, 2, 1, 3)
    lp = lam_p.astype(jnp.float32)
    lam = jnp.exp(jnp.sum(lp[0] * lp[1])) - jnp.exp(jnp.sum(lp[2] * lp[3])) + lam_init
    k_all = jnp.concatenate([k_l, k_c], axis=3)
    v_all = jnp.concatenate([v_l, v_c], axis=2)
    nb = T // Q_BLOCK
    q_blocks = jnp.moveaxis(q_l.reshape(B, DA_HEADS, 2, nb, Q_BLOCK, DA_DK), 3, 0)
    o = lax.map(lambda qb: diff_attend(qb, k_all, v_all, lam), q_blocks)
    o = o.transpose(1, 0, 3, 2, 4).reshape(B, T, DA_HEADS, DA_DV)

    def finish(t):
        return (rmsnorm(t, subln_w) * (1.0 - lam_init)).reshape(t.shape[0], t.shape[1], DA_HEADS * DA_DV)

    out = finish(o)
    out_c = finish(diff_attend(q_c, k_c, v_c, lam).transpose(0, 2, 1, 3)) if with_ctx else None
    return out, out_c


def fourier_branch(t):
    B, S, _ = t.shape
    tf = t.astype(jnp.float32).reshape(B, S, FN_GROUPS, FN_GD)
    y = jnp.real(jnp.fft.fft2(tf, axes=(1, 3), norm='ortho'))
    return y.reshape(B, S, FN_GROUPS * FN_GD).astype(t.dtype)


def sgu_branch(u, v, norm_w, w_s, b_s):
    B, S, _ = u.shape
    u = jax.nn.gelu(u)
    v = layernorm(jax.nn.gelu(v), norm_w)
    v = v.reshape(B, S // SG_CHUNK, SG_CHUNK, SG_GROUPS, SG_GD)
    v = jnp.einsum('gpq,bnqgd->bnpgd', w_s, v) + b_s.T[:, :, None]
    return u * v.reshape(B, S, SG_GROUPS * SG_GD)


def merge(branches, gate_pre, w_branch, w_out):
    br = jnp.stack(branches, axis=2)
    y = jnp.einsum('bsgc,gcd->bsgd', br, w_branch)
    gt = jax.nn.sigmoid(gate_pre.reshape(gate_pre.shape[:2] + (N_BRANCH, D_MODEL)))
    return jnp.einsum('bsgd,bsgd->bsd', gt, y) @ w_out


def mixer_sublayer(h, hc, rows, cols, lam_init, with_ctx, w_in, ml_conv_w, ml_conv_b, ml_gate_b, ml_norm,
                   da_lam, da_subln, sg_norm, sg_w, sg_b, w_branch, w_out):
    P = split_cols(h @ w_in)
    Pc = split_cols(hc @ w_in)
    m, mc = mlstm_branch(P[0], P[1], P[2], P[3], Pc[0], Pc[1], Pc[2], Pc[3],
                         ml_conv_w, ml_conv_b, ml_gate_b, ml_norm, with_ctx)
    d, dc = diff_branch(P[4], P[5], P[6], Pc[4], Pc[5], Pc[6], da_lam, da_subln, lam_init, rows, cols, with_ctx)
    f = fourier_branch(P[7])
    s = sgu_branch(P[8], P[9], sg_norm, sg_w, sg_b)
    y = merge([m, d, f, s], P[10], w_branch, w_out)
    yc = None
    if with_ctx:
        fc = fourier_branch(Pc[7])
        sc = sgu_branch(Pc[8], Pc[9], sg_norm, sg_w, sg_b)
        yc = merge([mc, dc, fc, sc], Pc[10], w_branch, w_out)
    return y, yc


def conv_ffn(h, w_up, conv_w, conv_b, w_down):
    a, g = jnp.split(h @ w_up, 2, axis=-1)
    return (jax.nn.silu(dwconv(a, conv_w, conv_b)) * g) @ w_down


def setup_inputs(seed: int = 0) -> dict:
    key = jax.random.key(seed)
    ks = jax.random.split(key, 24)
    L, D, H = DEPTH, D_MODEL, ML_HEADS

    def nrm(k, shape, s):
        return jax.random.normal(k, shape, jnp.float32) * s

    gate_b = jnp.stack([nrm(ks[10], (L, 2, H), 0.1),
                        jnp.linspace(3.0, 6.0, H, dtype=jnp.float32) + nrm(ks[11], (L, 2, H), 0.1)], axis=2)
    return {
        'x': nrm(ks[0], (BATCH, SEQ, D), 1.0),
        'c': nrm(ks[1], (BATCH, D), 1.0),
        'ctx': nrm(ks[2], (BATCH, CTX_LEN, D), 1.0),
        'c_ctx': nrm(ks[3], (D,), 1.0),
        'w_ada': nrm(ks[4], (L, D, 6 * D), 0.5 * D ** -0.5),
        'b_ada': nrm(ks[5], (L, 6 * D), 0.02),
        'norm_g': 1.0 + nrm(ks[6], (L, 4, D), 0.05),
        'w_in': nrm(ks[7], (L, D, IN_WIDTH), D ** -0.5),
        'ml_conv_w': nrm(ks[8], (L, CONV_W, 2 * ML_HEADS * ML_DH), 0.5),
        'ml_conv_b': nrm(ks[9], (L, 2 * ML_HEADS * ML_DH), 0.02),
        'ml_gate_b': gate_b,
        'ml_norm': 1.0 + nrm(ks[12], (L, ML_HEADS * ML_DH), 0.05),
        'da_lam': nrm(ks[13], (L, 4, DA_DK), 0.1),
        'da_subln': 1.0 + nrm(ks[14], (L, DA_DV), 0.05),
        'sg_norm': 1.0 + nrm(ks[15], (L, SG_GROUPS * SG_GD), 0.05),
        'sg_w': nrm(ks[16], (L, SG_GROUPS, SG_CHUNK, SG_CHUNK), SG_CHUNK ** -0.5),
        'sg_b': 1.0 + nrm(ks[17], (L, SG_GROUPS, SG_CHUNK), 0.1),
        'w_branch': nrm(ks[18], (L, N_BRANCH, BRANCH_W, D), BRANCH_W ** -0.5),
        'w_out': nrm(ks[19], (L, D, D), D ** -0.5),
        'ffn_up': nrm(ks[20], (L, D, 2 * D_FF), D ** -0.5),
        'ffn_conv_w': nrm(ks[21], (L, CONV_W, D_FF), 0.5),
        'ffn_conv_b': nrm(ks[22], (L, D_FF), 0.02),
        'ffn_down': nrm(ks[23], (L, D_FF, D), D_FF ** -0.5),
    }


def reference(x, c, ctx, c_ctx, w_ada, b_ada, norm_g, w_in, ml_conv_w, ml_conv_b, ml_gate_b, ml_norm,
              da_lam, da_subln, sg_norm, sg_w, sg_b, w_branch, w_out, ffn_up, ffn_conv_w, ffn_conv_b, ffn_down):
    B, T, D = x.shape
    ROWS = T // GRID_W
    rows = jnp.repeat(jnp.arange(ROWS, dtype=jnp.float32), GRID_W)
    cols = jnp.tile(jnp.arange(GRID_W, dtype=jnp.float32), ROWS)
    xc = ctx
    sc = jax.nn.silu(c)
    scc = jax.nn.silu(c_ctx)
    for l in range(DEPTH):
        last = l == DEPTH - 1
        lam_init = 0.8 - 0.6 * math.exp(-0.3 * l)
        mod = (sc @ w_ada[l] + b_ada[l]).reshape(B, 6, 1, D)
        modc = (scc @ w_ada[l] + b_ada[l]).reshape(6, 1, D)
        h = rmsnorm(x, norm_g[l, 0]) * (1.0 + mod[:, 1]) + mod[:, 0]
        hc = rmsnorm(xc, norm_g[l, 0]) * (1.0 + modc[1]) + modc[0]
        y, yc = mixer_sublayer(h, hc, rows, cols, lam_init, not last, w_in[l], ml_conv_w[l], ml_conv_b[l],
                               ml_gate_b[l], ml_norm[l], da_lam[l], da_subln[l], sg_norm[l], sg_w[l], sg_b[l],
                               w_branch[l], w_out[l])
        x = x + mod[:, 2] * rmsnorm(y, norm_g[l, 1])
        h = rmsnorm(x, norm_g[l, 2]) * (1.0 + mod[:, 4]) + mod[:, 3]
        x = x + mod[:, 5] * rmsnorm(conv_ffn(h, ffn_up[l], ffn_conv_w[l], ffn_conv_b[l], ffn_down[l]), norm_g[l, 3])
        if not last:
            xc = xc + modc[2] * rmsnorm(yc, norm_g[l, 1])
            hc = rmsnorm(xc, norm_g[l, 2]) * (1.0 + modc[4]) + modc[3]
            xc = xc + modc[5] * rmsnorm(conv_ffn(hc, ffn_up[l], ffn_conv_w[l], ffn_conv_b[l], ffn_down[l]), norm_g[l, 3])
    return x
```

```cpp
#include <hip/hip_runtime.h>
#include <hip/hip_cooperative_groups.h>
#include <stdint.h>
#include <stdio.h>
namespace cg = cooperative_groups;

typedef unsigned short u16;
typedef short bf16x8 __attribute__((ext_vector_type(8)));
typedef float f32x16 __attribute__((ext_vector_type(16)));
typedef unsigned int u32x4 __attribute__((ext_vector_type(4)));
typedef unsigned int u32x2 __attribute__((ext_vector_type(2)));
typedef float f32x4 __attribute__((ext_vector_type(4)));
#define DEV __device__ __forceinline__

constexpr int NROW = 16896;
constexpr int PSW = 2688;
constexpr int KPOS = 8448;
constexpr int LDS_BYTES = 73728;
constexpr float EPSV = 1e-6f;

constexpr size_t OFF_MOD = 0;
constexpr size_t OFF_TB1 = 294912;
constexpr size_t OFF_TA264 = OFF_TB1 + 16384;
constexpr size_t OFF_TA22 = OFF_TA264 + 32768;
constexpr size_t OFF_TCS = OFF_TA22 + 32768;
constexpr size_t OFF_TW = OFF_TCS + 65536;
constexpr size_t OFF_RT = OFF_TW + 65536;
constexpr size_t OFF_BAR = OFF_RT + 8192;
constexpr size_t OFF_KMAX = OFF_BAR + 15360;
constexpr size_t OFF_XC = OFF_BAR + 16384;
constexpr size_t OFF_H = OFF_XC + 2097152;
constexpr size_t OFF_WT = OFF_H + 34603008;
constexpr size_t WT_IN = 0;
constexpr size_t WT_BR = (size_t)6784 * 1024 * 2;
constexpr size_t WT_OUT = WT_BR + (size_t)4 * 1024 * 256 * 2;
constexpr size_t WT_UP = WT_OUT + (size_t)1024 * 1024 * 2;
constexpr size_t WT_DOWN = WT_UP + (size_t)5632 * 1024 * 2;
constexpr size_t WT_BYTES = WT_DOWN + (size_t)1024 * 2816 * 2;
constexpr size_t OFF_R1 = OFF_WT + WT_BYTES;
constexpr size_t R1_BYTES = (size_t)NROW * 5632 * 2;
constexpr size_t R1_PS = 0;
constexpr size_t R1_QR = (size_t)NROW * PSW * 2;
constexpr size_t R1_KR = R1_QR + 8650752;
constexpr size_t R1_VT = R1_KR + 8650752;
constexpr size_t R1_XRE = R1_VT + 8650752;
constexpr size_t R1_XIM = R1_XRE + 16777216;
constexpr size_t R1_DC = R1_XIM + 16777216;
constexpr size_t R1_DEC = R1_DC + (size_t)16 * 66 * 4160 * 4;
constexpr size_t R1_CP = R1_DEC + 8192;
constexpr size_t R1_END = R1_CP + (size_t)16 * 66 * 4160 * 2;
static_assert(R1_END <= R1_BYTES, "R1 overflow");
constexpr size_t OFF_R2 = OFF_R1 + R1_BYTES;
constexpr size_t R2_BR = 0;
constexpr size_t R2_Z = 34603008;

struct P {
  const float *x, *c, *ctx, *c_ctx, *w_ada, *b_ada, *norm_g, *w_in, *ml_conv_w, *ml_conv_b, *ml_gate_b, *ml_norm,
      *da_lam, *da_subln, *sg_norm, *sg_w, *sg_b, *w_branch, *w_out, *ffn_up, *ffn_conv_w, *ffn_conv_b, *ffn_down;
  float* out;
  char* ws;
  int ph0, ph1, coop, pad;
};

DEV int ltid() { int t = threadIdx.x; asm volatile("" : "+v"(t)); return t; }

#define XB_TMO      128
#define XB_XCNT(j)  (256  + 64 * (j))
#define XB_XSUB(j)  (1280 + 64 * (j))
#define XB_XGEN(j)  (2304 + 64 * (j))
#define XB_TOP      3328
#define XB_TOPGEN   3392
#define XCD_BAR_WORDS 3456
#define XB_SPIN_CAP (1u << 23)
#define LAS __attribute__((address_space(3)))
DEV unsigned xb_ld(unsigned* p) { return __hip_atomic_load(p, __ATOMIC_RELAXED, __HIP_MEMORY_SCOPE_AGENT); }
DEV unsigned xb_add(unsigned* p, unsigned v) { return __hip_atomic_fetch_add(p, v, __ATOMIC_RELAXED, __HIP_MEMORY_SCOPE_AGENT); }
DEV unsigned xb_xcc_id() { return (unsigned)__builtin_amdgcn_s_getreg((3 << 11) | 20) & 0xFu; }
#define XB_SPIN(cond, bar) do { unsigned _sp = 0; while (cond) { __builtin_amdgcn_s_sleep(0); \
    if ((++_sp & 255u) == 0u) { if (xb_ld(&(bar)[XB_TMO])) break; if (_sp > XB_SPIN_CAP) { atomicAdd(&(bar)[XB_TMO], 1u); break; } } } } while (0)
struct XcdBarrier { unsigned* bar; unsigned x; volatile LAS unsigned* st; };
DEV XcdBarrier xcd_barrier_post(unsigned* bar, volatile LAS unsigned* st) {
  XcdBarrier b; b.bar = bar; b.x = xb_xcc_id(); b.st = st;
  if (threadIdx.x == 0) (void)xb_add(&bar[XB_XCNT(b.x)], 1u);
  return b;
}
DEV void xcd_barrier_complete(unsigned* bar, unsigned x, unsigned& nloc, unsigned& nx) {
  const unsigned G = gridDim.x * gridDim.y * gridDim.z;
  unsigned sum, cnt, mine, sp = 0u;
  for (;;) {
    sum = 0u; cnt = 0u; mine = 0u;
#pragma unroll
    for (unsigned j = 0; j < 16; ++j) { const unsigned c = xb_ld(&bar[XB_XCNT(j)]); sum += c; cnt += (c > 0u) ? 1u : 0u; mine = (j == x) ? c : mine; }
    if (sum == G) break;
    __builtin_amdgcn_s_sleep(1);
    if ((++sp & 255u) == 0u) { if (xb_ld(&bar[XB_TMO])) break; if (sp > XB_SPIN_CAP) { atomicAdd(&bar[XB_TMO], 1u); break; } }
  }
  nloc = mine > 0u ? mine : 1u; nx = cnt > 0u ? cnt : 1u;
}
DEV void xcd_barrier(const XcdBarrier& b) {
  asm volatile("s_waitcnt vmcnt(0)" ::: "memory");
  __syncthreads();
  if (threadIdx.x == 0) {
    unsigned* bar = b.bar;
    __builtin_amdgcn_s_waitcnt(0);
    unsigned nloc = b.st[0], nx = b.st[1];
    if (nloc == 0u) { xcd_barrier_complete(bar, b.x, nloc, nx); b.st[0] = nloc; b.st[1] = nx; }
    const unsigned old = xb_add(&bar[XB_XSUB(b.x)], 1u);
    const unsigned gen = old / nloc;
    if (old + 1u == (gen + 1u) * nloc) {
      __builtin_amdgcn_fence(__ATOMIC_RELEASE, "agent");
      asm volatile("s_waitcnt vmcnt(0)" ::: "memory");
      const unsigned og = xb_add(&bar[XB_TOP], 1u);
      const unsigned tg = og / nx;
      if (og + 1u == (tg + 1u) * nx) xb_add(&bar[XB_TOPGEN], 1u);
      else XB_SPIN(xb_ld(&bar[XB_TOPGEN]) == tg, bar);
      __builtin_amdgcn_fence(__ATOMIC_ACQUIRE, "agent");
      xb_add(&bar[XB_XGEN(b.x)], 1u);
      asm volatile("s_waitcnt vmcnt(0)" ::: "memory");
    } else {
      XB_SPIN(xb_ld(&bar[XB_XGEN(b.x)]) == gen, bar);
      __builtin_amdgcn_fence(__ATOMIC_ACQUIRE, "agent");
      asm volatile("s_waitcnt vmcnt(0)" ::: "memory");
    }
  }
  __syncthreads();
}

DEV float bf2f(u16 h) { return __uint_as_float(((unsigned)h) << 16); }
typedef __bf16 hwbf16x2 __attribute__((ext_vector_type(2)));
typedef float f32x2 __attribute__((ext_vector_type(2)));
DEV unsigned pack2(float a, float b) { f32x2 v = {a, b}; hwbf16x2 r = __builtin_convertvector(v, hwbf16x2); return __builtin_bit_cast(unsigned, r); }
DEV u16 f2bf(float f) { return (u16)pack2(f, f); }
DEV float bflo(unsigned u) { return __uint_as_float(u << 16); }
DEV float bfhi(unsigned u) { return __uint_as_float(u & 0xffff0000u); }
DEV float sigmoidf_(float x) { return __builtin_amdgcn_rcpf(1.f + __expf(-x)); }
DEV float siluf_(float x) { return x * __builtin_amdgcn_rcpf(1.f + __expf(-x)); }
DEV float geluf_(float x) { return x * __builtin_amdgcn_rcpf(1.f + __expf(-1.5957691216057308f * (x + 0.044715f * x * x * x))); }
DEV float xmax32(float v) { auto r = __builtin_amdgcn_permlane32_swap(__float_as_uint(v), __float_as_uint(v), false, false); return fmaxf(__uint_as_float(r[0]), __uint_as_float(r[1])); }
DEV float xsum32(float v) { auto r = __builtin_amdgcn_permlane32_swap(__float_as_uint(v), __float_as_uint(v), false, false); return __uint_as_float(r[0]) + __uint_as_float(r[1]); }
DEV int rowmap(int i, int hh) { return (i & 3) + 8 * (i >> 2) + 4 * hh; }
DEV f32x16 mfma(bf16x8 a, bf16x8 b, f32x16 c) { return __builtin_amdgcn_mfma_f32_32x32x16_bf16(a, b, c, 0, 0, 0); }

template <int MI, int NI>
DEV void mma_lds(const u16* sA, int lda, int rowA0, const u16* sB, int ldb, int rowB0, int K, f32x16 (&acc)[MI][NI], int lane) {
  const int r = lane & 31, h = lane >> 5;
  for (int k0 = 0; k0 < K; k0 += 16) {
    bf16x8 a[MI], b[NI];
#pragma unroll
    for (int mi = 0; mi < MI; ++mi) a[mi] = *(const bf16x8*)(sA + (size_t)(rowA0 + mi * 32 + r) * lda + k0 + h * 8);
#pragma unroll
    for (int ni = 0; ni < NI; ++ni) b[ni] = *(const bf16x8*)(sB + (size_t)(rowB0 + ni * 32 + r) * ldb + k0 + h * 8);
#pragma unroll
    for (int mi = 0; mi < MI; ++mi)
#pragma unroll
      for (int ni = 0; ni < NI; ++ni) acc[mi][ni] = mfma(a[mi], b[ni], acc[mi][ni]);
  }
}

DEV int rowmap16(int i, int lane) { return ((i >> 3) & 1) * 16 + (lane >> 4) * 4 + (i & 3); }
DEV int colmap16(int i, int lane) { return ((i >> 2) & 1) * 16 + (lane & 15); }
template <int NI>
DEV void gemm_main(const u16* __restrict__ A, int lda, const u16* __restrict__ Bt, int ldb, int K, f32x16 (&acc)[2][NI], char* smem, int bsplit = 0) {
  constexpr int ABYTES = 128 * 128, STG = ABYTES + NI * 64 * 128;
  const int tid = ltid(), lane = tid & 63, w = tid >> 6, wr = w >> 1, wc = w & 1;
  const int r15 = lane & 15, q4 = lane >> 4;
  const int nk = K / 64;
  const unsigned lbase = (unsigned)(size_t)smem + tid * 16;
  const int sw = (r15 >> 1) & 7;
  const int co = ((tid & 7) ^ ((tid >> 4) & 7)) * 8;
  const u16* Ap = A + (size_t)(tid >> 3) * lda + co;
  const u16* Bp = Bt + (size_t)(tid >> 3) * ldb + co;
  f32x4 c[4][NI * 2];
#pragma unroll
  for (int m = 0; m < 4; ++m)
#pragma unroll
    for (int n = 0; n < NI * 2; ++n)
#pragma unroll
      for (int j = 0; j < 4; ++j) c[m][n][j] = acc[m >> 1][n >> 1][((m & 1) * 2 + (n & 1)) * 4 + j];
#define GLDS(kt, stg)                                                                                             \
  {                                                                                                               \
    _Pragma("unroll") for (int i = 0; i < 4; ++i)                                                                 \
      __builtin_amdgcn_global_load_lds((const unsigned*)(Ap + (size_t)(i * 32) * lda + (kt) * 64), (LAS unsigned*)(lbase + (stg) * STG + i * 4096), 16, 0, 0); \
    _Pragma("unroll") for (int i = 0; i < NI * 2; ++i)                                                            \
      __builtin_amdgcn_global_load_lds((const unsigned*)(Bp + (size_t)(i * 32 + (i >= NI ? bsplit : 0)) * ldb + (kt) * 64), (LAS unsigned*)(lbase + (stg) * STG + ABYTES + i * 4096), 16, 0, 0); \
  }
  GLDS(0, 0);
  asm volatile("s_waitcnt vmcnt(0)" ::: "memory");
  __builtin_amdgcn_s_barrier();
  for (int kt = 0; kt < nk; ++kt) {
    if (kt + 1 < nk) GLDS(kt + 1, (kt + 1) & 1);
    __builtin_amdgcn_sched_barrier(0);
    const char* base = smem + (kt & 1) * STG;
#pragma unroll
    for (int kk = 0; kk < 2; ++kk) {
      bf16x8 a[4], b[NI * 2];
      const int so = ((kk * 4 + q4) ^ sw) * 16;
#pragma unroll
      for (int m = 0; m < 4; ++m) a[m] = *(const bf16x8*)(base + (wr * 64 + m * 16 + r15) * 128 + so);
#pragma unroll
      for (int n = 0; n < NI * 2; ++n) b[n] = *(const bf16x8*)(base + ABYTES + (wc * NI * 32 + n * 16 + r15) * 128 + so);
#pragma unroll
      for (int m = 0; m < 4; ++m)
#pragma unroll
        for (int n = 0; n < NI * 2; ++n) c[m][n] = __builtin_amdgcn_mfma_f32_16x16x32_bf16(a[m], b[n], c[m][n], 0, 0, 0);
    }
    __builtin_amdgcn_sched_barrier(0);
    asm volatile("s_waitcnt vmcnt(0)" ::: "memory");
    __builtin_amdgcn_s_barrier();
  }
#undef GLDS
#pragma unroll
  for (int m = 0; m < 4; ++m)
#pragma unroll
    for (int n = 0; n < NI * 2; ++n)
#pragma unroll
      for (int j = 0; j < 4; ++j) acc[m >> 1][n >> 1][((m & 1) * 2 + (n & 1)) * 4 + j] = c[m][n][j];
}

template <int NI>
DEV void zero_acc(f32x16 (&acc)[2][NI]) {
#pragma unroll
  for (int mi = 0; mi < 2; ++mi)
#pragma unroll
    for (int ni = 0; ni < NI; ++ni)
#pragma unroll
      for (int i = 0; i < 16; ++i) acc[mi][ni][i] = 0.f;
}

DEV void gemm_big_p(const u16* const (&Ap)[4], const u16* const (&Bp)[2], int K, f32x16 (&acc)[4][2], char* smem) {
  constexpr int ABYTES = 256 * 64, STG = ABYTES + 128 * 64;
  const int tid = ltid(), lane = tid & 63, w = tid >> 6, wr = w >> 1, wc = w & 1;
  const int r15 = lane & 15, q4 = lane >> 4;
  const int nk = K / 32;
  const unsigned lbase = (unsigned)(size_t)smem + tid * 16;
  const int so = (q4 ^ ((0x78 >> (((r15 >> 2) & 3) * 2)) & 3)) * 16;
  f32x4 c[8][4];
#pragma unroll
  for (int m = 0; m < 8; ++m)
#pragma unroll
    for (int n = 0; n < 4; ++n)
#pragma unroll
      for (int j = 0; j < 4; ++j) c[m][n][j] = acc[m >> 1][n >> 1][((m & 1) * 2 + (n & 1)) * 4 + j];
#define GLDS(kt, stg)                                                                                             \
  {                                                                                                               \
    _Pragma("unroll") for (int i = 0; i < 4; ++i)                                                                 \
      __builtin_amdgcn_global_load_lds((const unsigned*)(Ap[i] + (kt) * 32), (LAS unsigned*)(lbase + (stg) * STG + i * 4096), 16, 0, 0); \
    _Pragma("unroll") for (int i = 0; i < 2; ++i)                                                                 \
      __builtin_amdgcn_global_load_lds((const unsigned*)(Bp[i] + (kt) * 32), (LAS unsigned*)(lbase + (stg) * STG + ABYTES + i * 4096), 16, 0, 0); \
  }
  GLDS(0, 0);
  if (nk > 1) { GLDS(1, 1); asm volatile("s_waitcnt vmcnt(6)" ::: "memory"); }
  else asm volatile("s_waitcnt vmcnt(0)" ::: "memory");
  __builtin_amdgcn_s_barrier();
  int cur = 0;
  for (int kt = 0; kt < nk; ++kt) {
    int nxt2 = cur + 2; if (nxt2 >= 3) nxt2 -= 3;
    if (kt + 2 < nk) GLDS(kt + 2, nxt2);
    __builtin_amdgcn_sched_barrier(0);
    const char* base = smem + cur * STG;
    {
      bf16x8 a[8], b[4];
#pragma unroll
      for (int m = 0; m < 8; ++m) a[m] = *(const bf16x8*)(base + (wr * 128 + m * 16 + r15) * 64 + so);
#pragma unroll
      for (int n = 0; n < 4; ++n) b[n] = *(const bf16x8*)(base + ABYTES + (wc * 64 + n * 16 + r15) * 64 + so);
#pragma unroll
      for (int m = 0; m < 8; ++m)
#pragma unroll
        for (int n = 0; n < 4; ++n) c[m][n] = __builtin_amdgcn_mfma_f32_16x16x32_bf16(a[m], b[n], c[m][n], 0, 0, 0);
    }
    __builtin_amdgcn_sched_barrier(0);
    if (kt + 2 < nk) asm volatile("s_waitcnt vmcnt(6)" ::: "memory");
    else asm volatile("s_waitcnt vmcnt(0)" ::: "memory");
    __builtin_amdgcn_s_barrier();
    cur = cur + 1 == 3 ? 0 : cur + 1;
  }
#undef GLDS
#pragma unroll
  for (int m = 0; m < 8; ++m)
#pragma unroll
    for (int n = 0; n < 4; ++n)
#pragma unroll
      for (int j = 0; j < 4; ++j) acc[m >> 1][n >> 1][((m & 1) * 2 + (n & 1)) * 4 + j] = c[m][n][j];
}
DEV void gemm_big(const u16* __restrict__ A, int lda, const u16* __restrict__ Bt, int ldb, int K, f32x16 (&acc)[4][2], char* smem) {
  const int tid = ltid();
  const int co = ((tid & 3) ^ ((0x78 >> (((tid >> 4) & 3) * 2)) & 3)) * 8;
  const u16* a0 = A + (size_t)(tid >> 2) * lda + co;
  const u16* b0 = Bt + (size_t)(tid >> 2) * ldb + co;
  const u16* const Ap[4] = {a0, a0 + (size_t)64 * lda, a0 + (size_t)128 * lda, a0 + (size_t)192 * lda};
  const u16* const Bp[2] = {b0, b0 + (size_t)64 * ldb};
  gemm_big_p(Ap, Bp, K, acc, smem);
}
DEV void zero_big(f32x16 (&acc)[4][2]) {
#pragma unroll
  for (int mi = 0; mi < 4; ++mi)
#pragma unroll
    for (int ni = 0; ni < 2; ++ni)
#pragma unroll
      for (int i = 0; i < 16; ++i) acc[mi][ni][i] = 0.f;
}
template <class F>
DEV void banded(int bid, int nb, int MT, int NT, int W, F f) {
  const int TOT = MT * NT, x = bid & 7, j = bid >> 3, per = nb >> 3, chunk = (TOT + 7) >> 3;
  for (int q = j; q < chunk; q += per) {
    int t = x * chunk + q;
    if (t >= TOT) break;
    int band = t / (MT * W), r = t - band * MT * W;
    int mt = r / W, nt = band * W + r - mt * W;
    f(mt, nt);
  }
}

DEV void mod_item(const P& p, int item, char* smem) {
  float* sS = (float*)smem;
  float* sR = sS + 3072;
  const int tid = ltid();
  for (int i = tid; i < 3072; i += 256) {
    int v = i >> 10, k = i & 1023;
    float c = v < 2 ? p.c[v * 1024 + k] : p.c_ctx[k];
    sS[i] = c * __builtin_amdgcn_rcpf(1.f + __expf(-c));
  }
  __syncthreads();
  const int l = item / 192, cgp = item % 192, cc = tid & 31, col = cgp * 32 + cc, kq = tid >> 5;
  const float* w = p.w_ada + (size_t)l * 1024 * 6144 + col;
  float a0 = 0, a1 = 0, a2 = 0;
#pragma unroll 16
  for (int k = kq * 128; k < kq * 128 + 128; ++k) {
    float wv = w[(size_t)k * 6144];
    a0 += sS[k] * wv; a1 += sS[1024 + k] * wv; a2 += sS[2048 + k] * wv;
  }
  sR[(kq * 3 + 0) * 32 + cc] = a0;
  sR[(kq * 3 + 1) * 32 + cc] = a1;
  sR[(kq * 3 + 2) * 32 + cc] = a2;
  __syncthreads();
  if (tid < 96) {
    int v = tid >> 5, c2 = tid & 31;
    float s_ = 0;
    for (int q = 0; q < 8; ++q) s_ += sR[(q * 3 + v) * 32 + c2];
    int col2 = cgp * 32 + c2;
    ((float*)(p.ws + OFF_MOD))[(l * 3 + v) * 6144 + col2] = s_ + p.b_ada[l * 6144 + col2];
  }
  __syncthreads();
}

DEV void tab_item(const P& p, int item) {
  u16* TB1 = (u16*)(p.ws + OFF_TB1);
  u16* TA264 = (u16*)(p.ws + OFF_TA264);
  u16* TA22 = (u16*)(p.ws + OFF_TA22);
  u16* TCS = (u16*)(p.ws + OFF_TCS);
  float* TW = (float*)(p.ws + OFF_TW);
  float* RT = (float*)(p.ws + OFF_RT);
  const int tid0 = ltid();
  for (int i = 0; i < 16; ++i) {
    int e = item * 4096 + i * 256 + tid0;
    float s, c;
    if (e < 8192) {
      int n = e >> 6, d = e & 63, m = ((n & 63) * d) & 63;
      sincospif(m / 32.f, &s, &c);
      TB1[e] = f2bf(n < 64 ? c : -s);
    } else if (e < 24576) {
      int q = e - 8192, r = q >> 7, j = q & 127, ka = r & 63, s1 = j & 63, m = (ka * s1) & 63;
      sincospif(m / 32.f, &s, &c);
      bool im = r >= 64, sec = j >= 64;
      float v = !im ? (sec ? s : c) : (sec ? c : -s);
      TA264[q] = f2bf(v);
    } else if (e < 40960) {
      int q = e - 24576, r = q >> 7, j = q & 127, ka = r & 63, s1 = j & 63;
      bool im = r >= 64, sec = j >= 64;
      float v = 0.f;
      if (ka < 2 && s1 < 2 && (im == sec)) v = (ka & s1) ? -1.f : 1.f;
      TA22[q] = f2bf(v);
    } else if (e < 73728) {
      int q = e - 40960, kb = q >> 8, j = q & 255, s2 = j & 127, m = (kb * s2) & 127;
      sincospif(m / 64.f, &s, &c);
      TCS[q] = f2bf(j < 128 ? c : s);
    } else if (e < 81920) {
      int q = e - 73728;
      sincospif(q / 4096.f, &s, &c);
      TW[2 * q] = c; TW[2 * q + 1] = s;
    } else if (e < 82944) {
      int q = e - 81920, pos = q >> 3, fi = q & 7;
      float fr = exp2f(-(float)fi * 0.125f * 13.287712379549449f);
      float ang = (float)pos * fr;
      double t = (double)ang * 0.3183098861837907;
      t -= 2.0 * floor(t * 0.5);
      sincospif((float)t, &s, &c);
      RT[2 * q] = c; RT[2 * q + 1] = s;
    }
  }
}

DEV void conv_item(const P& p, int l, int item, char* smem) {
  float* tile = (float*)smem;
  const int tid = ltid();
  char* WT = p.ws + OFF_WT;
  const float* src; u16* dst; int K, Nsrc, kt, nt, mode = 0;
  if (item < 1696) { src = p.w_in + (size_t)l * 1024 * 6672; K = 1024; Nsrc = 6672; dst = (u16*)(WT + WT_IN); kt = item % 16; nt = item / 16; mode = 1; }
  else if (item < 1952) { int q = item - 1696; int g = q >> 6; q &= 63; src = p.w_branch + (size_t)(l * 4 + g) * 256 * 1024; K = 256; Nsrc = 1024; dst = (u16*)(WT + WT_BR) + (size_t)g * 1024 * 256; kt = q % 4; nt = q / 4; }
  else if (item < 2208) { int q = item - 1952; src = p.w_out + (size_t)l * 1024 * 1024; K = 1024; Nsrc = 1024; dst = (u16*)(WT + WT_OUT); kt = q % 16; nt = q / 16; }
  else if (item < 3616) { int q = item - 2208; src = p.ffn_up + (size_t)l * 1024 * 5632; K = 1024; Nsrc = 5632; dst = (u16*)(WT + WT_UP); kt = q % 16; nt = q / 16; }
  else { int q = item - 3616; src = p.ffn_down + (size_t)l * 2816 * 1024; K = 2816; Nsrc = 1024; dst = (u16*)(WT + WT_DOWN); kt = q % 44; nt = q / 44; }
  int nd = nt * 64 + (tid & 63), ns = nd; bool valid = true;
  if (mode) {
    if (nd < 1024) ns = nd;
    else if (nd < 2560) ns = nd + 16;
    else if (nd < 2576) ns = 1024 + nd - 2560;
    else if (nd < 2688) valid = false;
    else ns = nd - 112;
  }
#pragma unroll
  for (int i = 0; i < 16; ++i) {
    int kk = (tid >> 6) + 4 * i;
    tile[kk * 65 + (tid & 63)] = valid ? src[(size_t)(kt * 64 + kk) * Nsrc + ns] : 0.f;
  }
  __syncthreads();
  const int n = tid >> 2, kq = tid & 3;
  unsigned pk[8];
#pragma unroll
  for (int j = 0; j < 8; ++j) pk[j] = pack2(tile[(kq * 16 + 2 * j) * 65 + n], tile[(kq * 16 + 2 * j + 1) * 65 + n]);
  u32x4* d = (u32x4*)(dst + (size_t)(nt * 64 + n) * K + kt * 64 + kq * 16);
  d[0] = u32x4{pk[0], pk[1], pk[2], pk[3]};
  d[1] = u32x4{pk[4], pk[5], pk[6], pk[7]};
  __syncthreads();
}

DEV float dpp_add(float v, int ctrl_is) { return v; }
DEV float wave_sum(float v) {
  int x = __float_as_int(v);
  v += __int_as_float(__builtin_amdgcn_update_dpp(0, x, 0xB1, 0xF, 0xF, true));
  x = __float_as_int(v);
  v += __int_as_float(__builtin_amdgcn_update_dpp(0, x, 0x4E, 0xF, 0xF, true));
  x = __float_as_int(v);
  v += __int_as_float(__builtin_amdgcn_update_dpp(0, x, 0x141, 0xF, 0xF, true));
  x = __float_as_int(v);
  v += __int_as_float(__builtin_amdgcn_update_dpp(0, x, 0x140, 0xF, 0xF, true));
  x = __float_as_int(v);
  return __int_as_float(__builtin_amdgcn_readlane(x, 0)) + __int_as_float(__builtin_amdgcn_readlane(x, 16)) +
         __int_as_float(__builtin_amdgcn_readlane(x, 32)) + __int_as_float(__builtin_amdgcn_readlane(x, 48));
}

DEV void rowpass_item(const P& p, int l, int mode, int item) {
  const int tid0 = ltid(); const int w = tid0 >> 6, lane = tid0 & 63, r = item * 4 + w;
  const int vec = r < 8192 ? 0 : (r < 16384 ? 1 : 2);
  float* X = r < 16384 ? p.out + (size_t)r * 1024 : (float*)(p.ws + OFF_XC) + (size_t)(r - 16384) * 1024;
  const float* MOD = (const float*)(p.ws + OFF_MOD);
  const int lh = (mode == 2) ? l + 1 : l;
  const bool doh = lh < 4;
  const int lhc = doh ? lh : 3;
  const float* xsrc = mode == 0 ? (r < 16384 ? p.x + (size_t)r * 1024 : p.ctx + (size_t)(r - 16384) * 1024) : X;
  const float* Y = (const float*)(p.ws + OFF_R1) + (size_t)r * 1024;
  const float* gate = MOD + (size_t)(l * 3 + vec) * 6144 + (mode == 1 ? 2 : 5) * 1024;
  const float* gp = p.norm_g + (size_t)(l * 4 + (mode == 1 ? 1 : 3)) * 1024;
  const float* g = p.norm_g + (size_t)(lhc * 4 + (mode == 1 ? 2 : 0)) * 1024;
  const float* sc = MOD + (size_t)(lhc * 3 + vec) * 6144 + (mode == 1 ? 4 : 1) * 1024;
  const float* sh = MOD + (size_t)(lhc * 3 + vec) * 6144 + (mode == 1 ? 3 : 0) * 1024;
  f32x4 xq[4], yq[4], gq[4], nq[4], hq[4], s1q[4], s0q[4];
#pragma unroll
  for (int i = 0; i < 4; ++i) {
    xq[i] = *(const f32x4*)(xsrc + i * 256 + lane * 4);
    if (mode != 0) {
      yq[i] = *(const f32x4*)(Y + i * 256 + lane * 4);
      gq[i] = *(const f32x4*)(gate + i * 256 + lane * 4);
      nq[i] = *(const f32x4*)(gp + i * 256 + lane * 4);
    }
    hq[i] = *(const f32x4*)(g + i * 256 + lane * 4);
    s1q[i] = *(const f32x4*)(sc + i * 256 + lane * 4);
    s0q[i] = *(const f32x4*)(sh + i * 256 + lane * 4);
  }
  if (mode != 0) {
    float ss = 0;
#pragma unroll
    for (int i = 0; i < 4; ++i)
#pragma unroll
      for (int j = 0; j < 4; ++j) ss += yq[i][j] * yq[i][j];
    ss = wave_sum(ss);
    const float rs = rsqrtf(ss * (1.f / 1024.f) + EPSV);
#pragma unroll
    for (int i = 0; i < 4; ++i)
#pragma unroll
      for (int j = 0; j < 4; ++j) xq[i][j] += gq[i][j] * (yq[i][j] * rs * nq[i][j]);
  }
#pragma unroll
  for (int i = 0; i < 4; ++i) *(f32x4*)(X + i * 256 + lane * 4) = xq[i];
  if (doh) {
    float ss = 0;
#pragma unroll
    for (int i = 0; i < 4; ++i)
#pragma unroll
      for (int j = 0; j < 4; ++j) ss += xq[i][j] * xq[i][j];
    ss = wave_sum(ss);
    const float rs = rsqrtf(ss * (1.f / 1024.f) + EPSV);
    u16* H = (u16*)(p.ws + OFF_H) + (size_t)r * 1024;
#pragma unroll
    for (int i = 0; i < 4; ++i) {
      float h0 = xq[i][0] * rs * hq[i][0] * (1.f + s1q[i][0]) + s0q[i][0];
      float h1 = xq[i][1] * rs * hq[i][1] * (1.f + s1q[i][1]) + s0q[i][1];
      float h2 = xq[i][2] * rs * hq[i][2] * (1.f + s1q[i][2]) + s0q[i][2];
      float h3 = xq[i][3] * rs * hq[i][3] * (1.f + s1q[i][3]) + s0q[i][3];
      *(u32x2*)(H + i * 256 + lane * 4) = u32x2{pack2(h0, h1), pack2(h2, h3)};
    }
  }
}

DEV void gemm1_item(const P& p, int mt, int nt, char* smem) {
  f32x16 acc[2][2]; zero_acc<2>(acc);
  gemm_main<2>((const u16*)(p.ws + OFF_H) + (size_t)mt * 128 * 1024, 1024, (const u16*)(p.ws + OFF_WT + WT_IN) + (size_t)nt * 128 * 1024, 1024, 1024, acc, smem);
  const int tid0 = ltid(); const int lane = tid0 & 63, w = tid0 >> 6, wr = w >> 1, wc = w & 1, r31 = lane & 31, hh = lane >> 5;
  u16* PS = (u16*)(p.ws + OFF_R1 + R1_PS);
#pragma unroll
  for (int mi = 0; mi < 2; ++mi)
#pragma unroll
    for (int ni = 0; ni < 2; ++ni)
#pragma unroll
      for (int i = 0; i < 16; ++i) {
        int row = mt * 128 + wr * 64 + mi * 32 + rowmap16(i, lane), col = nt * 128 + wc * 64 + ni * 32 + colmap16(i, lane);
        PS[(size_t)row * PSW + col] = f2bf(acc[mi][ni][i]);
      }
}

template <int NI>
DEV void merge_item(const P& p, int mt, int nt, char* smem) {
  f32x16 z[2][NI]; zero_acc<NI>(z);
  const u16* H = (const u16*)(p.ws + OFF_H) + (size_t)mt * 128 * 1024;
  const u16* BR = (const u16*)(p.ws + OFF_R2 + R2_BR) + (size_t)mt * 128 * 1024;
  const u16* WinT = (const u16*)(p.ws + OFF_WT + WT_IN);
  const u16* WbrT = (const u16*)(p.ws + OFF_WT + WT_BR);
#pragma unroll 1
  for (int g = 0; g < 4; ++g) {
    unsigned yp[2][NI][8];
    {
      f32x16 ay[2][NI]; zero_acc<NI>(ay);
      gemm_main<NI>(BR + g * 256, 1024, WbrT + (size_t)(g * 1024 + nt * NI * 64) * 256, 256, 256, ay, smem);
#pragma unroll
      for (int mi = 0; mi < 2; ++mi)
#pragma unroll
        for (int ni = 0; ni < NI; ++ni)
#pragma unroll
          for (int j = 0; j < 8; ++j) yp[mi][ni][j] = pack2(ay[mi][ni][2 * j], ay[mi][ni][2 * j + 1]);
      __builtin_amdgcn_sched_barrier(0);
    }
    f32x16 ag[2][NI]; zero_acc<NI>(ag);
    gemm_main<NI>(H, 1024, WinT + (size_t)(2688 + g * 1024 + nt * NI * 64) * 1024, 1024, 1024, ag, smem);
#pragma unroll
    for (int mi = 0; mi < 2; ++mi)
#pragma unroll
      for (int ni = 0; ni < NI; ++ni)
#pragma unroll
        for (int j = 0; j < 8; ++j) {
          const unsigned y2 = yp[mi][ni][j];
          z[mi][ni][2 * j] += sigmoidf_(ag[mi][ni][2 * j]) * bflo(y2);
          z[mi][ni][2 * j + 1] += sigmoidf_(ag[mi][ni][2 * j + 1]) * bfhi(y2);
        }
  }
  const int tid0 = ltid(); const int lane = tid0 & 63, w = tid0 >> 6, wr = w >> 1, wc = w & 1, r31 = lane & 31, hh = lane >> 5;
  u16* Z = (u16*)(p.ws + OFF_R2 + R2_Z);
#pragma unroll
  for (int mi = 0; mi < 2; ++mi)
#pragma unroll
    for (int ni = 0; ni < NI; ++ni)
#pragma unroll
      for (int i = 0; i < 16; ++i) {
        int row = mt * 128 + wr * 64 + mi * 32 + rowmap16(i, lane), col = nt * NI * 64 + wc * NI * 32 + ni * 32 + colmap16(i, lane);
        Z[(size_t)row * 1024 + col] = f2bf(z[mi][ni][i]);
      }
}

DEV void gemm_f32_big(const u16* A, int K, const u16* Bt, float* O, int mt, int nt, char* smem) {
  f32x16 acc[2][2]; zero_acc<2>(acc);
  gemm_main<2>(A + (size_t)mt * 128 * K, K, Bt + (size_t)nt * 128 * K, K, K, acc, smem);
  const int tid0 = ltid(); const int lane = tid0 & 63, w = tid0 >> 6, wr = w >> 1, wc = w & 1, r31 = lane & 31, hh = lane >> 5;
#pragma unroll
  for (int mi = 0; mi < 2; ++mi)
#pragma unroll
    for (int ni = 0; ni < 2; ++ni)
#pragma unroll
      for (int i = 0; i < 16; ++i) {
        int row = mt * 128 + wr * 64 + mi * 32 + rowmap16(i, lane), col = nt * 128 + wc * 64 + ni * 32 + colmap16(i, lane);
        O[(size_t)row * 1024 + col] = acc[mi][ni][i];
      }
}
DEV void gemm_f32_small(const u16* A, int K, const u16* Bt, float* O, int item, char* smem) {
  const int mt = item >> 4, nt = item & 15;
  f32x16 acc[2][1]; zero_acc<1>(acc);
  gemm_main<1>(A + (size_t)(16384 + mt * 128) * K, K, Bt + (size_t)nt * 64 * K, K, K, acc, smem);
  const int tid0 = ltid(); const int lane = tid0 & 63, w = tid0 >> 6, wr = w >> 1, wc = w & 1, r31 = lane & 31, hh = lane >> 5;
#pragma unroll
  for (int mi = 0; mi < 2; ++mi)
#pragma unroll
    for (int i = 0; i < 16; ++i) {
      int row = 16384 + mt * 128 + wr * 64 + mi * 32 + rowmap16(i, lane), col = nt * 64 + wc * 32 + colmap16(i, lane);
      O[(size_t)row * 1024 + col] = acc[mi][0][i];
    }
}

DEV void seq_bounds(int r, int& s0, int& s1) {
  if (r < 16384) { s0 = r & ~8191; s1 = s0 + 8192; } else { s0 = 16384 + ((r - 16384) & ~255); s1 = s0 + 256; }
}

DEV void upact_item(const P& p, int l, int mt, int nt, char* smem) {
  const int tid = ltid();
  const int srow = mt * 254 - 1;
  const u16* H = (const u16*)(p.ws + OFF_H);
  const u16* W = (const u16*)(p.ws + OFF_WT + WT_UP);
  const u16* Ap[4];
#pragma unroll
  for (int i = 0; i < 4; ++i) {
    int gr = srow + (tid >> 2) + 64 * i;
    gr = gr < 0 ? 0 : (gr > NROW - 1 ? NROW - 1 : gr);
    Ap[i] = H + (size_t)gr * 1024 + ((tid & 3) ^ ((0x78 >> (((tid >> 4) & 3) * 2)) & 3)) * 8;
  }
  const int co = ((tid & 3) ^ ((0x78 >> (((tid >> 4) & 3) * 2)) & 3)) * 8;
  const u16* const Bp[2] = {W + (size_t)(nt * 64 + (tid >> 2)) * 1024 + co, W + (size_t)(2816 + nt * 64 + (tid >> 2)) * 1024 + co};
  f32x16 acc[4][2]; zero_big(acc);
  {
    const u16* const Ap2[4] = {Ap[0], Ap[1], Ap[2], Ap[3]};
    gemm_big_p(Ap2, Bp, 1024, acc, smem);
  }
  const int lane = tid & 63, w = tid >> 6, wr = w >> 1, wc = w & 1, r31 = lane & 31, hh = lane >> 5;
  u16* sU = (u16*)smem;
#pragma unroll
  for (int mi = 0; mi < 4; ++mi)
#pragma unroll
    for (int ni = 0; ni < 2; ++ni)
#pragma unroll
      for (int i = 0; i < 16; ++i) sU[(wr * 128 + mi * 32 + rowmap16(i, lane)) * 136 + wc * 64 + ni * 32 + colmap16(i, lane)] = f2bf(acc[mi][ni][i]);
  __syncthreads();
  const int cg_ = tid & 7, col = nt * 64 + cg_ * 8;
  const float* cw = p.ffn_conv_w + (size_t)l * 3 * 2816 + col;
  const float* cb = p.ffn_conv_b + (size_t)l * 2816 + col;
  float w0[8], w1[8], w2[8], bb[8];
#pragma unroll
  for (int q = 0; q < 2; ++q) {
    f32x4 t0 = *(const f32x4*)(cw + q * 4), t1 = *(const f32x4*)(cw + 2816 + q * 4), t2 = *(const f32x4*)(cw + 5632 + q * 4), t3 = *(const f32x4*)(cb + q * 4);
#pragma unroll
    for (int e = 0; e < 4; ++e) { w0[q * 4 + e] = t0[e]; w1[q * 4 + e] = t1[e]; w2[q * 4 + e] = t2[e]; bb[q * 4 + e] = t3[e]; }
  }
  u16* ACT = (u16*)(p.ws + OFF_R2);
  for (int k = 0; k < 8; ++k) {
    const int idx = tid + k * 256, rr = 1 + (idx >> 3);
    const int R = srow + rr;
    if (rr <= 254 && R < NROW) {
      int s0, s1; seq_bounds(R, s0, s1);
      const u32x4 z4 = {0, 0, 0, 0};
      const u32x4 am = (R - 1 >= s0) ? *(const u32x4*)(sU + (rr - 1) * 136 + cg_ * 8) : z4;
      const u32x4 a0 = *(const u32x4*)(sU + rr * 136 + cg_ * 8);
      const u32x4 ap = (R + 1 < s1) ? *(const u32x4*)(sU + (rr + 1) * 136 + cg_ * 8) : z4;
      const u32x4 gg = *(const u32x4*)(sU + rr * 136 + 64 + cg_ * 8);
      float o[8];
#pragma unroll
      for (int j = 0; j < 4; ++j) {
        float v0 = w0[2 * j] * bflo(am[j]) + w1[2 * j] * bflo(a0[j]) + w2[2 * j] * bflo(ap[j]) + bb[2 * j];
        float v1 = w0[2 * j + 1] * bfhi(am[j]) + w1[2 * j + 1] * bfhi(a0[j]) + w2[2 * j + 1] * bfhi(ap[j]) + bb[2 * j + 1];
        o[2 * j] = siluf_(v0) * bflo(gg[j]);
        o[2 * j + 1] = siluf_(v1) * bfhi(gg[j]);
      }
      *(u32x4*)(ACT + (size_t)R * 2816 + col) = u32x4{pack2(o[0], o[1]), pack2(o[2], o[3]), pack2(o[4], o[5]), pack2(o[6], o[7])};
    }
  }
  __syncthreads();
}

DEV void attnprep_item(const P& p, int tl, char* smem) {
  const int tid = ltid();
  const u16* PS = (const u16*)(p.ws + OFF_R1 + R1_PS);
  u16* QR = (u16*)(p.ws + OFF_R1 + R1_QR);
  u16* KR = (u16*)(p.ws + OFF_R1 + R1_KR);
  u16* VT = (u16*)(p.ws + OFF_R1 + R1_VT);
  const float* RT = (const float*)(p.ws + OFF_RT);
  const int r0 = tl * 128;
  const bool lat = r0 < 16384;
  const int b = lat ? (r0 >> 13) : ((r0 - 16384) >> 8);
  const int pos0 = lat ? (r0 & 8191) : 8192 + ((r0 - 16384) & 255);
  const float QS = 0.17677669529663687f * 1.4426950408889634f;
  unsigned* sKm = (unsigned*)(smem + 70656);
  if (tid < 8) sKm[tid] = 0u;
  __syncthreads();
  for (int it = 0; it < 4; ++it) {
    int task = tid + it * 256, tok = task >> 3, hc = task & 7, h = hc >> 1, c = hc & 1;
    int r = r0 + tok, pos = pos0 + tok;
    int rowi = (pos >> 6) & 127, coli = pos & 63;
    for (int qk = 0; qk < 2; ++qk) {
      const u16* src = PS + (size_t)r * PSW + (qk ? 1280 : 1024) + h * 64 + c * 32;
      float v[32];
#pragma unroll
      for (int j = 0; j < 4; ++j) {
        u32x4 u = *(const u32x4*)(src + j * 8);
#pragma unroll
        for (int e = 0; e < 4; ++e) { v[j * 8 + 2 * e] = bflo(u[e]); v[j * 8 + 2 * e + 1] = bfhi(u[e]); }
      }
      float o[32];
      if (lat) {
#pragma unroll
        for (int a = 0; a < 2; ++a) {
          int pa = a == 0 ? rowi : coli;
#pragma unroll
          for (int i = 0; i < 8; ++i) {
            float cs = RT[(pa * 8 + i) * 2], sn = RT[(pa * 8 + i) * 2 + 1];
            float x1 = v[a * 16 + i], x2 = v[a * 16 + 8 + i];
            o[a * 16 + i] = x1 * cs - x2 * sn;
            o[a * 16 + 8 + i] = x2 * cs + x1 * sn;
          }
        }
      } else {
#pragma unroll
        for (int i = 0; i < 32; ++i) o[i] = v[i];
      }
      const float sc = qk ? 1.f : QS;
      if (qk) {
        float ssk = 0.f;
#pragma unroll
        for (int i = 0; i < 32; ++i) { float t = bf2f(f2bf(o[i])); ssk += t * t; }
        ssk = fmaxf(ssk, __shfl_xor(ssk, 8)); ssk = fmaxf(ssk, __shfl_xor(ssk, 16)); ssk = fmaxf(ssk, __shfl_xor(ssk, 32));
        if ((tid & 63) < 8) atomicMax(&sKm[hc], __float_as_uint(ssk));
      }
      u16* dst = (qk ? KR : QR) + ((size_t)((b * 4 + h) * 2 + c) * KPOS + pos) * 32;
#pragma unroll
      for (int j = 0; j < 4; ++j)
        *(u32x4*)(dst + j * 8) = u32x4{pack2(o[j * 8] * sc, o[j * 8 + 1] * sc), pack2(o[j * 8 + 2] * sc, o[j * 8 + 3] * sc),
                                       pack2(o[j * 8 + 4] * sc, o[j * 8 + 5] * sc), pack2(o[j * 8 + 6] * sc, o[j * 8 + 7] * sc)};
    }
  }
  u16* sV = (u16*)smem;
  for (int it = 0; it < 16; ++it) {
    int ch = tid + it * 256, tok = ch & 127, cc = ch >> 7;
    u32x4 u = *(const u32x4*)(PS + (size_t)(r0 + tok) * PSW + 1536 + cc * 8);
    const int tokp = (tok & ~12) | ((tok & 4) << 1) | ((tok & 8) >> 1);
#pragma unroll
    for (int e = 0; e < 4; ++e) {
      sV[(cc * 8 + 2 * e) * 136 + tokp] = (u16)(u[e] & 0xffff);
      sV[(cc * 8 + 2 * e + 1) * 136 + tokp] = (u16)(u[e] >> 16);
    }
  }
  __syncthreads();
  if (tid < 8) atomicMax((unsigned*)(p.ws + OFF_KMAX) + (b * 4 + (tid >> 1)) * 2 + (tid & 1), sKm[tid]);
  {
    int hv = tid;
    u16* dst = VT + ((size_t)(b * 4) * 64 + hv) * KPOS + pos0;
#pragma unroll
    for (int j = 0; j < 16; ++j) *(u32x4*)(dst + j * 8) = *(const u32x4*)(sV + hv * 136 + j * 8);
  }
  __syncthreads();
}

DEV void ml_gates(const P& p, int l, int h, int r0, float* sG) {
  const int tid = ltid(), lane = tid & 63, w = tid >> 6;
  const u16* PS = (const u16*)(p.ws + OFF_R1 + R1_PS);
  {
    int t = tid & 127, d = tid >> 7;
    const u16* g = PS + (size_t)(r0 + t) * PSW + 2560 + d * 8;
    float ig = bf2f(g[h]) + p.ml_gate_b[((l * 2 + d) * 2 + 0) * 4 + h];
    float fg = bf2f(g[4 + h]) + p.ml_gate_b[((l * 2 + d) * 2 + 1) * 4 + h];
    float lf = fminf(fg, 0.f) - __logf(1.f + __expf(-fabsf(fg)));
    sG[d * 128 + t] = ig;
    sG[(4 + d) * 128 + t] = lf;
  }
  __syncthreads();
  if (w == 0) {
    float a = sG[4 * 128 + 2 * lane], b2 = sG[4 * 128 + 2 * lane + 1];
    float s = a + b2, incl = s;
#pragma unroll
    for (int off = 1; off < 64; off <<= 1) { float t = __shfl_up(incl, off); if (lane >= off) incl += t; }
    float excl = incl - s;
    sG[2 * 128 + 2 * lane] = excl + a;
    sG[2 * 128 + 2 * lane + 1] = excl + a + b2;
  } else if (w == 1) {
    float a = sG[5 * 128 + 2 * lane], b2 = sG[5 * 128 + 2 * lane + 1];
    float s = a + b2, incl = s;
#pragma unroll
    for (int off = 1; off < 64; off <<= 1) { float t = __shfl_down(incl, off); if (lane + off < 64) incl += t; }
    float excl = incl - s;
    sG[3 * 128 + 2 * lane + 1] = excl + b2;
    sG[3 * 128 + 2 * lane] = excl + b2 + a;
  }
  __syncthreads();
}

DEV void ml_conv8(const P& p, int l, const u16* PS, int r, int s0, int s1, int col, float scale, float* o) {
  u32x4 z4 = {0, 0, 0, 0};
  u32x4 am = (r - 1 >= s0) ? *(const u32x4*)(PS + (size_t)(r - 1) * PSW + col) : z4;
  u32x4 a0 = *(const u32x4*)(PS + (size_t)r * PSW + col);
  u32x4 ap = (r + 1 < s1) ? *(const u32x4*)(PS + (size_t)(r + 1) * PSW + col) : z4;
  const float* cw = p.ml_conv_w + (size_t)l * 3 * 512 + col;
  const float* cb = p.ml_conv_b + (size_t)l * 512 + col;
  f32x4 w0[2], w1[2], w2[2], bb[2];
#pragma unroll
  for (int q = 0; q < 2; ++q) {
    w0[q] = *(const f32x4*)(cw + q * 4); w1[q] = *(const f32x4*)(cw + 512 + q * 4); w2[q] = *(const f32x4*)(cw + 1024 + q * 4);
    bb[q] = *(const f32x4*)(cb + q * 4);
  }
#pragma unroll
  for (int j = 0; j < 4; ++j) {
    const int q = j >> 1, e = (j & 1) * 2;
    float v0 = w0[q][e] * bflo(am[j]) + w1[q][e] * bflo(a0[j]) + w2[q][e] * bflo(ap[j]) + bb[q][e];
    float v1 = w0[q][e + 1] * bfhi(am[j]) + w1[q][e + 1] * bfhi(a0[j]) + w2[q][e + 1] * bfhi(ap[j]) + bb[q][e + 1];
    o[2 * j] = siluf_(v0) * scale;
    o[2 * j + 1] = siluf_(v1) * scale;
  }
}

DEV void ml_decode(int item, int& b, int& h, int& cidx, int& r0) {
  if (item < 512) { b = item >> 8; h = (item >> 6) & 3; cidx = item & 63; }
  else { int q = item - 512; b = q >> 3; h = (q >> 1) & 3; cidx = 64 + (q & 1); }
  r0 = cidx < 64 ? b * 8192 + cidx * 128 : 16384 + b * 256 + (cidx - 64) * 128;
}

DEV void mla_item(const P& p, int l, int item, char* smem) {
  const int tid = ltid(), lane = tid & 63, w = tid >> 6, r31 = lane & 31, hh = lane >> 5;
  int b, h, cidx, r0; ml_decode(item, b, h, cidx, r0);
  int s0, s1; seq_bounds(r0, s0, s1);
  const u16* PS = (const u16*)(p.ws + OFF_R1 + R1_PS);
  float* sG = (float*)smem;
  float* sRed = (float*)(smem + 4096);
  u16* sB = (u16*)(smem + 5120);
  u16* sA0 = sB + 64 * 136;
  u16* sA1 = sA0 + 64 * 136;
  ml_gates(p, l, h, r0, sG);
  {
    int d = tid >> 7, s = tid & 127;
    float wd = d == 0 ? __expf(sG[2 * 128 + 127] - sG[2 * 128 + s] + sG[s]) : __expf(sG[3 * 128] - sG[3 * 128 + s] + sG[128 + s]);
    sG[(6 + d) * 128 + s] = wd;
  }
  __syncthreads();
  {
    int s = tid & 127, cgh = tid >> 7;
    float w0 = sG[6 * 128 + s], w1 = sG[7 * 128 + s];
    for (int i = 0; i < 4; ++i) {
      int cg_ = cgh * 4 + i;
      float o[8];
      ml_conv8(p, l, PS, r0 + s, s0, s1, 256 + h * 64 + cg_ * 8, 1.f, o);
#pragma unroll
      for (int j = 0; j < 8; ++j) sB[(cg_ * 8 + j) * 136 + s] = f2bf(o[j]);
      u32x4 u = *(const u32x4*)(PS + (size_t)(r0 + s) * PSW + 512 + h * 64 + cg_ * 8);
#pragma unroll
      for (int e = 0; e < 4; ++e) {
        float v0 = bflo(u[e]), v1 = bfhi(u[e]);
        sA0[(cg_ * 8 + 2 * e) * 136 + s] = f2bf(w0 * v0);
        sA0[(cg_ * 8 + 2 * e + 1) * 136 + s] = f2bf(w0 * v1);
        sA1[(cg_ * 8 + 2 * e) * 136 + s] = f2bf(w1 * v0);
        sA1[(cg_ * 8 + 2 * e + 1) * 136 + s] = f2bf(w1 * v1);
      }
    }
  }
  __syncthreads();
  const int d = w >> 1, ni = w & 1;
  f32x16 acc[2][1];
#pragma unroll
  for (int mi = 0; mi < 2; ++mi)
#pragma unroll
    for (int i = 0; i < 16; ++i) acc[mi][0][i] = 0.f;
  mma_lds<2, 1>(d ? sA1 : sA0, 136, 0, sB, 136, ni * 32, 128, acc, lane);
  float* DC = (float*)(p.ws + OFF_R1 + R1_DC);
  {
    float* dst = DC + ((size_t)(((b * 4 + h) * 2 + d) * 66 + cidx)) * 4160;
#pragma unroll
    for (int mi = 0; mi < 2; ++mi)
#pragma unroll
      for (int i = 0; i < 16; ++i) dst[(mi * 32 + rowmap(i, hh)) * 64 + ni * 32 + r31] = acc[mi][0][i];
    if (cidx >= 64) {
      u16* CPb = (u16*)(p.ws + OFF_R1 + R1_CP) + (size_t)(((b * 4 + h) * 2 + d) * 66) * 4160;
      if ((d == 0) == (cidx == 64)) {
#pragma unroll
        for (int mi = 0; mi < 2; ++mi)
#pragma unroll
          for (int i = 0; i < 16; ++i) {
            const int e_ = (mi * 32 + rowmap(i, hh)) * 64 + ni * 32 + r31;
            CPb[(size_t)(cidx ^ 1) * 4160 + e_] = f2bf(acc[mi][0][i]);
            CPb[(size_t)cidx * 4160 + e_] = (u16)0;
          }
      }
    }
  }
  {
    int k = tid & 63, dd = (tid >> 6) & 1, half = tid >> 7;
    float s = 0;
    for (int j = half * 64; j < half * 64 + 64; ++j) s += sG[(6 + dd) * 128 + j] * bf2f(sB[k * 136 + j]);
    sRed[tid] = s;
  }
  __syncthreads();
  if (tid < 128) {
    int k = tid & 63, dd = tid >> 6;
    DC[((size_t)(((b * 4 + h) * 2 + dd) * 66 + cidx)) * 4160 + 64 * 64 + k] = sRed[tid] + sRed[tid + 128];
    if (cidx >= 64) {
      u16* CPb = (u16*)(p.ws + OFF_R1 + R1_CP) + (size_t)(((b * 4 + h) * 2 + dd) * 66) * 4160;
      if ((dd == 0) == (cidx == 64)) {
        CPb[(size_t)(cidx ^ 1) * 4160 + 64 * 64 + k] = f2bf(sRed[tid] + sRed[tid + 128]);
        CPb[(size_t)cidx * 4160 + 64 * 64 + k] = (u16)0;
      }
    }
  }
  if (tid == 0) {
    float* DEC = (float*)(p.ws + OFF_R1 + R1_DEC);
    DEC[((b * 4 + h) * 2 + 0) * 66 + cidx] = expf(sG[2 * 128 + 127]);
    DEC[((b * 4 + h) * 2 + 1) * 66 + cidx] = expf(sG[3 * 128]);
  }
  __syncthreads();
}

DEV void scan_item(const P& p, int item) {
  const int seq = item >> 2, quarter = item & 3, d = seq & 1;
  const float* DC = (const float*)(p.ws + OFF_R1 + R1_DC) + (size_t)seq * 66 * 4160;
  const float* DEC = (const float*)(p.ws + OFF_R1 + R1_DEC) + seq * 66;
  u16* CP = (u16*)(p.ws + OFF_R1 + R1_CP) + (size_t)seq * 66 * 4160;
  float st[5];
  int e[5];
  const int tid0 = ltid();
#pragma unroll
  for (int i = 0; i < 5; ++i) { st[i] = 0.f; int q = tid0 + i * 256; e[i] = q < 1040 ? quarter * 1040 + q : quarter * 1040; }
  const bool last_ok = tid0 + 4 * 256 < 1040;
  for (int s0 = 0; s0 < 66; s0 += 6) {
    float dc[6][5], dec[6];
    int cx[6];
#pragma unroll
    for (int u = 0; u < 6; ++u) {
      int step = s0 + u;
      cx[u] = d == 0 ? (step < 2 ? 64 + step : step - 2) : (step < 2 ? 65 - step : 63 - (step - 2));
      dec[u] = DEC[cx[u]];
#pragma unroll
      for (int i = 0; i < 5; ++i) dc[u][i] = DC[(size_t)cx[u] * 4160 + e[i]];
    }
#pragma unroll
    for (int u = 0; u < 6; ++u) {
#pragma unroll
      for (int i = 0; i < 5; ++i) {
        if ((i < 4 || last_ok) && s0 + u >= 2) CP[(size_t)cx[u] * 4160 + e[i]] = f2bf(st[i]);
        st[i] = dec[u] * st[i] + dc[u][i];
      }
    }
  }
}

DEV void mlc_item(const P& p, int l, int item, char* smem) {
  const int tid = ltid(), lane = tid & 63, w = tid >> 6, r31 = lane & 31, hh = lane >> 5;
  int b, h, cidx, r0; ml_decode(item, b, h, cidx, r0);
  int s0, s1; seq_bounds(r0, s0, s1);
  const u16* PS = (const u16*)(p.ws + OFF_R1 + R1_PS);
  float* sG = (float*)smem;
  float* sN = (float*)(smem + 4096);
  u16* sK = (u16*)(smem + 4608);
  u16* sQ = sK + 128 * 72;
  u16* sC = sQ;
  u16* sVT = sQ + 128 * 72;
  ml_gates(p, l, h, r0, sG);
  {
    int d = tid >> 7, s = tid & 127;
    sG[(6 + d) * 128 + s] = sG[d * 128 + s] - sG[(2 + d) * 128 + s];
  }
  {
    for (int i = 0; i < 4; ++i) {
      int ch = tid + i * 256, s = ch >> 3, cg_ = ch & 7;
      float o[8];
      ml_conv8(p, l, PS, r0 + s, s0, s1, 256 + h * 64 + cg_ * 8, 1.f, o);
      *(u32x4*)(sK + s * 72 + cg_ * 8) = u32x4{pack2(o[0], o[1]), pack2(o[2], o[3]), pack2(o[4], o[5]), pack2(o[6], o[7])};
      ml_conv8(p, l, PS, r0 + s, s0, s1, h * 64 + cg_ * 8, 0.125f, o);
      *(u32x4*)(sQ + s * 72 + cg_ * 8) = u32x4{pack2(o[0], o[1]), pack2(o[2], o[3]), pack2(o[4], o[5]), pack2(o[6], o[7])};
    }
    int s = tid & 127, cgh = tid >> 7;
    for (int i = 0; i < 4; ++i) {
      int cg_ = cgh * 4 + i;
      u32x4 u = *(const u32x4*)(PS + (size_t)(r0 + s) * PSW + 512 + h * 64 + cg_ * 8);
#pragma unroll
      for (int e = 0; e < 4; ++e) {
        sVT[(cg_ * 8 + 2 * e) * 136 + s] = (u16)(u[e] & 0xffff);
        sVT[(cg_ * 8 + 2 * e + 1) * 136 + s] = (u16)(u[e] >> 16);
      }
    }
  }
  __syncthreads();
  bf16x8 qf[4];
#pragma unroll
  for (int ks = 0; ks < 4; ++ks) qf[ks] = *(const bf16x8*)(sQ + (w * 32 + r31) * 72 + ks * 16 + hh * 8);
  __syncthreads();
  {
    const u16* CP = (const u16*)(p.ws + OFF_R1 + R1_CP);
    for (int d = 0; d < 2; ++d) {
      const u16* src = CP + ((size_t)(((b * 4 + h) * 2 + d) * 66 + cidx)) * 4160;
      for (int ch = tid; ch < 64 * 8; ch += 256) {
        int rr = ch >> 3, cc = ch & 7;
        *(u32x4*)(sC + (d * 64 + rr) * 72 + cc * 8) = *(const u32x4*)(src + rr * 64 + cc * 8);
      }
      if (tid < 64) sN[d * 64 + tid] = bf2f(src[64 * 64 + tid]);
    }
  }
  __syncthreads();
  const int qloc = w * 32 + r31;
  f32x16 Hs[2];
#pragma unroll
  for (int vt = 0; vt < 2; ++vt)
#pragma unroll
    for (int i = 0; i < 16; ++i) Hs[vt][i] = 0.f;
#pragma unroll 1
  for (int d = 0; d < 2; ++d) {
    f32x16 R[2];
#pragma unroll
    for (int vt = 0; vt < 2; ++vt) {
#pragma unroll
      for (int i = 0; i < 16; ++i) R[vt][i] = 0.f;
#pragma unroll
      for (int ks = 0; ks < 4; ++ks) {
        bf16x8 a = *(const bf16x8*)(sC + (d * 64 + vt * 32 + r31) * 72 + ks * 16 + hh * 8);
        R[vt] = mfma(a, qf[ks], R[vt]);
      }
    }
    float nq = 0.f;
#pragma unroll
    for (int ks = 0; ks < 4; ++ks)
#pragma unroll
      for (int j = 0; j < 8; ++j) nq += sN[d * 64 + ks * 16 + hh * 8 + j] * bf2f((u16)qf[ks][j]);
    nq = xsum32(nq);
    const float Bq = sG[(2 + d) * 128 + qloc];
    const float eb = __expf(Bq);
    const int sgn = d == 0 ? 1 : -1;
#pragma unroll
    for (int vt = 0; vt < 2; ++vt)
#pragma unroll
      for (int i = 0; i < 16; ++i) R[vt][i] *= eb;
    float den = 0.f;
#pragma unroll 1
    for (int kt = 0; kt < 4; ++kt) {
      f32x16 X;
#pragma unroll
      for (int i = 0; i < 16; ++i) X[i] = 0.f;
#pragma unroll
      for (int ks = 0; ks < 4; ++ks) {
        bf16x8 a = *(const bf16x8*)(sK + (kt * 32 + r31) * 72 + ks * 16 + hh * 8);
        X = mfma(a, qf[ks], X);
      }
      float pv[16];
#pragma unroll
      for (int i = 0; i < 16; ++i) {
        int key = kt * 32 + rowmap(i, hh);
        int tdiff = sgn * (qloc - key);
        float wgt = __expf(Bq + sG[(6 + d) * 128 + key] + (float)min(tdiff, 0) * 1e30f);
        pv[i] = X[i] * wgt;
        den += pv[i];
      }
#pragma unroll
      for (int s = 0; s < 2; ++s) {
        u32x4 pu = {pack2(pv[8 * s], pv[8 * s + 1]), pack2(pv[8 * s + 2], pv[8 * s + 3]), pack2(pv[8 * s + 4], pv[8 * s + 5]), pack2(pv[8 * s + 6], pv[8 * s + 7])};
        bf16x8 pf = __builtin_bit_cast(bf16x8, pu);
        const int ks2 = kt * 2 + s;
#pragma unroll
        for (int vt = 0; vt < 2; ++vt) {
          const u16* vp = sVT + (vt * 32 + r31) * 136 + 16 * ks2 + 4 * hh;
          u32x2 lo = *(const u32x2*)vp, hi = *(const u32x2*)(vp + 8);
          u32x4 au = {lo[0], lo[1], hi[0], hi[1]};
          R[vt] = mfma(__builtin_bit_cast(bf16x8, au), pf, R[vt]);
        }
      }
    }
    den = xsum32(den);
    den += eb * nq;
    float inv = 1.f / fmaxf(fabsf(den), 1.f);
#pragma unroll
    for (int vt = 0; vt < 2; ++vt)
#pragma unroll
      for (int i = 0; i < 16; ++i) Hs[vt][i] += R[vt][i] * inv;
  }
  float ss = 0;
#pragma unroll
  for (int vt = 0; vt < 2; ++vt)
#pragma unroll
    for (int i = 0; i < 16; ++i) ss += Hs[vt][i] * Hs[vt][i];
  ss = xsum32(ss);
  const float rs = rsqrtf(ss * (1.f / 64.f) + EPSV);
  u16* BR = (u16*)(p.ws + OFF_R2 + R2_BR);
  const int row = r0 + qloc;
#pragma unroll
  for (int vt = 0; vt < 2; ++vt)
#pragma unroll
    for (int i = 0; i < 16; ++i) {
      int v = vt * 32 + rowmap(i, hh);
      float o = bf2f(PS[(size_t)row * PSW + 768 + h * 64 + v]);
      float val = Hs[vt][i] * rs * p.ml_norm[l * 256 + h * 64 + v] * sigmoidf_(o);
      BR[(size_t)row * 1024 + h * 64 + v] = f2bf(val);
    }
  __syncthreads();
}

DEV void attn_item(const P& p, int l, int item, char* smem, float lam, float lam_init) {
  const int tid = ltid(), lane = tid & 63, w = tid >> 6, r31 = lane & 31, hh = lane >> 5;
  const int c = w & 1, qs = w >> 1;
  int b, h, q0, key0, ntile;
  if (item < 1024) { b = item >> 9; h = (item >> 7) & 3; q0 = (item & 127) * 64; key0 = 0; ntile = 132; }
  else { int q = item - 1024; b = q >> 4; h = (q >> 2) & 3; q0 = 8192 + (q & 3) * 64; key0 = 8192; ntile = 4; }
  const int bh = b * 4 + h;
  const u16* QR = (const u16*)(p.ws + OFF_R1 + R1_QR);
  const u16* KR = (const u16*)(p.ws + OFF_R1 + R1_KR);
  const u16* VT = (const u16*)(p.ws + OFF_R1 + R1_VT);
  bf16x8 qf[2];
  {
    const u16* qb = QR + ((size_t)(bh * 2 + c) * KPOS + q0 + qs * 32 + r31) * 32;
    qf[0] = *(const bf16x8*)(qb + hh * 8);
    qf[1] = *(const bf16x8*)(qb + 16 + hh * 8);
  }
  constexpr int KB = 16384, STG = 32768;
  const unsigned lbase = (unsigned)(size_t)smem + tid * 16;
  const u16* kp0 = KR + ((size_t)(bh * 2) * KPOS + key0 + (tid >> 2)) * 32 + ((tid & 3) ^ ((tid >> 4) & 3)) * 8;
  const u16* vp0 = VT + ((size_t)bh * 64 + (tid >> 4)) * KPOS + key0 + ((tid & 15) ^ ((tid >> 4) & 15)) * 8;
#define AGLDS(kt, stg)                                                                                            \
  {                                                                                                               \
    _Pragma("unroll") for (int i = 0; i < 4; ++i)                                                                 \
      __builtin_amdgcn_global_load_lds((const unsigned*)(kp0 + (size_t)(i >> 1) * KPOS * 32 + (size_t)((i & 1) * 64 + (kt) * 128) * 32), \
                                       (LAS unsigned*)(lbase + (stg) * STG + i * 4096), 16, 0, 0);                \
    _Pragma("unroll") for (int i = 0; i < 4; ++i)                                                                 \
      __builtin_amdgcn_global_load_lds((const unsigned*)(vp0 + (size_t)(i * 16) * KPOS + (kt) * 128),             \
                                       (LAS unsigned*)(lbase + (stg) * STG + KB + i * 4096), 16, 0, 0);           \
  }
  f32x16 O[2], NEGM;
#pragma unroll
  for (int i = 0; i < 16; ++i) { O[0][i] = 0.f; O[1][i] = 0.f; }
  float lsum = 0.f;
  {
    float qq = 0.f;
#pragma unroll
    for (int ks = 0; ks < 2; ++ks)
#pragma unroll
      for (int j = 0; j < 8; ++j) { float t = bf2f((u16)qf[ks][j]); qq += t * t; }
    qq = xsum32(qq);
    const float k2 = __uint_as_float(__hip_atomic_load((unsigned*)(p.ws + OFF_KMAX) + bh * 2 + c, __ATOMIC_RELAXED, __HIP_MEMORY_SCOPE_AGENT));
    const float mref = sqrtf(qq * k2) * 1.001f;
#pragma unroll
    for (int i = 0; i < 16; ++i) NEGM[i] = -mref;
  }
  const int nt2 = ntile >> 1;
  const int swk = (r31 >> 2) & 3, swv = r31 & 15;
  AGLDS(0, 0);
  asm volatile("s_waitcnt vmcnt(0)" ::: "memory");
  __builtin_amdgcn_s_barrier();
  for (int kt = 0; kt < nt2; ++kt) {
    if (kt + 1 < nt2) AGLDS(kt + 1, (kt + 1) & 1);
    __builtin_amdgcn_sched_barrier(0);
    const char* kb = smem + (kt & 1) * STG + c * 8192;
    const char* vb = smem + (kt & 1) * STG + KB;
    f32x16 X[4];
#pragma unroll
    for (int k2 = 0; k2 < 4; ++k2) {
      const char* kp_ = kb + (k2 * 32 + r31) * 64;
      X[k2] = mfma(*(const bf16x8*)(kp_ + ((hh) ^ swk) * 16), qf[0], NEGM);
      X[k2] = mfma(*(const bf16x8*)(kp_ + ((2 + hh) ^ swk) * 16), qf[1], X[k2]);
    }
    float ps = 0.f;
#pragma unroll
    for (int k2 = 0; k2 < 4; ++k2)
#pragma unroll
      for (int i = 0; i < 16; ++i) { float e = __builtin_amdgcn_exp2f(X[k2][i]); X[k2][i] = e; ps += e; }
    lsum += ps;
#pragma unroll
    for (int ks2 = 0; ks2 < 8; ++ks2) {
      const int k2 = ks2 >> 1, s_ = ks2 & 1;
      u32x4 pu = {pack2(X[k2][8 * s_], X[k2][8 * s_ + 1]), pack2(X[k2][8 * s_ + 2], X[k2][8 * s_ + 3]),
                  pack2(X[k2][8 * s_ + 4], X[k2][8 * s_ + 5]), pack2(X[k2][8 * s_ + 6], X[k2][8 * s_ + 7])};
      bf16x8 pf = __builtin_bit_cast(bf16x8, pu);
#pragma unroll
      for (int vt = 0; vt < 2; ++vt) {
        bf16x8 av = *(const bf16x8*)(vb + (vt * 32 + r31) * 256 + ((2 * ks2 + hh) ^ swv) * 16);
        O[vt] = mfma(av, pf, O[vt]);
      }
    }
    __builtin_amdgcn_sched_barrier(0);
    asm volatile("s_waitcnt vmcnt(0)" ::: "memory");
    __builtin_amdgcn_s_barrier();
  }
#undef AGLDS
  const float ltot = xsum32(lsum);
  const float inv = 1.f / ltot;
  float* sX = (float*)smem;
  if (c == 1) {
#pragma unroll
    for (int vt = 0; vt < 2; ++vt)
#pragma unroll
      for (int i = 0; i < 16; ++i) sX[(qs * 32 + vt * 16 + i) * 64 + lane] = O[vt][i] * inv * lam;
  }
  __syncthreads();
  if (c == 0) {
    float ss = 0.f;
#pragma unroll
    for (int vt = 0; vt < 2; ++vt)
#pragma unroll
      for (int i = 0; i < 16; ++i) { float o = O[vt][i] * inv - sX[(qs * 32 + vt * 16 + i) * 64 + lane]; O[vt][i] = o; ss += o * o; }
    ss = xsum32(ss);
    const float rs = rsqrtf(ss * (1.f / 64.f) + EPSV) * (1.f - lam_init);
    const int qpos = q0 + qs * 32 + r31;
    const int row = qpos < 8192 ? b * 8192 + qpos : 16384 + b * 256 + (qpos - 8192);
    u16* BR = (u16*)(p.ws + OFF_R2 + R2_BR);
#pragma unroll
    for (int vt = 0; vt < 2; ++vt)
#pragma unroll
      for (int i = 0; i < 16; ++i) {
        int v = vt * 32 + rowmap(i, hh);
        BR[(size_t)row * 1024 + 256 + h * 64 + v] = f2bf(O[vt][i] * rs * p.da_subln[l * 64 + v]);
      }
  }
  __syncthreads();
}

DEV void f2_item(const P& p, int item, char* smem) {
  const int tid = ltid(), lane = tid & 63, w = tid >> 6, r31 = lane & 31, hh = lane >> 5;
  int seq, g, s2, N1, base;
  if (item < 1024) { seq = item >> 9; g = (item >> 7) & 3; s2 = item & 127; N1 = 64; base = seq * 8192; }
  else { int q = item - 1024; seq = 2 + (q >> 9); g = (q >> 7) & 3; s2 = q & 127; N1 = 2; base = 16384 + (seq - 2) * 256; }
  const u16* PS = (const u16*)(p.ws + OFF_R1 + R1_PS);
  u16* sT = (u16*)smem;
  u16* sAB = (u16*)(smem + 9216);
  float* sEx = (float*)(smem + 9216 + 17408);
  for (int i = 0; i < 2; ++i) {
    int ch = tid + i * 256, s1 = ch >> 3, cc = ch & 7;
    u32x4 v = {0, 0, 0, 0};
    if (s1 < N1) v = *(const u32x4*)(PS + (size_t)(base + 128 * s1 + s2) * PSW + 1792 + g * 64 + cc * 8);
    *(u32x4*)(sT + s1 * 72 + cc * 8) = v;
  }
  __syncthreads();
  {
    const int mi = w & 1, nh = w >> 1;
    f32x16 a1[1][2];
#pragma unroll
    for (int ni = 0; ni < 2; ++ni)
#pragma unroll
      for (int i = 0; i < 16; ++i) a1[0][ni][i] = 0.f;
    mma_lds<1, 2>(sT, 72, mi * 32, (const u16*)(p.ws + OFF_TB1), 64, nh * 64, 64, a1, lane);
#pragma unroll
    for (int ni = 0; ni < 2; ++ni)
#pragma unroll
      for (int i = 0; i < 16; ++i) sAB[(ni * 32 + r31) * 136 + nh * 64 + mi * 32 + rowmap(i, hh)] = f2bf(a1[0][ni][i]);
  }
  __syncthreads();
  {
    f32x16 a2[1][2];
#pragma unroll
    for (int ni = 0; ni < 2; ++ni)
#pragma unroll
      for (int i = 0; i < 16; ++i) a2[0][ni][i] = 0.f;
    mma_lds<1, 2>((const u16*)(p.ws + (N1 == 64 ? OFF_TA264 : OFF_TA22)), 128, w * 32, sAB, 136, 0, 128, a2, lane);
#pragma unroll
    for (int ni = 0; ni < 2; ++ni)
#pragma unroll
      for (int i = 0; i < 16; ++i) sEx[(w * 32 + rowmap(i, hh)) * 65 + ni * 32 + r31] = a2[0][ni][i];
  }
  __syncthreads();
  {
    const float* TW = (const float*)(p.ws + OFF_TW);
    u16* XRE = (u16*)(p.ws + OFF_R1 + R1_XRE);
    u16* XIM = (u16*)(p.ws + OFF_R1 + R1_XIM);
    for (int i = 0; i < 16; ++i) {
      int e = tid + i * 256, ka = e >> 6, k2 = e & 63;
      if (ka < N1) {
        float re = sEx[ka * 65 + k2], im = sEx[(64 + ka) * 65 + k2];
        int idx = (ka * s2 * (N1 == 64 ? 1 : 32)) & 8191;
        float cs = TW[2 * idx], sn = TW[2 * idx + 1];
        size_t o = ((size_t)((seq * 4 + g) * 64 + ka) * 128 + s2) * 64 + k2;
        XRE[o] = f2bf(re * cs + im * sn);
        XIM[o] = f2bf(im * cs - re * sn);
      }
    }
  }
  __syncthreads();
}

DEV void f2ctx_item(const P& p, int item, char* smem) {
  const int tid = ltid(), lane = tid & 63, w = tid >> 6, r31 = lane & 31, hh = lane >> 5;
  const int seq = 2 + (item >> 4), g = (item >> 2) & 3, grp = item & 3, base = 16384 + (seq - 2) * 256;
  const u16* PS = (const u16*)(p.ws + OFF_R1 + R1_PS);
  u16* sT = (u16*)smem;
  float* sEx = (float*)(smem + 9216 + 17408);
  for (int i = 0; i < 2; ++i) {
    int ch = tid + i * 256, rr = ch >> 3, cc = ch & 7, s1 = rr >> 5, j = rr & 31;
    *(u32x4*)(sT + rr * 72 + cc * 8) = *(const u32x4*)(PS + (size_t)(base + 128 * s1 + grp * 32 + j) * PSW + 1792 + g * 64 + cc * 8);
  }
  __syncthreads();
  {
    const int mi = w & 1, nh = w >> 1;
    f32x16 a1[1][2];
#pragma unroll
    for (int ni = 0; ni < 2; ++ni)
#pragma unroll
      for (int i = 0; i < 16; ++i) a1[0][ni][i] = 0.f;
    mma_lds<1, 2>(sT, 72, mi * 32, (const u16*)(p.ws + OFF_TB1), 64, nh * 64, 64, a1, lane);
#pragma unroll
    for (int ni = 0; ni < 2; ++ni)
#pragma unroll
      for (int i = 0; i < 16; ++i) sEx[(mi * 32 + rowmap(i, hh)) * 130 + nh * 64 + ni * 32 + r31] = a1[0][ni][i];
  }
  __syncthreads();
  {
    const float* TW = (const float*)(p.ws + OFF_TW);
    u16* XRE = (u16*)(p.ws + OFF_R1 + R1_XRE);
    u16* XIM = (u16*)(p.ws + OFF_R1 + R1_XIM);
    for (int i = 0; i < 16; ++i) {
      int e = tid + i * 256, ka = e >> 11, j = (e >> 6) & 31, k2 = e & 63;
      int s2 = grp * 32 + j;
      float a0 = sEx[j * 130 + k2], b0 = sEx[j * 130 + 64 + k2], a1v = sEx[(32 + j) * 130 + k2], b1v = sEx[(32 + j) * 130 + 64 + k2];
      float re = ka ? a0 - a1v : a0 + a1v, im = ka ? b0 - b1v : b0 + b1v;
      int idx = (ka * s2 * 32) & 8191;
      float cs = TW[2 * idx], sn = TW[2 * idx + 1];
      size_t o = ((size_t)((seq * 4 + g) * 64 + ka) * 128 + s2) * 64 + k2;
      XRE[o] = f2bf(re * cs + im * sn);
      XIM[o] = f2bf(im * cs - re * sn);
    }
  }
  __syncthreads();
}

DEV void f3_item(const P& p, int item, char* smem) {
  const int tid = ltid(), lane = tid & 63, w = tid >> 6, r31 = lane & 31, hh = lane >> 5;
  int seq, g, ka, N1, base; float scale;
  if (item < 512) { seq = item >> 8; g = (item >> 6) & 3; ka = item & 63; N1 = 64; base = seq * 8192; scale = 1.f / 724.0773439350247f; }
  else { int q = item - 512; seq = 2 + (q >> 3); g = (q >> 1) & 3; ka = q & 1; N1 = 2; base = 16384 + (seq - 2) * 256; scale = 1.f / 128.f; }
  u16* sB = (u16*)smem;
  const u16* XRE = (const u16*)(p.ws + OFF_R1 + R1_XRE) + (size_t)((seq * 4 + g) * 64 + ka) * 128 * 64;
  const u16* XIM = (const u16*)(p.ws + OFF_R1 + R1_XIM) + (size_t)((seq * 4 + g) * 64 + ka) * 128 * 64;
  {
    int s2 = tid & 127, cgh = tid >> 7;
    for (int i = 0; i < 4; ++i) {
      int cg_ = cgh * 4 + i;
      u32x4 ur = *(const u32x4*)(XRE + s2 * 64 + cg_ * 8);
      u32x4 ui = *(const u32x4*)(XIM + s2 * 64 + cg_ * 8);
#pragma unroll
      for (int e = 0; e < 4; ++e) {
        sB[(cg_ * 8 + 2 * e) * 264 + s2] = (u16)(ur[e] & 0xffff);
        sB[(cg_ * 8 + 2 * e + 1) * 264 + s2] = (u16)(ur[e] >> 16);
        sB[(cg_ * 8 + 2 * e) * 264 + 128 + s2] = (u16)(ui[e] & 0xffff);
        sB[(cg_ * 8 + 2 * e + 1) * 264 + 128 + s2] = (u16)(ui[e] >> 16);
      }
    }
  }
  __syncthreads();
  f32x16 acc[1][2];
#pragma unroll
  for (int ni = 0; ni < 2; ++ni)
#pragma unroll
    for (int i = 0; i < 16; ++i) acc[0][ni][i] = 0.f;
  mma_lds<1, 2>((const u16*)(p.ws + OFF_TCS), 256, w * 32, sB, 264, 0, 256, acc, lane);
  u16* BR = (u16*)(p.ws + OFF_R2 + R2_BR);
#pragma unroll
  for (int ni = 0; ni < 2; ++ni)
#pragma unroll
    for (int i = 0; i < 16; ++i) {
      int kb = w * 32 + rowmap(i, hh), k2 = ni * 32 + r31;
      int row = base + ka + N1 * kb;
      BR[(size_t)row * 1024 + 512 + g * 64 + k2] = f2bf(acc[0][ni][i] * scale);
    }
  __syncthreads();
}

DEV void sgu_item(const P& p, int l, int item, char* smem) {
  const int tid = ltid(), lane = tid & 63, w = tid >> 6, r31 = lane & 31, hh = lane >> 5;
  const int tl = item >> 2, g = item & 3, r0 = tl * 128;
  const u16* PS = (const u16*)(p.ws + OFF_R1 + R1_PS);
  u16* sA = (u16*)smem;
  u16* sB = (u16*)(smem + 34816);
  float* sSt = (float*)(smem + 34816 + 17408);
  {
    int tok = tid >> 1, half = tid & 1;
    const u16* src = PS + (size_t)(r0 + tok) * PSW + 2304 + half * 128;
    float s = 0, sq = 0;
    for (int j = 0; j < 16; ++j) {
      u32x4 u = *(const u32x4*)(src + j * 8);
#pragma unroll
      for (int e = 0; e < 4; ++e) { float a = geluf_(bflo(u[e])), b2 = geluf_(bfhi(u[e])); s += a + b2; sq += a * a + b2 * b2; }
    }
    s += __shfl_xor(s, 1); sq += __shfl_xor(sq, 1);
    float mean = s * (1.f / 256.f);
    float var = fmaxf(sq * (1.f / 256.f) - mean * mean, 0.f);
    if (half == 0) { sSt[tok * 2] = mean; sSt[tok * 2 + 1] = rsqrtf(var + EPSV); }
  }
  __syncthreads();
  {
    int q = tid & 127, cgh = tid >> 7;
    float mean = sSt[q * 2], rstd = sSt[q * 2 + 1];
    for (int i = 0; i < 4; ++i) {
      int cg_ = cgh * 4 + i;
      u32x4 u = *(const u32x4*)(PS + (size_t)(r0 + q) * PSW + 2304 + g * 64 + cg_ * 8);
#pragma unroll
      for (int e = 0; e < 4; ++e) {
        int d0 = cg_ * 8 + 2 * e;
        float a = (geluf_(bflo(u[e])) - mean) * rstd * p.sg_norm[l * 256 + g * 64 + d0];
        float b2 = (geluf_(bfhi(u[e])) - mean) * rstd * p.sg_norm[l * 256 + g * 64 + d0 + 1];
        sB[d0 * 136 + q] = f2bf(a);
        sB[(d0 + 1) * 136 + q] = f2bf(b2);
      }
    }
    const float* W = p.sg_w + (size_t)(l * 4 + g) * 128 * 128;
    for (int i = 0; i < 8; ++i) {
      int pr = (tid >> 4) + 16 * i, cc = (tid & 15) * 8;
      f32x4 a = *(const f32x4*)(W + pr * 128 + cc), b2 = *(const f32x4*)(W + pr * 128 + cc + 4);
      *(u32x4*)(sA + pr * 136 + cc) = u32x4{pack2(a[0], a[1]), pack2(a[2], a[3]), pack2(b2[0], b2[1]), pack2(b2[2], b2[3])};
    }
  }
  __syncthreads();
  f32x16 acc[1][2];
#pragma unroll
  for (int ni = 0; ni < 2; ++ni)
#pragma unroll
    for (int i = 0; i < 16; ++i) acc[0][ni][i] = 0.f;
  mma_lds<1, 2>(sA, 136, w * 32, sB, 136, 0, 128, acc, lane);
  u16* BR = (u16*)(p.ws + OFF_R2 + R2_BR);
#pragma unroll
  for (int ni = 0; ni < 2; ++ni)
#pragma unroll
    for (int i = 0; i < 16; ++i) {
      int pp = w * 32 + rowmap(i, hh), d = ni * 32 + r31;
      float u = geluf_(bf2f(PS[(size_t)(r0 + pp) * PSW + 2048 + g * 64 + d]));
      float val = (acc[0][ni][i] + p.sg_b[(l * 4 + g) * 128 + pp]) * u;
      BR[(size_t)(r0 + pp) * 1024 + 768 + g * 64 + d] = f2bf(val);
    }
  __syncthreads();
}

__global__ void __launch_bounds__(256, 2) mega(P p) {
  extern __shared__ __attribute__((aligned(16))) char smem[];
  cg::grid_group grid = cg::this_grid();
  __shared__ unsigned xb_st[4];
  if (threadIdx.x < 4) xb_st[threadIdx.x] = 0u;
  __syncthreads();
  XcdBarrier xb = xcd_barrier_post((unsigned*)(p.ws + OFF_BAR), (volatile LAS unsigned*)xb_st);
  int phase = 0;
  const int bid = blockIdx.x, nb = gridDim.x;
#ifndef DUP
#define DUP 0
#endif
#define PH_BEGIN if (phase >= p.ph0 && phase < p.ph1) {
#define REP_BEGIN(kind) for (int rep_ = 0; rep_ < 1 + ((DUP >> (kind)) & 1); ++rep_) { if (rep_) xcd_barrier(xb);
#define REP_END }
#define PH_END } ++phase; if (p.coop) { if (p.coop == 2 && phase == 1) grid.sync(); else xcd_barrier(xb); }

  PH_BEGIN
  for (int it = bid; it < 768 + 21 + 4320; it += nb) {
    if (it < 768) mod_item(p, it, smem);
    else if (it < 789) tab_item(p, it - 768);
    else conv_item(p, 0, it - 789, smem);
  }
  PH_END
  PH_BEGIN
  for (int it = bid; it < NROW / 4; it += nb) rowpass_item(p, 0, 0, it);
  PH_END

  for (int l = 0; l < 4; ++l) {
    const float lam_init = 0.8f - 0.6f * expf(-0.3f * (float)l);
    const bool last = l == 3;
    PH_BEGIN
REP_BEGIN(0)
    banded(bid, nb, 132, 21, 7, [&](int mt, int nt) { gemm1_item(p, mt, nt, smem); });
REP_END
    PH_END
    PH_BEGIN
REP_BEGIN(1)
    for (int it = bid; it < 132 + 528 + 528 + 1024 + 32; it += nb) {
      if (it < 132) attnprep_item(p, it, smem);
      else if (it < 660) mla_item(p, l, it - 132, smem);
      else if (it < 1188) { if (!(last && it - 660 >= 512)) sgu_item(p, l, it - 660, smem); }
      else if (it < 2212) f2_item(p, it - 1188, smem);
      else if (!last) f2ctx_item(p, it - 2212, smem);
    }
REP_END
    PH_END
    PH_BEGIN
    {
      float s01 = 0.f, s23 = 0.f;
      for (int i = 0; i < 32; ++i) {
        s01 += p.da_lam[l * 128 + i] * p.da_lam[l * 128 + 32 + i];
        s23 += p.da_lam[l * 128 + 64 + i] * p.da_lam[l * 128 + 96 + i];
      }
      const float lam = expf(s01) - expf(s23) + lam_init;
      {
        const int x = bid & 7, j = bid >> 3, per = nb >> 3;
        for (int r_ = 0; r_ < 1 + ((DUP >> 2) & 1); ++r_) {
          for (int q = j; q < 128; q += per) attn_item(p, l, x * 128 + q, smem, lam, lam_init);
          if (!last) for (int q = j; q < 4; q += per) attn_item(p, l, 1024 + x * 4 + q, smem, lam, lam_init);
        }
      }
      if (!last) for (int it = bid - (nb - 16); it >= 0 && it < 16; it += nb) mlc_item(p, l, 512 + it, smem);
      for (int it = bid; it < 64 + 528; it += nb) {
        if (it < 64) { for (int r_ = 0; r_ < 1 + ((DUP >> 9) & 1); ++r_) scan_item(p, it); }
        else if (!(last && it - 64 >= 512)) { for (int r_ = 0; r_ < 1 + ((DUP >> 10) & 1); ++r_) f3_item(p, it - 64, smem); }
      }
    }
    PH_END
    PH_BEGIN
REP_BEGIN(3)
    for (int it = bid; it < 512; it += nb) mlc_item(p, l, it, smem);
REP_END
    PH_END
    PH_BEGIN
REP_BEGIN(4)
    banded(bid, nb, 128, 8, 8, [&](int mt, int nt) { merge_item<2>(p, mt, nt, smem); });
    if (!last) for (int it = bid; it < 64; it += nb) merge_item<1>(p, 128 + (it >> 4), it & 15, smem);
REP_END
    PH_END
    PH_BEGIN
REP_BEGIN(5)
    banded(bid, nb, 128, 8, 8, [&](int mt, int nt) { gemm_f32_big((const u16*)(p.ws + OFF_R2 + R2_Z), 1024, (const u16*)(p.ws + OFF_WT + WT_OUT), (float*)(p.ws + OFF_R1), mt, nt, smem); });
    if (!last) for (int it = bid; it < 64; it += nb)
      gemm_f32_small((const u16*)(p.ws + OFF_R2 + R2_Z), 1024, (const u16*)(p.ws + OFF_WT + WT_OUT), (float*)(p.ws + OFF_R1), it, smem);
REP_END
    PH_END
    PH_BEGIN
    for (int it = bid; it < NROW / 4; it += nb) rowpass_item(p, l, 1, it);
    PH_END
    PH_BEGIN
REP_BEGIN(6)
    banded(bid, nb, 67, 44, 11, [&](int mt, int nt) { upact_item(p, l, mt, nt, smem); });
REP_END
    PH_END
    PH_BEGIN
REP_BEGIN(8)
    banded(bid, nb, 128, 8, 8, [&](int mt, int nt) { gemm_f32_big((const u16*)(p.ws + OFF_R2), 2816, (const u16*)(p.ws + OFF_WT + WT_DOWN), (float*)(p.ws + OFF_R1), mt, nt, smem); });
    if (!last) for (int it = bid; it < 64; it += nb)
      gemm_f32_small((const u16*)(p.ws + OFF_R2), 2816, (const u16*)(p.ws + OFF_WT + WT_DOWN), (float*)(p.ws + OFF_R1), it, smem);
REP_END
    PH_END
    PH_BEGIN
    {
      const int nconv = l < 3 ? 4320 : 0;
      for (int it = bid; it < NROW / 4 + nconv; it += nb) {
        if (it < NROW / 4) rowpass_item(p, l, 2, it);
        else { for (int r_ = 0; r_ < 1 + ((DUP >> 11) & 1); ++r_) conv_item(p, l + 1, it - NROW / 4, smem); }
      }
    }
    PH_END
  }
}

extern "C" void kernel_launch(void* const* d_in, const int* in_sizes, int n_in, void* d_out, int out_size, void* d_ws, size_t ws_size,
                              hipStream_t stream) {
  static int grid_blocks = 0;
  if (!grid_blocks) {
    if (hipFuncSetAttribute((const void*)mega, hipFuncAttributeMaxDynamicSharedMemorySize, LDS_BYTES) != hipSuccess) {
      fprintf(stderr, "hipFuncSetAttribute failed\n");
    }
    int dev = 0, cus = 0, per_cu = 0;
    hipGetDevice(&dev);
    hipDeviceGetAttribute(&cus, hipDeviceAttributeMultiprocessorCount, dev);
    hipOccupancyMaxActiveBlocksPerMultiprocessor(&per_cu, (const void*)mega, 256, LDS_BYTES);
    if (per_cu > 2) per_cu = 2;
    if (per_cu < 1) per_cu = 1;
    grid_blocks = cus * per_cu;
  }
  P p{};
  const float** f = (const float**)&p;
  for (int i = 0; i < 23; ++i) f[i] = (const float*)d_in[i];
  p.out = (float*)d_out;
  p.ws = (char*)d_ws;
  p.ph0 = 0; p.ph1 = 1 << 30; p.coop = 1; p.pad = 0;
  hipMemsetAsync((char*)d_ws + OFF_BAR, 0, 16384, stream);
  void* args[] = {&p};
  hipError_t e = hipLaunchCooperativeKernel((const void*)mega, dim3(grid_blocks), dim3(256), args, LDS_BYTES, stream);
  if (e != hipSuccess) fprintf(stderr, "cooperative launch failed: %s (grid %d)\n", hipGetErrorString(e), grid_blocks);
}
```

```cpp
#include <hip/hip_runtime.h>
#include <hip/hip_cooperative_groups.h>
#include <stdint.h>
#include <stdio.h>
namespace cg = cooperative_groups;

typedef unsigned short u16;
typedef short bf16x8 __attribute__((ext_vector_type(8)));
typedef float f32x16 __attribute__((ext_vector_type(16)));
typedef unsigned int u32x4 __attribute__((ext_vector_type(4)));
typedef unsigned int u32x2 __attribute__((ext_vector_type(2)));
typedef float f32x4 __attribute__((ext_vector_type(4)));
#define DEV __device__ __forceinline__

constexpr int NROW = 16896;
constexpr int PSW = 2688;
constexpr int KPOS = 8448;
constexpr int LDS_BYTES = 73728;
constexpr float EPSV = 1e-6f;

constexpr size_t OFF_MOD = 0;
constexpr size_t OFF_TB1 = 294912;
constexpr size_t OFF_TA264 = OFF_TB1 + 16384;
constexpr size_t OFF_TA22 = OFF_TA264 + 32768;
constexpr size_t OFF_TCS = OFF_TA22 + 32768;
constexpr size_t OFF_TW = OFF_TCS + 65536;
constexpr size_t OFF_RT = OFF_TW + 65536;
constexpr size_t OFF_BAR = OFF_RT + 8192;
constexpr size_t OFF_KMAX = OFF_BAR + 15360;
constexpr size_t OFF_XC = OFF_BAR + 16384;
constexpr size_t OFF_H = OFF_XC + 2097152;
constexpr size_t OFF_WT = OFF_H + 34603008;
constexpr size_t WT_IN = 0;
constexpr size_t WT_BR = (size_t)6784 * 1024 * 2;
constexpr size_t WT_OUT = WT_BR + (size_t)4 * 1024 * 256 * 2;
constexpr size_t WT_UP = WT_OUT + (size_t)1024 * 1024 * 2;
constexpr size_t WT_DOWN = WT_UP + (size_t)5632 * 1024 * 2;
constexpr size_t WT_BYTES = WT_DOWN + (size_t)1024 * 2816 * 2;
constexpr size_t OFF_R1 = OFF_WT + WT_BYTES;
constexpr size_t R1_BYTES = (size_t)NROW * 5632 * 2;
constexpr size_t R1_PS = 0;
constexpr size_t R1_QR = (size_t)NROW * PSW * 2;
constexpr size_t R1_KR = R1_QR + 8650752;
constexpr size_t R1_VT = R1_KR + 8650752;
constexpr size_t R1_XRE = R1_VT + 8650752;
constexpr size_t R1_XIM = R1_XRE + 16777216;
constexpr size_t R1_DC = R1_XIM + 16777216;
constexpr size_t R1_DEC = R1_DC + (size_t)16 * 66 * 4160 * 4;
constexpr size_t R1_CP = R1_DEC + 8192;
constexpr size_t R1_END = R1_CP + (size_t)16 * 66 * 4160 * 2;
static_assert(R1_END <= R1_BYTES, "R1 overflow");
constexpr size_t OFF_R2 = OFF_R1 + R1_BYTES;
constexpr size_t R2_BR = 0;
constexpr size_t R2_Z = 34603008;

struct P {
  const float *x, *c, *ctx, *c_ctx, *w_ada, *b_ada, *norm_g, *w_in, *ml_conv_w, *ml_conv_b, *ml_gate_b, *ml_norm,
      *da_lam, *da_subln, *sg_norm, *sg_w, *sg_b, *w_branch, *w_out, *ffn_up, *ffn_conv_w, *ffn_conv_b, *ffn_down;
  float* out;
  char* ws;
  int ph0, ph1, coop, pad;
};

DEV int ltid() { int t = threadIdx.x; asm volatile("" : "+v"(t)); return t; }

#define XB_TMO      128
#define XB_XCNT(j)  (256  + 64 * (j))
#define XB_XSUB(j)  (1280 + 64 * (j))
#define XB_XGEN(j)  (2304 + 64 * (j))
#define XB_TOP      3328
#define XB_TOPGEN   3392
#define XCD_BAR_WORDS 3456
#define XB_SPIN_CAP (1u << 23)
#define LAS __attribute__((address_space(3)))
DEV unsigned xb_ld(unsigned* p) { return __hip_atomic_load(p, __ATOMIC_RELAXED, __HIP_MEMORY_SCOPE_AGENT); }
DEV unsigned xb_add(unsigned* p, unsigned v) { return __hip_atomic_fetch_add(p, v, __ATOMIC_RELAXED, __HIP_MEMORY_SCOPE_AGENT); }
DEV unsigned xb_xcc_id() { return (unsigned)__builtin_amdgcn_s_getreg((3 << 11) | 20) & 0xFu; }
#define XB_SPIN(cond, bar) do { unsigned _sp = 0; while (cond) { __builtin_amdgcn_s_sleep(1); \
    if ((++_sp & 255u) == 0u) { if (xb_ld(&(bar)[XB_TMO])) break; if (_sp > XB_SPIN_CAP) { atomicAdd(&(bar)[XB_TMO], 1u); break; } } } } while (0)
struct XcdBarrier { unsigned* bar; unsigned x; volatile LAS unsigned* st; };
DEV XcdBarrier xcd_barrier_post(unsigned* bar, volatile LAS unsigned* st) {
  XcdBarrier b; b.bar = bar; b.x = xb_xcc_id(); b.st = st;
  if (threadIdx.x == 0) (void)xb_add(&bar[XB_XCNT(b.x)], 1u);
  return b;
}
DEV void xcd_barrier_complete(unsigned* bar, unsigned x, unsigned& nloc, unsigned& nx) {
  const unsigned G = gridDim.x * gridDim.y * gridDim.z;
  unsigned sum, cnt, mine, sp = 0u;
  for (;;) {
    sum = 0u; cnt = 0u; mine = 0u;
#pragma unroll
    for (unsigned j = 0; j < 16; ++j) { const unsigned c = xb_ld(&bar[XB_XCNT(j)]); sum += c; cnt += (c > 0u) ? 1u : 0u; mine = (j == x) ? c : mine; }
    if (sum == G) break;
    __builtin_amdgcn_s_sleep(1);
    if ((++sp & 255u) == 0u) { if (xb_ld(&bar[XB_TMO])) break; if (sp > XB_SPIN_CAP) { atomicAdd(&bar[XB_TMO], 1u); break; } }
  }
  nloc = mine > 0u ? mine : 1u; nx = cnt > 0u ? cnt : 1u;
}
DEV void xcd_barrier(const XcdBarrier& b) {
  asm volatile("s_waitcnt vmcnt(0)" ::: "memory");
  __syncthreads();
  if (threadIdx.x == 0) {
    unsigned* bar = b.bar;
    __builtin_amdgcn_s_waitcnt(0);
    unsigned nloc = b.st[0], nx = b.st[1];
    if (nloc == 0u) { xcd_barrier_complete(bar, b.x, nloc, nx); b.st[0] = nloc; b.st[1] = nx; }
    const unsigned old = xb_add(&bar[XB_XSUB(b.x)], 1u);
    const unsigned gen = old / nloc;
    if (old + 1u == (gen + 1u) * nloc) {
      __builtin_amdgcn_fence(__ATOMIC_RELEASE, "agent");
      asm volatile("s_waitcnt vmcnt(0)" ::: "memory");
      const unsigned og = xb_add(&bar[XB_TOP], 1u);
      const unsigned tg = og / nx;
      if (og + 1u == (tg + 1u) * nx) xb_add(&bar[XB_TOPGEN], 1u);
      else XB_SPIN(xb_ld(&bar[XB_TOPGEN]) == tg, bar);
      __builtin_amdgcn_fence(__ATOMIC_ACQUIRE, "agent");
      xb_add(&bar[XB_XGEN(b.x)], 1u);
      asm volatile("s_waitcnt vmcnt(0)" ::: "memory");
    } else {
      XB_SPIN(xb_ld(&bar[XB_XGEN(b.x)]) == gen, bar);
      __builtin_amdgcn_fence(__ATOMIC_ACQUIRE, "agent");
      asm volatile("s_waitcnt vmcnt(0)" ::: "memory");
    }
  }
  __syncthreads();
}

DEV float bf2f(u16 h) { return __uint_as_float(((unsigned)h) << 16); }
typedef __bf16 hwbf16x2 __attribute__((ext_vector_type(2)));
typedef float f32x2 __attribute__((ext_vector_type(2)));
DEV unsigned pack2(float a, float b) { f32x2 v = {a, b}; hwbf16x2 r = __builtin_convertvector(v, hwbf16x2); return __builtin_bit_cast(unsigned, r); }
DEV u16 f2bf(float f) { return (u16)pack2(f, f); }
DEV float bflo(unsigned u) { return __uint_as_float(u << 16); }
DEV float bfhi(unsigned u) { return __uint_as_float(u & 0xffff0000u); }
DEV float sigmoidf_(float x) { return __builtin_amdgcn_rcpf(1.f + __expf(-x)); }
DEV float siluf_(float x) { return x * __builtin_amdgcn_rcpf(1.f + __expf(-x)); }
DEV float geluf_(float x) { return x * __builtin_amdgcn_rcpf(1.f + __expf(-1.5957691216057308f * (x + 0.044715f * x * x * x))); }
DEV float xmax32(float v) { auto r = __builtin_amdgcn_permlane32_swap(__float_as_uint(v), __float_as_uint(v), false, false); return fmaxf(__uint_as_float(r[0]), __uint_as_float(r[1])); }
DEV float xsum32(float v) { auto r = __builtin_amdgcn_permlane32_swap(__float_as_uint(v), __float_as_uint(v), false, false); return __uint_as_float(r[0]) + __uint_as_float(r[1]); }
DEV int rowmap(int i, int hh) { return (i & 3) + 8 * (i >> 2) + 4 * hh; }
DEV f32x16 mfma(bf16x8 a, bf16x8 b, f32x16 c) { return __builtin_amdgcn_mfma_f32_32x32x16_bf16(a, b, c, 0, 0, 0); }

template <int MI, int NI>
DEV void mma_lds(const u16* sA, int lda, int rowA0, const u16* sB, int ldb, int rowB0, int K, f32x16 (&acc)[MI][NI], int lane) {
  const int r = lane & 31, h = lane >> 5;
  for (int k0 = 0; k0 < K; k0 += 16) {
    bf16x8 a[MI], b[NI];
#pragma unroll
    for (int mi = 0; mi < MI; ++mi) a[mi] = *(const bf16x8*)(sA + (size_t)(rowA0 + mi * 32 + r) * lda + k0 + h * 8);
#pragma unroll
    for (int ni = 0; ni < NI; ++ni) b[ni] = *(const bf16x8*)(sB + (size_t)(rowB0 + ni * 32 + r) * ldb + k0 + h * 8);
#pragma unroll
    for (int mi = 0; mi < MI; ++mi)
#pragma unroll
      for (int ni = 0; ni < NI; ++ni) acc[mi][ni] = mfma(a[mi], b[ni], acc[mi][ni]);
  }
}

DEV int rowmap16(int i, int lane) { return ((i >> 3) & 1) * 16 + (lane >> 4) * 4 + (i & 3); }
DEV int colmap16(int i, int lane) { return ((i >> 2) & 1) * 16 + (lane & 15); }
template <int NI>
DEV void gemm_main(const u16* __restrict__ A, int lda, const u16* __restrict__ Bt, int ldb, int K, f32x16 (&acc)[2][NI], char* smem, int bsplit = 0) {
  constexpr int ABYTES = 128 * 128, STG = ABYTES + NI * 64 * 128;
  const int tid = ltid(), lane = tid & 63, w = tid >> 6, wr = w >> 1, wc = w & 1;
  const int r15 = lane & 15, q4 = lane >> 4;
  const int nk = K / 64;
  const unsigned lbase = (unsigned)(size_t)smem + tid * 16;
  const int sw = (r15 >> 1) & 7;
  const int co = ((tid & 7) ^ ((tid >> 4) & 7)) * 8;
  const u16* Ap = A + (size_t)(tid >> 3) * lda + co;
  const u16* Bp = Bt + (size_t)(tid >> 3) * ldb + co;
  f32x4 c[4][NI * 2];
#pragma unroll
  for (int m = 0; m < 4; ++m)
#pragma unroll
    for (int n = 0; n < NI * 2; ++n)
#pragma unroll
      for (int j = 0; j < 4; ++j) c[m][n][j] = acc[m >> 1][n >> 1][((m & 1) * 2 + (n & 1)) * 4 + j];
#define GLDS(kt, stg)                                                                                             \
  {                                                                                                               \
    _Pragma("unroll") for (int i = 0; i < 4; ++i)                                                                 \
      __builtin_amdgcn_global_load_lds((const unsigned*)(Ap + (size_t)(i * 32) * lda + (kt) * 64), (LAS unsigned*)(lbase + (stg) * STG + i * 4096), 16, 0, 0); \
    _Pragma("unroll") for (int i = 0; i < NI * 2; ++i)                                                            \
      __builtin_amdgcn_global_load_lds((const unsigned*)(Bp + (size_t)(i * 32 + (i >= NI ? bsplit : 0)) * ldb + (kt) * 64), (LAS unsigned*)(lbase + (stg) * STG + ABYTES + i * 4096), 16, 0, 0); \
  }
  GLDS(0, 0);
  asm volatile("s_waitcnt vmcnt(0)" ::: "memory");
  __builtin_amdgcn_s_barrier();
  for (int kt = 0; kt < nk; ++kt) {
    if (kt + 1 < nk) GLDS(kt + 1, (kt + 1) & 1);
    __builtin_amdgcn_sched_barrier(0);
    const char* base = smem + (kt & 1) * STG;
#pragma unroll
    for (int kk = 0; kk < 2; ++kk) {
      bf16x8 a[4], b[NI * 2];
      const int so = ((kk * 4 + q4) ^ sw) * 16;
#pragma unroll
      for (int m = 0; m < 4; ++m) a[m] = *(const bf16x8*)(base + (wr * 64 + m * 16 + r15) * 128 + so);
#pragma unroll
      for (int n = 0; n < NI * 2; ++n) b[n] = *(const bf16x8*)(base + ABYTES + (wc * NI * 32 + n * 16 + r15) * 128 + so);
#pragma unroll
      for (int m = 0; m < 4; ++m)
#pragma unroll
        for (int n = 0; n < NI * 2; ++n) c[m][n] = __builtin_amdgcn_mfma_f32_16x16x32_bf16(a[m], b[n], c[m][n], 0, 0, 0);
    }
    __builtin_amdgcn_sched_barrier(0);
    asm volatile("s_waitcnt vmcnt(0)" ::: "memory");
    __builtin_amdgcn_s_barrier();
  }
#undef GLDS
#pragma unroll
  for (int m = 0; m < 4; ++m)
#pragma unroll
    for (int n = 0; n < NI * 2; ++n)
#pragma unroll
      for (int j = 0; j < 4; ++j) acc[m >> 1][n >> 1][((m & 1) * 2 + (n & 1)) * 4 + j] = c[m][n][j];
}

template <int NI>
DEV void zero_acc(f32x16 (&acc)[2][NI]) {
#pragma unroll
  for (int mi = 0; mi < 2; ++mi)
#pragma unroll
    for (int ni = 0; ni < NI; ++ni)
#pragma unroll
      for (int i = 0; i < 16; ++i) acc[mi][ni][i] = 0.f;
}

DEV void gemm_big_p(const u16* const (&Ap)[4], const u16* const (&Bp)[2], int K, f32x16 (&acc)[4][2], char* smem) {
  constexpr int ABYTES = 256 * 64, STG = ABYTES + 128 * 64;
  const int tid = ltid(), lane = tid & 63, w = tid >> 6, wr = w >> 1, wc = w & 1;
  const int r15 = lane & 15, q4 = lane >> 4;
  const int nk = K / 32;
  const unsigned lbase = (unsigned)(size_t)smem + tid * 16;
  const int so = (q4 ^ ((0x78 >> (((r15 >> 2) & 3) * 2)) & 3)) * 16;
  f32x4 c[8][4];
#pragma unroll
  for (int m = 0; m < 8; ++m)
#pragma unroll
    for (int n = 0; n < 4; ++n)
#pragma unroll
      for (int j = 0; j < 4; ++j) c[m][n][j] = acc[m >> 1][n >> 1][((m & 1) * 2 + (n & 1)) * 4 + j];
#define GLDS(kt, stg)                                                                                             \
  {                                                                                                               \
    _Pragma("unroll") for (int i = 0; i < 4; ++i)                                                                 \
      __builtin_amdgcn_global_load_lds((const unsigned*)(Ap[i] + (kt) * 32), (LAS unsigned*)(lbase + (stg) * STG + i * 4096), 16, 0, 0); \
    _Pragma("unroll") for (int i = 0; i < 2; ++i)                                                                 \
      __builtin_amdgcn_global_load_lds((const unsigned*)(Bp[i] + (kt) * 32), (LAS unsigned*)(lbase + (stg) * STG + ABYTES + i * 4096), 16, 0, 0); \
  }
  GLDS(0, 0);
  if (nk > 1) { GLDS(1, 1); asm volatile("s_waitcnt vmcnt(6)" ::: "memory"); }
  else asm volatile("s_waitcnt vmcnt(0)" ::: "memory");
  __builtin_amdgcn_s_barrier();
  int cur = 0;
  for (int kt = 0; kt < nk; ++kt) {
    int nxt2 = cur + 2; if (nxt2 >= 3) nxt2 -= 3;
    if (kt + 2 < nk) GLDS(kt + 2, nxt2);
    __builtin_amdgcn_sched_barrier(0);
    const char* base = smem + cur * STG;
    {
      bf16x8 a[8], b[4];
#pragma unroll
      for (int m = 0; m < 8; ++m) a[m] = *(const bf16x8*)(base + (wr * 128 + m * 16 + r15) * 64 + so);
#pragma unroll
      for (int n = 0; n < 4; ++n) b[n] = *(const bf16x8*)(base + ABYTES + (wc * 64 + n * 16 + r15) * 64 + so);
#pragma unroll
      for (int m = 0; m < 8; ++m)
#pragma unroll
        for (int n = 0; n < 4; ++n) c[m][n] = __builtin_amdgcn_mfma_f32_16x16x32_bf16(a[m], b[n], c[m][n], 0, 0, 0);
    }
    __builtin_amdgcn_sched_barrier(0);
    if (kt + 2 < nk) asm volatile("s_waitcnt vmcnt(6)" ::: "memory");
    else asm volatile("s_waitcnt vmcnt(0)" ::: "memory");
    __builtin_amdgcn_s_barrier();
    cur = cur + 1 == 3 ? 0 : cur + 1;
  }
#undef GLDS
#pragma unroll
  for (int m = 0; m < 8; ++m)
#pragma unroll
    for (int n = 0; n < 4; ++n)
#pragma unroll
      for (int j = 0; j < 4; ++j) acc[m >> 1][n >> 1][((m & 1) * 2 + (n & 1)) * 4 + j] = c[m][n][j];
}
DEV void gemm_big(const u16* __restrict__ A, int lda, const u16* __restrict__ Bt, int ldb, int K, f32x16 (&acc)[4][2], char* smem) {
  const int tid = ltid();
  const int co = ((tid & 3) ^ ((0x78 >> (((tid >> 4) & 3) * 2)) & 3)) * 8;
  const u16* a0 = A + (size_t)(tid >> 2) * lda + co;
  const u16* b0 = Bt + (size_t)(tid >> 2) * ldb + co;
  const u16* const Ap[4] = {a0, a0 + (size_t)64 * lda, a0 + (size_t)128 * lda, a0 + (size_t)192 * lda};
  const u16* const Bp[2] = {b0, b0 + (size_t)64 * ldb};
  gemm_big_p(Ap, Bp, K, acc, smem);
}
DEV void zero_big(f32x16 (&acc)[4][2]) {
#pragma unroll
  for (int mi = 0; mi < 4; ++mi)
#pragma unroll
    for (int ni = 0; ni < 2; ++ni)
#pragma unroll
      for (int i = 0; i < 16; ++i) acc[mi][ni][i] = 0.f;
}
template <class F>
DEV void banded(int bid, int nb, int MT, int NT, int W, F f) {
  const int TOT = MT * NT, x = bid & 7, j = bid >> 3, per = nb >> 3, chunk = (TOT + 7) >> 3;
  for (int q = j; q < chunk; q += per) {
    int t = x * chunk + q;
    if (t >= TOT) break;
    int band = t / (MT * W), r = t - band * MT * W;
    int mt = r / W, nt = band * W + r - mt * W;
    f(mt, nt);
  }
}

DEV void mod_item(const P& p, int item, char* smem) {
  float* sS = (float*)smem;
  float* sR = sS + 3072;
  const int tid = ltid();
  for (int i = tid; i < 3072; i += 256) {
    int v = i >> 10, k = i & 1023;
    float c = v < 2 ? p.c[v * 1024 + k] : p.c_ctx[k];
    sS[i] = c * __builtin_amdgcn_rcpf(1.f + __expf(-c));
  }
  __syncthreads();
  const int l = item / 192, cgp = item % 192, cc = tid & 31, col = cgp * 32 + cc, kq = tid >> 5;
  const float* w = p.w_ada + (size_t)l * 1024 * 6144 + col;
  float a0 = 0, a1 = 0, a2 = 0;
#pragma unroll 16
  for (int k = kq * 128; k < kq * 128 + 128; ++k) {
    float wv = w[(size_t)k * 6144];
    a0 += sS[k] * wv; a1 += sS[1024 + k] * wv; a2 += sS[2048 + k] * wv;
  }
  sR[(kq * 3 + 0) * 32 + cc] = a0;
  sR[(kq * 3 + 1) * 32 + cc] = a1;
  sR[(kq * 3 + 2) * 32 + cc] = a2;
  __syncthreads();
  if (tid < 96) {
    int v = tid >> 5, c2 = tid & 31;
    float s_ = 0;
    for (int q = 0; q < 8; ++q) s_ += sR[(q * 3 + v) * 32 + c2];
    int col2 = cgp * 32 + c2;
    ((float*)(p.ws + OFF_MOD))[(l * 3 + v) * 6144 + col2] = s_ + p.b_ada[l * 6144 + col2];
  }
  __syncthreads();
}

DEV void tab_item(const P& p, int item) {
  u16* TB1 = (u16*)(p.ws + OFF_TB1);
  u16* TA264 = (u16*)(p.ws + OFF_TA264);
  u16* TA22 = (u16*)(p.ws + OFF_TA22);
  u16* TCS = (u16*)(p.ws + OFF_TCS);
  float* TW = (float*)(p.ws + OFF_TW);
  float* RT = (float*)(p.ws + OFF_RT);
  const int tid0 = ltid();
  for (int i = 0; i < 16; ++i) {
    int e = item * 4096 + i * 256 + tid0;
    float s, c;
    if (e < 8192) {
      int n = e >> 6, d = e & 63, m = ((n & 63) * d) & 63;
      sincospif(m / 32.f, &s, &c);
      TB1[e] = f2bf(n < 64 ? c : -s);
    } else if (e < 24576) {
      int q = e - 8192, r = q >> 7, j = q & 127, ka = r & 63, s1 = j & 63, m = (ka * s1) & 63;
      sincospif(m / 32.f, &s, &c);
      bool im = r >= 64, sec = j >= 64;
      float v = !im ? (sec ? s : c) : (sec ? c : -s);
      TA264[q] = f2bf(v);
    } else if (e < 40960) {
      int q = e - 24576, r = q >> 7, j = q & 127, ka = r & 63, s1 = j & 63;
      bool im = r >= 64, sec = j >= 64;
      float v = 0.f;
      if (ka < 2 && s1 < 2 && (im == sec)) v = (ka & s1) ? -1.f : 1.f;
      TA22[q] = f2bf(v);
    } else if (e < 73728) {
      int q = e - 40960, kb = q >> 8, j = q & 255, s2 = j & 127, m = (kb * s2) & 127;
      sincospif(m / 64.f, &s, &c);
      TCS[q] = f2bf(j < 128 ? c : s);
    } else if (e < 81920) {
      int q = e - 73728;
      sincospif(q / 4096.f, &s, &c);
      TW[2 * q] = c; TW[2 * q + 1] = s;
    } else if (e < 82944) {
      int q = e - 81920, pos = q >> 3, fi = q & 7;
      float fr = exp2f(-(float)fi * 0.125f * 13.287712379549449f);
      float ang = (float)pos * fr;
      double t = (double)ang * 0.3183098861837907;
      t -= 2.0 * floor(t * 0.5);
      sincospif((float)t, &s, &c);
      RT[2 * q] = c; RT[2 * q + 1] = s;
    }
  }
}

DEV void conv_item(const P& p, int l, int item, char* smem) {
  float* tile = (float*)smem;
  const int tid = ltid();
  char* WT = p.ws + OFF_WT;
  const float* src; u16* dst; int K, Nsrc, kt, nt, mode = 0;
  if (item < 1696) { src = p.w_in + (size_t)l * 1024 * 6672; K = 1024; Nsrc = 6672; dst = (u16*)(WT + WT_IN); kt = item % 16; nt = item / 16; mode = 1; }
  else if (item < 1952) { int q = item - 1696; int g = q >> 6; q &= 63; src = p.w_branch + (size_t)(l * 4 + g) * 256 * 1024; K = 256; Nsrc = 1024; dst = (u16*)(WT + WT_BR) + (size_t)g * 1024 * 256; kt = q % 4; nt = q / 4; }
  else if (item < 2208) { int q = item - 1952; src = p.w_out + (size_t)l * 1024 * 1024; K = 1024; Nsrc = 1024; dst = (u16*)(WT + WT_OUT); kt = q % 16; nt = q / 16; }
  else if (item < 3616) { int q = item - 2208; src = p.ffn_up + (size_t)l * 1024 * 5632; K = 1024; Nsrc = 5632; dst = (u16*)(WT + WT_UP); kt = q % 16; nt = q / 16; }
  else { int q = item - 3616; src = p.ffn_down + (size_t)l * 2816 * 1024; K = 2816; Nsrc = 1024; dst = (u16*)(WT + WT_DOWN); kt = q % 44; nt = q / 44; }
  int nd = nt * 64 + (tid & 15) * 4, ns = nd; bool valid = true;
  if (mode) {
    if (nd < 1024) ns = nd;
    else if (nd < 2560) ns = nd + 16;
    else if (nd < 2576) ns = 1024 + nd - 2560;
    else if (nd < 2688) valid = false;
    else ns = nd - 112;
  }
#pragma unroll
  for (int i = 0; i < 4; ++i) {
    int kk = (tid >> 4) + 16 * i;
    f32x4 v = {0.f, 0.f, 0.f, 0.f};
    if (valid) v = *(const f32x4*)(src + (size_t)(kt * 64 + kk) * Nsrc + ns);
    float* t = tile + kk * 65 + (tid & 15) * 4;
    t[0] = v[0]; t[1] = v[1]; t[2] = v[2]; t[3] = v[3];
  }
  __syncthreads();
  const int n = tid >> 2, kq = tid & 3;
  unsigned pk[8];
#pragma unroll
  for (int j = 0; j < 8; ++j) pk[j] = pack2(tile[(kq * 16 + 2 * j) * 65 + n], tile[(kq * 16 + 2 * j + 1) * 65 + n]);
  u32x4* d = (u32x4*)(dst + (size_t)(nt * 64 + n) * K + kt * 64 + kq * 16);
  d[0] = u32x4{pk[0], pk[1], pk[2], pk[3]};
  d[1] = u32x4{pk[4], pk[5], pk[6], pk[7]};
  __syncthreads();
}

DEV float dpp_add(float v, int ctrl_is) { return v; }
DEV float wave_sum(float v) {
  int x = __float_as_int(v);
  v += __int_as_float(__builtin_amdgcn_update_dpp(0, x, 0xB1, 0xF, 0xF, true));
  x = __float_as_int(v);
  v += __int_as_float(__builtin_amdgcn_update_dpp(0, x, 0x4E, 0xF, 0xF, true));
  x = __float_as_int(v);
  v += __int_as_float(__builtin_amdgcn_update_dpp(0, x, 0x141, 0xF, 0xF, true));
  x = __float_as_int(v);
  v += __int_as_float(__builtin_amdgcn_update_dpp(0, x, 0x140, 0xF, 0xF, true));
  x = __float_as_int(v);
  return __int_as_float(__builtin_amdgcn_readlane(x, 0)) + __int_as_float(__builtin_amdgcn_readlane(x, 16)) +
         __int_as_float(__builtin_amdgcn_readlane(x, 32)) + __int_as_float(__builtin_amdgcn_readlane(x, 48));
}

DEV void rowpass_item(const P& p, int l, int mode, int item) {
  const int tid0 = ltid(); const int w = tid0 >> 6, lane = tid0 & 63, r = item * 4 + w;
  const int vec = r < 8192 ? 0 : (r < 16384 ? 1 : 2);
  float* X = r < 16384 ? p.out + (size_t)r * 1024 : (float*)(p.ws + OFF_XC) + (size_t)(r - 16384) * 1024;
  const float* MOD = (const float*)(p.ws + OFF_MOD);
  const int lh = (mode == 2) ? l + 1 : l;
  const bool doh = lh < 4;
  const int lhc = doh ? lh : 3;
  const float* xsrc = mode == 0 ? (r < 16384 ? p.x + (size_t)r * 1024 : p.ctx + (size_t)(r - 16384) * 1024) : X;
  const float* Y = (const float*)(p.ws + OFF_R1) + (size_t)r * 1024;
  const float* gate = MOD + (size_t)(l * 3 + vec) * 6144 + (mode == 1 ? 2 : 5) * 1024;
  const float* gp = p.norm_g + (size_t)(l * 4 + (mode == 1 ? 1 : 3)) * 1024;
  const float* g = p.norm_g + (size_t)(lhc * 4 + (mode == 1 ? 2 : 0)) * 1024;
  const float* sc = MOD + (size_t)(lhc * 3 + vec) * 6144 + (mode == 1 ? 4 : 1) * 1024;
  const float* sh = MOD + (size_t)(lhc * 3 + vec) * 6144 + (mode == 1 ? 3 : 0) * 1024;
  f32x4 xq[4], yq[4], gq[4], nq[4], hq[4], s1q[4], s0q[4];
#pragma unroll
  for (int i = 0; i < 4; ++i) {
    xq[i] = *(const f32x4*)(xsrc + i * 256 + lane * 4);
    if (mode != 0) {
      yq[i] = *(const f32x4*)(Y + i * 256 + lane * 4);
      gq[i] = *(const f32x4*)(gate + i * 256 + lane * 4);
      nq[i] = *(const f32x4*)(gp + i * 256 + lane * 4);
    }
    hq[i] = *(const f32x4*)(g + i * 256 + lane * 4);
    s1q[i] = *(const f32x4*)(sc + i * 256 + lane * 4);
    s0q[i] = *(const f32x4*)(sh + i * 256 + lane * 4);
  }
  if (mode != 0) {
    float ss = 0;
#pragma unroll
    for (int i = 0; i < 4; ++i)
#pragma unroll
      for (int j = 0; j < 4; ++j) ss += yq[i][j] * yq[i][j];
    ss = wave_sum(ss);
    const float rs = rsqrtf(ss * (1.f / 1024.f) + EPSV);
#pragma unroll
    for (int i = 0; i < 4; ++i)
#pragma unroll
      for (int j = 0; j < 4; ++j) xq[i][j] += gq[i][j] * (yq[i][j] * rs * nq[i][j]);
  }
#pragma unroll
  for (int i = 0; i < 4; ++i) *(f32x4*)(X + i * 256 + lane * 4) = xq[i];
  if (doh) {
    float ss = 0;
#pragma unroll
    for (int i = 0; i < 4; ++i)
#pragma unroll
      for (int j = 0; j < 4; ++j) ss += xq[i][j] * xq[i][j];
    ss = wave_sum(ss);
    const float rs = rsqrtf(ss * (1.f / 1024.f) + EPSV);
    u16* H = (u16*)(p.ws + OFF_H) + (size_t)r * 1024;
#pragma unroll
    for (int i = 0; i < 4; ++i) {
      float h0 = xq[i][0] * rs * hq[i][0] * (1.f + s1q[i][0]) + s0q[i][0];
      float h1 = xq[i][1] * rs * hq[i][1] * (1.f + s1q[i][1]) + s0q[i][1];
      float h2 = xq[i][2] * rs * hq[i][2] * (1.f + s1q[i][2]) + s0q[i][2];
      float h3 = xq[i][3] * rs * hq[i][3] * (1.f + s1q[i][3]) + s0q[i][3];
      *(u32x2*)(H + i * 256 + lane * 4) = u32x2{pack2(h0, h1), pack2(h2, h3)};
    }
  }
}

DEV void gemm1_item(const P& p, int mt, int nt, char* smem) {
  f32x16 acc[2][2]; zero_acc<2>(acc);
  gemm_main<2>((const u16*)(p.ws + OFF_H) + (size_t)mt * 128 * 1024, 1024, (const u16*)(p.ws + OFF_WT + WT_IN) + (size_t)nt * 128 * 1024, 1024, 1024, acc, smem);
  const int tid0 = ltid(); const int lane = tid0 & 63, w = tid0 >> 6, wr = w >> 1, wc = w & 1, r31 = lane & 31, hh = lane >> 5;
  u16* PS = (u16*)(p.ws + OFF_R1 + R1_PS);
#pragma unroll
  for (int mi = 0; mi < 2; ++mi)
#pragma unroll
    for (int ni = 0; ni < 2; ++ni)
#pragma unroll
      for (int i = 0; i < 16; ++i) {
        int row = mt * 128 + wr * 64 + mi * 32 + rowmap16(i, lane), col = nt * 128 + wc * 64 + ni * 32 + colmap16(i, lane);
        PS[(size_t)row * PSW + col] = f2bf(acc[mi][ni][i]);
      }
}

template <int NI>
DEV void merge_item(const P& p, int mt, int nt, char* smem) {
  f32x16 z[2][NI]; zero_acc<NI>(z);
  const u16* H = (const u16*)(p.ws + OFF_H) + (size_t)mt * 128 * 1024;
  const u16* BR = (const u16*)(p.ws + OFF_R2 + R2_BR) + (size_t)mt * 128 * 1024;
  const u16* WinT = (const u16*)(p.ws + OFF_WT + WT_IN);
  const u16* WbrT = (const u16*)(p.ws + OFF_WT + WT_BR);
#pragma unroll 1
  for (int g = 0; g < 4; ++g) {
    unsigned yp[2][NI][8];
    {
      f32x16 ay[2][NI]; zero_acc<NI>(ay);
      gemm_main<NI>(BR + g * 256, 1024, WbrT + (size_t)(g * 1024 + nt * NI * 64) * 256, 256, 256, ay, smem);
#pragma unroll
      for (int mi = 0; mi < 2; ++mi)
#pragma unroll
        for (int ni = 0; ni < NI; ++ni)
#pragma unroll
          for (int j = 0; j < 8; ++j) yp[mi][ni][j] = pack2(ay[mi][ni][2 * j], ay[mi][ni][2 * j + 1]);
      __builtin_amdgcn_sched_barrier(0);
    }
    f32x16 ag[2][NI]; zero_acc<NI>(ag);
    gemm_main<NI>(H, 1024, WinT + (size_t)(2688 + g * 1024 + nt * NI * 64) * 1024, 1024, 1024, ag, smem);
#pragma unroll
    for (int mi = 0; mi < 2; ++mi)
#pragma unroll
      for (int ni = 0; ni < NI; ++ni)
#pragma unroll
        for (int j = 0; j < 8; ++j) {
          const unsigned y2 = yp[mi][ni][j];
          z[mi][ni][2 * j] += sigmoidf_(ag[mi][ni][2 * j]) * bflo(y2);
          z[mi][ni][2 * j + 1] += sigmoidf_(ag[mi][ni][2 * j + 1]) * bfhi(y2);
        }
  }
  const int tid0 = ltid(); const int lane = tid0 & 63, w = tid0 >> 6, wr = w >> 1, wc = w & 1, r31 = lane & 31, hh = lane >> 5;
  u16* Z = (u16*)(p.ws + OFF_R2 + R2_Z);
#pragma unroll
  for (int mi = 0; mi < 2; ++mi)
#pragma unroll
    for (int ni = 0; ni < NI; ++ni)
#pragma unroll
      for (int i = 0; i < 16; ++i) {
        int row = mt * 128 + wr * 64 + mi * 32 + rowmap16(i, lane), col = nt * NI * 64 + wc * NI * 32 + ni * 32 + colmap16(i, lane);
        Z[(size_t)row * 1024 + col] = f2bf(z[mi][ni][i]);
      }
}

DEV void gemm_f32_big(const u16* A, int K, const u16* Bt, float* O, int mt, int nt, char* smem) {
  f32x16 acc[2][2]; zero_acc<2>(acc);
  gemm_main<2>(A + (size_t)mt * 128 * K, K, Bt + (size_t)nt * 128 * K, K, K, acc, smem);
  const int tid0 = ltid(); const int lane = tid0 & 63, w = tid0 >> 6, wr = w >> 1, wc = w & 1, r31 = lane & 31, hh = lane >> 5;
#pragma unroll
  for (int mi = 0; mi < 2; ++mi)
#pragma unroll
    for (int ni = 0; ni < 2; ++ni)
#pragma unroll
      for (int i = 0; i < 16; ++i) {
        int row = mt * 128 + wr * 64 + mi * 32 + rowmap16(i, lane), col = nt * 128 + wc * 64 + ni * 32 + colmap16(i, lane);
        O[(size_t)row * 1024 + col] = acc[mi][ni][i];
      }
}
DEV void gemm_f32_small(const u16* A, int K, const u16* Bt, float* O, int item, char* smem) {
  const int mt = item >> 4, nt = item & 15;
  f32x16 acc[2][1]; zero_acc<1>(acc);
  gemm_main<1>(A + (size_t)(16384 + mt * 128) * K, K, Bt + (size_t)nt * 64 * K, K, K, acc, smem);
  const int tid0 = ltid(); const int lane = tid0 & 63, w = tid0 >> 6, wr = w >> 1, wc = w & 1, r31 = lane & 31, hh = lane >> 5;
#pragma unroll
  for (int mi = 0; mi < 2; ++mi)
#pragma unroll
    for (int i = 0; i < 16; ++i) {
      int row = 16384 + mt * 128 + wr * 64 + mi * 32 + rowmap16(i, lane), col = nt * 64 + wc * 32 + colmap16(i, lane);
      O[(size_t)row * 1024 + col] = acc[mi][0][i];
    }
}

DEV void seq_bounds(int r, int& s0, int& s1) {
  if (r < 16384) { s0 = r & ~8191; s1 = s0 + 8192; } else { s0 = 16384 + ((r - 16384) & ~255); s1 = s0 + 256; }
}

DEV void upact_item(const P& p, int l, int mt, int nt, char* smem) {
  const int tid = ltid();
  const int srow = mt * 254 - 1;
  const u16* H = (const u16*)(p.ws + OFF_H);
  const u16* W = (const u16*)(p.ws + OFF_WT + WT_UP);
  const u16* Ap[4];
#pragma unroll
  for (int i = 0; i < 4; ++i) {
    int gr = srow + (tid >> 2) + 64 * i;
    gr = gr < 0 ? 0 : (gr > NROW - 1 ? NROW - 1 : gr);
    Ap[i] = H + (size_t)gr * 1024 + ((tid & 3) ^ ((0x78 >> (((tid >> 4) & 3) * 2)) & 3)) * 8;
  }
  const int co = ((tid & 3) ^ ((0x78 >> (((tid >> 4) & 3) * 2)) & 3)) * 8;
  const u16* const Bp[2] = {W + (size_t)(nt * 64 + (tid >> 2)) * 1024 + co, W + (size_t)(2816 + nt * 64 + (tid >> 2)) * 1024 + co};
  f32x16 acc[4][2]; zero_big(acc);
  {
    const u16* const Ap2[4] = {Ap[0], Ap[1], Ap[2], Ap[3]};
    gemm_big_p(Ap2, Bp, 1024, acc, smem);
  }
  const int lane = tid & 63, w = tid >> 6, wr = w >> 1, wc = w & 1, r31 = lane & 31, hh = lane >> 5;
  u16* sU = (u16*)smem;
#pragma unroll
  for (int mi = 0; mi < 4; ++mi)
#pragma unroll
    for (int ni = 0; ni < 2; ++ni)
#pragma unroll
      for (int i = 0; i < 16; ++i) sU[(wr * 128 + mi * 32 + rowmap16(i, lane)) * 136 + wc * 64 + ni * 32 + colmap16(i, lane)] = f2bf(acc[mi][ni][i]);
  __syncthreads();
  const int cg_ = tid & 7, col = nt * 64 + cg_ * 8;
  const float* cw = p.ffn_conv_w + (size_t)l * 3 * 2816 + col;
  const float* cb = p.ffn_conv_b + (size_t)l * 2816 + col;
  float w0[8], w1[8], w2[8], bb[8];
#pragma unroll
  for (int q = 0; q < 2; ++q) {
    f32x4 t0 = *(const f32x4*)(cw + q * 4), t1 = *(const f32x4*)(cw + 2816 + q * 4), t2 = *(const f32x4*)(cw + 5632 + q * 4), t3 = *(const f32x4*)(cb + q * 4);
#pragma unroll
    for (int e = 0; e < 4; ++e) { w0[q * 4 + e] = t0[e]; w1[q * 4 + e] = t1[e]; w2[q * 4 + e] = t2[e]; bb[q * 4 + e] = t3[e]; }
  }
  u16* ACT = (u16*)(p.ws + OFF_R2);
  for (int k = 0; k < 8; ++k) {
    const int idx = tid + k * 256, rr = 1 + (idx >> 3);
    const int R = srow + rr;
    if (rr <= 254 && R < NROW) {
      int s0, s1; seq_bounds(R, s0, s1);
      const u32x4 z4 = {0, 0, 0, 0};
      const u32x4 am = (R - 1 >= s0) ? *(const u32x4*)(sU + (rr - 1) * 136 + cg_ * 8) : z4;
      const u32x4 a0 = *(const u32x4*)(sU + rr * 136 + cg_ * 8);
      const u32x4 ap = (R + 1 < s1) ? *(const u32x4*)(sU + (rr + 1) * 136 + cg_ * 8) : z4;
      const u32x4 gg = *(const u32x4*)(sU + rr * 136 + 64 + cg_ * 8);
      float o[8];
#pragma unroll
      for (int j = 0; j < 4; ++j) {
        float v0 = w0[2 * j] * bflo(am[j]) + w1[2 * j] * bflo(a0[j]) + w2[2 * j] * bflo(ap[j]) + bb[2 * j];
        float v1 = w0[2 * j + 1] * bfhi(am[j]) + w1[2 * j + 1] * bfhi(a0[j]) + w2[2 * j + 1] * bfhi(ap[j]) + bb[2 * j + 1];
        o[2 * j] = siluf_(v0) * bflo(gg[j]);
        o[2 * j + 1] = siluf_(v1) * bfhi(gg[j]);
      }
      *(u32x4*)(ACT + (size_t)R * 2816 + col) = u32x4{pack2(o[0], o[1]), pack2(o[2], o[3]), pack2(o[4], o[5]), pack2(o[6], o[7])};
    }
  }
  __syncthreads();
}

DEV void attnprep_item(const P& p, int tl, char* smem) {
  const int tid = ltid();
  const u16* PS = (const u16*)(p.ws + OFF_R1 + R1_PS);
  u16* QR = (u16*)(p.ws + OFF_R1 + R1_QR);
  u16* KR = (u16*)(p.ws + OFF_R1 + R1_KR);
  u16* VT = (u16*)(p.ws + OFF_R1 + R1_VT);
  const float* RT = (const float*)(p.ws + OFF_RT);
  const int r0 = tl * 128;
  const bool lat = r0 < 16384;
  const int b = lat ? (r0 >> 13) : ((r0 - 16384) >> 8);
  const int pos0 = lat ? (r0 & 8191) : 8192 + ((r0 - 16384) & 255);
  const float QS = 0.17677669529663687f * 1.4426950408889634f;
  unsigned* sKm = (unsigned*)(smem + 70656);
  if (tid < 8) sKm[tid] = 0u;
  __syncthreads();
  for (int it = 0; it < 4; ++it) {
    int task = tid + it * 256, tok = task >> 3, hc = task & 7, h = hc >> 1, c = hc & 1;
    int r = r0 + tok, pos = pos0 + tok;
    int rowi = (pos >> 6) & 127, coli = pos & 63;
    for (int qk = 0; qk < 2; ++qk) {
      const u16* src = PS + (size_t)r * PSW + (qk ? 1280 : 1024) + h * 64 + c * 32;
      float v[32];
#pragma unroll
      for (int j = 0; j < 4; ++j) {
        u32x4 u = *(const u32x4*)(src + j * 8);
#pragma unroll
        for (int e = 0; e < 4; ++e) { v[j * 8 + 2 * e] = bflo(u[e]); v[j * 8 + 2 * e + 1] = bfhi(u[e]); }
      }
      float o[32];
      if (lat) {
#pragma unroll
        for (int a = 0; a < 2; ++a) {
          int pa = a == 0 ? rowi : coli;
#pragma unroll
          for (int i = 0; i < 8; ++i) {
            float cs = RT[(pa * 8 + i) * 2], sn = RT[(pa * 8 + i) * 2 + 1];
            float x1 = v[a * 16 + i], x2 = v[a * 16 + 8 + i];
            o[a * 16 + i] = x1 * cs - x2 * sn;
            o[a * 16 + 8 + i] = x2 * cs + x1 * sn;
          }
        }
      } else {
#pragma unroll
        for (int i = 0; i < 32; ++i) o[i] = v[i];
      }
      const float sc = qk ? 1.f : QS;
      if (qk) {
        float ssk = 0.f;
#pragma unroll
        for (int i = 0; i < 32; ++i) { float t = bf2f(f2bf(o[i])); ssk += t * t; }
        ssk = fmaxf(ssk, __shfl_xor(ssk, 8)); ssk = fmaxf(ssk, __shfl_xor(ssk, 16)); ssk = fmaxf(ssk, __shfl_xor(ssk, 32));
        if ((tid & 63) < 8) atomicMax(&sKm[hc], __float_as_uint(ssk));
      }
      u16* dst = (qk ? KR : QR) + ((size_t)((b * 4 + h) * 2 + c) * KPOS + pos) * 32;
#pragma unroll
      for (int j = 0; j < 4; ++j)
        *(u32x4*)(dst + j * 8) = u32x4{pack2(o[j * 8] * sc, o[j * 8 + 1] * sc), pack2(o[j * 8 + 2] * sc, o[j * 8 + 3] * sc),
                                       pack2(o[j * 8 + 4] * sc, o[j * 8 + 5] * sc), pack2(o[j * 8 + 6] * sc, o[j * 8 + 7] * sc)};
    }
  }
  u16* sV = (u16*)smem;
  for (int it = 0; it < 16; ++it) {
    int ch = tid + it * 256, tok = ch & 127, cc = ch >> 7;
    u32x4 u = *(const u32x4*)(PS + (size_t)(r0 + tok) * PSW + 1536 + cc * 8);
    const int tokp = (tok & ~12) | ((tok & 4) << 1) | ((tok & 8) >> 1);
#pragma unroll
    for (int e = 0; e < 4; ++e) {
      sV[(cc * 8 + 2 * e) * 136 + tokp] = (u16)(u[e] & 0xffff);
      sV[(cc * 8 + 2 * e + 1) * 136 + tokp] = (u16)(u[e] >> 16);
    }
  }
  __syncthreads();
  if (tid < 8) atomicMax((unsigned*)(p.ws + OFF_KMAX) + (b * 4 + (tid >> 1)) * 2 + (tid & 1), sKm[tid]);
  {
    int hv = tid;
    u16* dst = VT + ((size_t)(b * 4) * 64 + hv) * KPOS + pos0;
#pragma unroll
    for (int j = 0; j < 16; ++j) *(u32x4*)(dst + j * 8) = *(const u32x4*)(sV + hv * 136 + j * 8);
  }
  __syncthreads();
}

DEV void ml_gates(const P& p, int l, int h, int r0, float* sG) {
  const int tid = ltid(), lane = tid & 63, w = tid >> 6;
  const u16* PS = (const u16*)(p.ws + OFF_R1 + R1_PS);
  {
    int t = tid & 127, d = tid >> 7;
    const u16* g = PS + (size_t)(r0 + t) * PSW + 2560 + d * 8;
    float ig = bf2f(g[h]) + p.ml_gate_b[((l * 2 + d) * 2 + 0) * 4 + h];
    float fg = bf2f(g[4 + h]) + p.ml_gate_b[((l * 2 + d) * 2 + 1) * 4 + h];
    float lf = fminf(fg, 0.f) - __logf(1.f + __expf(-fabsf(fg)));
    sG[d * 128 + t] = ig;
    sG[(4 + d) * 128 + t] = lf;
  }
  __syncthreads();
  if (w == 0) {
    float a = sG[4 * 128 + 2 * lane], b2 = sG[4 * 128 + 2 * lane + 1];
    float s = a + b2, incl = s;
#pragma unroll
    for (int off = 1; off < 64; off <<= 1) { float t = __shfl_up(incl, off); if (lane >= off) incl += t; }
    float excl = incl - s;
    sG[2 * 128 + 2 * lane] = excl + a;
    sG[2 * 128 + 2 * lane + 1] = excl + a + b2;
  } else if (w == 1) {
    float a = sG[5 * 128 + 2 * lane], b2 = sG[5 * 128 + 2 * lane + 1];
    float s = a + b2, incl = s;
#pragma unroll
    for (int off = 1; off < 64; off <<= 1) { float t = __shfl_down(incl, off); if (lane + off < 64) incl += t; }
    float excl = incl - s;
    sG[3 * 128 + 2 * lane + 1] = excl + b2;
    sG[3 * 128 + 2 * lane] = excl + b2 + a;
  }
  __syncthreads();
}

DEV void ml_conv8(const P& p, int l, const u16* PS, int r, int s0, int s1, int col, float scale, float* o) {
  u32x4 z4 = {0, 0, 0, 0};
  u32x4 am = (r - 1 >= s0) ? *(const u32x4*)(PS + (size_t)(r - 1) * PSW + col) : z4;
  u32x4 a0 = *(const u32x4*)(PS + (size_t)r * PSW + col);
  u32x4 ap = (r + 1 < s1) ? *(const u32x4*)(PS + (size_t)(r + 1) * PSW + col) : z4;
  const float* cw = p.ml_conv_w + (size_t)l * 3 * 512 + col;
  const float* cb = p.ml_conv_b + (size_t)l * 512 + col;
  f32x4 w0[2], w1[2], w2[2], bb[2];
#pragma unroll
  for (int q = 0; q < 2; ++q) {
    w0[q] = *(const f32x4*)(cw + q * 4); w1[q] = *(const f32x4*)(cw + 512 + q * 4); w2[q] = *(const f32x4*)(cw + 1024 + q * 4);
    bb[q] = *(const f32x4*)(cb + q * 4);
  }
#pragma unroll
  for (int j = 0; j < 4; ++j) {
    const int q = j >> 1, e = (j & 1) * 2;
    float v0 = w0[q][e] * bflo(am[j]) + w1[q][e] * bflo(a0[j]) + w2[q][e] * bflo(ap[j]) + bb[q][e];
    float v1 = w0[q][e + 1] * bfhi(am[j]) + w1[q][e + 1] * bfhi(a0[j]) + w2[q][e + 1] * bfhi(ap[j]) + bb[q][e + 1];
    o[2 * j] = siluf_(v0) * scale;
    o[2 * j + 1] = siluf_(v1) * scale;
  }
}

DEV void ml_decode(int item, int& b, int& h, int& cidx, int& r0) {
  if (item < 512) { b = item >> 8; h = (item >> 6) & 3; cidx = item & 63; }
  else { int q = item - 512; b = q >> 3; h = (q >> 1) & 3; cidx = 64 + (q & 1); }
  r0 = cidx < 64 ? b * 8192 + cidx * 128 : 16384 + b * 256 + (cidx - 64) * 128;
}

DEV void mla_item(const P& p, int l, int item, char* smem) {
  const int tid = ltid(), lane = tid & 63, w = tid >> 6, r31 = lane & 31, hh = lane >> 5;
  int b, h, cidx, r0; ml_decode(item, b, h, cidx, r0);
  int s0, s1; seq_bounds(r0, s0, s1);
  const u16* PS = (const u16*)(p.ws + OFF_R1 + R1_PS);
  float* sG = (float*)smem;
  float* sRed = (float*)(smem + 4096);
  u16* sB = (u16*)(smem + 5120);
  u16* sA0 = sB + 64 * 136;
  u16* sA1 = sA0 + 64 * 136;
  ml_gates(p, l, h, r0, sG);
  {
    int d = tid >> 7, s = tid & 127;
    float wd = d == 0 ? __expf(sG[2 * 128 + 127] - sG[2 * 128 + s] + sG[s]) : __expf(sG[3 * 128] - sG[3 * 128 + s] + sG[128 + s]);
    sG[(6 + d) * 128 + s] = wd;
  }
  __syncthreads();
  {
    int s = tid & 127, cgh = tid >> 7;
    float w0 = sG[6 * 128 + s], w1 = sG[7 * 128 + s];
    for (int i = 0; i < 4; ++i) {
      int cg_ = cgh * 4 + i;
      float o[8];
      ml_conv8(p, l, PS, r0 + s, s0, s1, 256 + h * 64 + cg_ * 8, 1.f, o);
#pragma unroll
      for (int j = 0; j < 8; ++j) sB[(cg_ * 8 + j) * 136 + s] = f2bf(o[j]);
      u32x4 u = *(const u32x4*)(PS + (size_t)(r0 + s) * PSW + 512 + h * 64 + cg_ * 8);
#pragma unroll
      for (int e = 0; e < 4; ++e) {
        float v0 = bflo(u[e]), v1 = bfhi(u[e]);
        sA0[(cg_ * 8 + 2 * e) * 136 + s] = f2bf(w0 * v0);
        sA0[(cg_ * 8 + 2 * e + 1) * 136 + s] = f2bf(w0 * v1);
        sA1[(cg_ * 8 + 2 * e) * 136 + s] = f2bf(w1 * v0);
        sA1[(cg_ * 8 + 2 * e + 1) * 136 + s] = f2bf(w1 * v1);
      }
    }
  }
  __syncthreads();
  const int d = w >> 1, ni = w & 1;
  f32x16 acc[2][1];
#pragma unroll
  for (int mi = 0; mi < 2; ++mi)
#pragma unroll
    for (int i = 0; i < 16; ++i) acc[mi][0][i] = 0.f;
  mma_lds<2, 1>(d ? sA1 : sA0, 136, 0, sB, 136, ni * 32, 128, acc, lane);
  float* DC = (float*)(p.ws + OFF_R1 + R1_DC);
  {
    float* dst = DC + ((size_t)(((b * 4 + h) * 2 + d) * 66 + cidx)) * 4160;
#pragma unroll
    for (int mi = 0; mi < 2; ++mi)
#pragma unroll
      for (int i = 0; i < 16; ++i) dst[(mi * 32 + rowmap(i, hh)) * 64 + ni * 32 + r31] = acc[mi][0][i];
    if (cidx >= 64) {
      u16* CPb = (u16*)(p.ws + OFF_R1 + R1_CP) + (size_t)(((b * 4 + h) * 2 + d) * 66) * 4160;
      if ((d == 0) == (cidx == 64)) {
#pragma unroll
        for (int mi = 0; mi < 2; ++mi)
#pragma unroll
          for (int i = 0; i < 16; ++i) {
            const int e_ = (mi * 32 + rowmap(i, hh)) * 64 + ni * 32 + r31;
            CPb[(size_t)(cidx ^ 1) * 4160 + e_] = f2bf(acc[mi][0][i]);
            CPb[(size_t)cidx * 4160 + e_] = (u16)0;
          }
      }
    }
  }
  {
    int k = tid & 63, dd = (tid >> 6) & 1, half = tid >> 7;
    float s = 0;
    for (int j = half * 64; j < half * 64 + 64; ++j) s += sG[(6 + dd) * 128 + j] * bf2f(sB[k * 136 + j]);
    sRed[tid] = s;
  }
  __syncthreads();
  if (tid < 128) {
    int k = tid & 63, dd = tid >> 6;
    DC[((size_t)(((b * 4 + h) * 2 + dd) * 66 + cidx)) * 4160 + 64 * 64 + k] = sRed[tid] + sRed[tid + 128];
    if (cidx >= 64) {
      u16* CPb = (u16*)(p.ws + OFF_R1 + R1_CP) + (size_t)(((b * 4 + h) * 2 + dd) * 66) * 4160;
      if ((dd == 0) == (cidx == 64)) {
        CPb[(size_t)(cidx ^ 1) * 4160 + 64 * 64 + k] = f2bf(sRed[tid] + sRed[tid + 128]);
        CPb[(size_t)cidx * 4160 + 64 * 64 + k] = (u16)0;
      }
    }
  }
  if (tid == 0) {
    float* DEC = (float*)(p.ws + OFF_R1 + R1_DEC);
    DEC[((b * 4 + h) * 2 + 0) * 66 + cidx] = expf(sG[2 * 128 + 127]);
    DEC[((b * 4 + h) * 2 + 1) * 66 + cidx] = expf(sG[3 * 128]);
  }
  __syncthreads();
}

DEV void scan_item(const P& p, int item) {
  const int seq = item >> 2, quarter = item & 3, d = seq & 1;
  const float* DC = (const float*)(p.ws + OFF_R1 + R1_DC) + (size_t)seq * 66 * 4160;
  const float* DEC = (const float*)(p.ws + OFF_R1 + R1_DEC) + seq * 66;
  u16* CP = (u16*)(p.ws + OFF_R1 + R1_CP) + (size_t)seq * 66 * 4160;
  float st[5];
  int e[5];
  const int tid0 = ltid();
#pragma unroll
  for (int i = 0; i < 5; ++i) { st[i] = 0.f; int q = tid0 + i * 256; e[i] = q < 1040 ? quarter * 1040 + q : quarter * 1040; }
  const bool last_ok = tid0 + 4 * 256 < 1040;
  for (int s0 = 0; s0 < 66; s0 += 6) {
    float dc[6][5], dec[6];
    int cx[6];
#pragma unroll
    for (int u = 0; u < 6; ++u) {
      int step = s0 + u;
      cx[u] = d == 0 ? (step < 2 ? 64 + step : step - 2) : (step < 2 ? 65 - step : 63 - (step - 2));
      dec[u] = DEC[cx[u]];
#pragma unroll
      for (int i = 0; i < 5; ++i) dc[u][i] = DC[(size_t)cx[u] * 4160 + e[i]];
    }
#pragma unroll
    for (int u = 0; u < 6; ++u) {
#pragma unroll
      for (int i = 0; i < 5; ++i) {
        if ((i < 4 || last_ok) && s0 + u >= 2) CP[(size_t)cx[u] * 4160 + e[i]] = f2bf(st[i]);
        st[i] = dec[u] * st[i] + dc[u][i];
      }
    }
  }
}

DEV void mlc_item(const P& p, int l, int item, char* smem) {
  const int tid = ltid(), lane = tid & 63, w = tid >> 6, r31 = lane & 31, hh = lane >> 5;
  int b, h, cidx, r0; ml_decode(item, b, h, cidx, r0);
  int s0, s1; seq_bounds(r0, s0, s1);
  const u16* PS = (const u16*)(p.ws + OFF_R1 + R1_PS);
  float* sG = (float*)smem;
  float* sN = (float*)(smem + 4096);
  u16* sK = (u16*)(smem + 4608);
  u16* sQ = sK + 128 * 72;
  u16* sC = sQ;
  u16* sVT = sQ + 128 * 72;
  ml_gates(p, l, h, r0, sG);
  {
    int d = tid >> 7, s = tid & 127;
    sG[(6 + d) * 128 + s] = sG[d * 128 + s] - sG[(2 + d) * 128 + s];
  }
  {
    for (int i = 0; i < 4; ++i) {
      int ch = tid + i * 256, s = ch >> 3, cg_ = ch & 7;
      float o[8];
      ml_conv8(p, l, PS, r0 + s, s0, s1, 256 + h * 64 + cg_ * 8, 1.f, o);
      *(u32x4*)(sK + s * 72 + cg_ * 8) = u32x4{pack2(o[0], o[1]), pack2(o[2], o[3]), pack2(o[4], o[5]), pack2(o[6], o[7])};
      ml_conv8(p, l, PS, r0 + s, s0, s1, h * 64 + cg_ * 8, 0.125f, o);
      *(u32x4*)(sQ + s * 72 + cg_ * 8) = u32x4{pack2(o[0], o[1]), pack2(o[2], o[3]), pack2(o[4], o[5]), pack2(o[6], o[7])};
    }
    int s = tid & 127, cgh = tid >> 7;
    for (int i = 0; i < 4; ++i) {
      int cg_ = cgh * 4 + i;
      u32x4 u = *(const u32x4*)(PS + (size_t)(r0 + s) * PSW + 512 + h * 64 + cg_ * 8);
#pragma unroll
      for (int e = 0; e < 4; ++e) {
        sVT[(cg_ * 8 + 2 * e) * 136 + s] = (u16)(u[e] & 0xffff);
        sVT[(cg_ * 8 + 2 * e + 1) * 136 + s] = (u16)(u[e] >> 16);
      }
    }
  }
  __syncthreads();
  bf16x8 qf[4];
#pragma unroll
  for (int ks = 0; ks < 4; ++ks) qf[ks] = *(const bf16x8*)(sQ + (w * 32 + r31) * 72 + ks * 16 + hh * 8);
  __syncthreads();
  {
    const u16* CP = (const u16*)(p.ws + OFF_R1 + R1_CP);
    for (int d = 0; d < 2; ++d) {
      const u16* src = CP + ((size_t)(((b * 4 + h) * 2 + d) * 66 + cidx)) * 4160;
      for (int ch = tid; ch < 64 * 8; ch += 256) {
        int rr = ch >> 3, cc = ch & 7;
        *(u32x4*)(sC + (d * 64 + rr) * 72 + cc * 8) = *(const u32x4*)(src + rr * 64 + cc * 8);
      }
      if (tid < 64) sN[d * 64 + tid] = bf2f(src[64 * 64 + tid]);
    }
  }
  __syncthreads();
  const int qloc = w * 32 + r31;
  f32x16 Hs[2];
#pragma unroll
  for (int vt = 0; vt < 2; ++vt)
#pragma unroll
    for (int i = 0; i < 16; ++i) Hs[vt][i] = 0.f;
#pragma unroll 1
  for (int d = 0; d < 2; ++d) {
    f32x16 R[2];
#pragma unroll
    for (int vt = 0; vt < 2; ++vt) {
#pragma unroll
      for (int i = 0; i < 16; ++i) R[vt][i] = 0.f;
#pragma unroll
      for (int ks = 0; ks < 4; ++ks) {
        bf16x8 a = *(const bf16x8*)(sC + (d * 64 + vt * 32 + r31) * 72 + ks * 16 + hh * 8);
        R[vt] = mfma(a, qf[ks], R[vt]);
      }
    }
    float nq = 0.f;
#pragma unroll
    for (int ks = 0; ks < 4; ++ks)
#pragma unroll
      for (int j = 0; j < 8; ++j) nq += sN[d * 64 + ks * 16 + hh * 8 + j] * bf2f((u16)qf[ks][j]);
    nq = xsum32(nq);
    const float Bq = sG[(2 + d) * 128 + qloc];
    const float eb = __expf(Bq);
    const int sgn = d == 0 ? 1 : -1;
#pragma unroll
    for (int vt = 0; vt < 2; ++vt)
#pragma unroll
      for (int i = 0; i < 16; ++i) R[vt][i] *= eb;
    float den = 0.f;
#pragma unroll 1
    for (int kt = 0; kt < 4; ++kt) {
      f32x16 X;
#pragma unroll
      for (int i = 0; i < 16; ++i) X[i] = 0.f;
#pragma unroll
      for (int ks = 0; ks < 4; ++ks) {
        bf16x8 a = *(const bf16x8*)(sK + (kt * 32 + r31) * 72 + ks * 16 + hh * 8);
        X = mfma(a, qf[ks], X);
      }
      float pv[16];
#pragma unroll
      for (int i = 0; i < 16; ++i) {
        int key = kt * 32 + rowmap(i, hh);
        int tdiff = sgn * (qloc - key);
        float wgt = __expf(Bq + sG[(6 + d) * 128 + key] + (float)min(tdiff, 0) * 1e30f);
        pv[i] = X[i] * wgt;
        den += pv[i];
      }
#pragma unroll
      for (int s = 0; s < 2; ++s) {
        u32x4 pu = {pack2(pv[8 * s], pv[8 * s + 1]), pack2(pv[8 * s + 2], pv[8 * s + 3]), pack2(pv[8 * s + 4], pv[8 * s + 5]), pack2(pv[8 * s + 6], pv[8 * s + 7])};
        bf16x8 pf = __builtin_bit_cast(bf16x8, pu);
        const int ks2 = kt * 2 + s;
#pragma unroll
        for (int vt = 0; vt < 2; ++vt) {
          const u16* vp = sVT + (vt * 32 + r31) * 136 + 16 * ks2 + 4 * hh;
          u32x2 lo = *(const u32x2*)vp, hi = *(const u32x2*)(vp + 8);
          u32x4 au = {lo[0], lo[1], hi[0], hi[1]};
          R[vt] = mfma(__builtin_bit_cast(bf16x8, au), pf, R[vt]);
        }
      }
    }
    den = xsum32(den);
    den += eb * nq;
    float inv = 1.f / fmaxf(fabsf(den), 1.f);
#pragma unroll
    for (int vt = 0; vt < 2; ++vt)
#pragma unroll
      for (int i = 0; i < 16; ++i) Hs[vt][i] += R[vt][i] * inv;
  }
  float ss = 0;
#pragma unroll
  for (int vt = 0; vt < 2; ++vt)
#pragma unroll
    for (int i = 0; i < 16; ++i) ss += Hs[vt][i] * Hs[vt][i];
  ss = xsum32(ss);
  const float rs = rsqrtf(ss * (1.f / 64.f) + EPSV);
  u16* BR = (u16*)(p.ws + OFF_R2 + R2_BR);
  const int row = r0 + qloc;
#pragma unroll
  for (int vt = 0; vt < 2; ++vt)
#pragma unroll
    for (int i = 0; i < 16; ++i) {
      int v = vt * 32 + rowmap(i, hh);
      float o = bf2f(PS[(size_t)row * PSW + 768 + h * 64 + v]);
      float val = Hs[vt][i] * rs * p.ml_norm[l * 256 + h * 64 + v] * sigmoidf_(o);
      BR[(size_t)row * 1024 + h * 64 + v] = f2bf(val);
    }
  __syncthreads();
}

DEV void attn_item(const P& p, int l, int item, char* smem, float lam, float lam_init) {
  const int tid = ltid(), lane = tid & 63, w = tid >> 6, r31 = lane & 31, hh = lane >> 5;
  const int c = w & 1, qs = w >> 1;
  int b, h, q0, key0, ntile;
  if (item < 1024) { b = item >> 9; h = (item >> 7) & 3; q0 = (item & 127) * 64; key0 = 0; ntile = 132; }
  else { int q = item - 1024; b = q >> 4; h = (q >> 2) & 3; q0 = 8192 + (q & 3) * 64; key0 = 8192; ntile = 4; }
  const int bh = b * 4 + h;
  const u16* QR = (const u16*)(p.ws + OFF_R1 + R1_QR);
  const u16* KR = (const u16*)(p.ws + OFF_R1 + R1_KR);
  const u16* VT = (const u16*)(p.ws + OFF_R1 + R1_VT);
  bf16x8 qf[2];
  {
    const u16* qb = QR + ((size_t)(bh * 2 + c) * KPOS + q0 + qs * 32 + r31) * 32;
    qf[0] = *(const bf16x8*)(qb + hh * 8);
    qf[1] = *(const bf16x8*)(qb + 16 + hh * 8);
  }
  constexpr int KB = 16384, STG = 32768;
  const unsigned lbase = (unsigned)(size_t)smem + tid * 16;
  const u16* kp0 = KR + ((size_t)(bh * 2) * KPOS + key0 + (tid >> 2)) * 32 + ((tid & 3) ^ ((tid >> 4) & 3)) * 8;
  const u16* vp0 = VT + ((size_t)bh * 64 + (tid >> 4)) * KPOS + key0 + ((tid & 15) ^ ((tid >> 4) & 15)) * 8;
#define AGLDS(kt, stg)                                                                                            \
  {                                                                                                               \
    _Pragma("unroll") for (int i = 0; i < 4; ++i)                                                                 \
      __builtin_amdgcn_global_load_lds((const unsigned*)(kp0 + (size_t)(i >> 1) * KPOS * 32 + (size_t)((i & 1) * 64 + (kt) * 128) * 32), \
                                       (LAS unsigned*)(lbase + (stg) * STG + i * 4096), 16, 0, 0);                \
    _Pragma("unroll") for (int i = 0; i < 4; ++i)                                                                 \
      __builtin_amdgcn_global_load_lds((const unsigned*)(vp0 + (size_t)(i * 16) * KPOS + (kt) * 128),             \
                                       (LAS unsigned*)(lbase + (stg) * STG + KB + i * 4096), 16, 0, 0);           \
  }
  f32x16 O[2], NEGM;
#pragma unroll
  for (int i = 0; i < 16; ++i) { O[0][i] = 0.f; O[1][i] = 0.f; }
  float lsum = 0.f;
  {
    float qq = 0.f;
#pragma unroll
    for (int ks = 0; ks < 2; ++ks)
#pragma unroll
      for (int j = 0; j < 8; ++j) { float t = bf2f((u16)qf[ks][j]); qq += t * t; }
    qq = xsum32(qq);
    const float k2 = __uint_as_float(__hip_atomic_load((unsigned*)(p.ws + OFF_KMAX) + bh * 2 + c, __ATOMIC_RELAXED, __HIP_MEMORY_SCOPE_AGENT));
    const float mref = sqrtf(qq * k2) * 1.001f;
#pragma unroll
    for (int i = 0; i < 16; ++i) NEGM[i] = -mref;
  }
  const int nt2 = ntile >> 1;
  const int swk = (r31 >> 2) & 3, swv = r31 & 15;
  AGLDS(0, 0);
  asm volatile("s_waitcnt vmcnt(0)" ::: "memory");
  __builtin_amdgcn_s_barrier();
  for (int kt = 0; kt < nt2; ++kt) {
    if (kt + 1 < nt2) AGLDS(kt + 1, (kt + 1) & 1);
    __builtin_amdgcn_sched_barrier(0);
    const char* kb = smem + (kt & 1) * STG + c * 8192;
    const char* vb = smem + (kt & 1) * STG + KB;
    f32x16 X[4];
#pragma unroll
    for (int k2 = 0; k2 < 4; ++k2) {
      const char* kp_ = kb + (k2 * 32 + r31) * 64;
      X[k2] = mfma(*(const bf16x8*)(kp_ + ((hh) ^ swk) * 16), qf[0], NEGM);
      X[k2] = mfma(*(const bf16x8*)(kp_ + ((2 + hh) ^ swk) * 16), qf[1], X[k2]);
    }
    float ps = 0.f;
#pragma unroll
    for (int k2 = 0; k2 < 4; ++k2)
#pragma unroll
      for (int i = 0; i < 16; ++i) { float e = __builtin_amdgcn_exp2f(X[k2][i]); X[k2][i] = e; ps += e; }
    lsum += ps;
#pragma unroll
    for (int ks2 = 0; ks2 < 8; ++ks2) {
      const int k2 = ks2 >> 1, s_ = ks2 & 1;
      u32x4 pu = {pack2(X[k2][8 * s_], X[k2][8 * s_ + 1]), pack2(X[k2][8 * s_ + 2], X[k2][8 * s_ + 3]),
                  pack2(X[k2][8 * s_ + 4], X[k2][8 * s_ + 5]), pack2(X[k2][8 * s_ + 6], X[k2][8 * s_ + 7])};
      bf16x8 pf = __builtin_bit_cast(bf16x8, pu);
#pragma unroll
      for (int vt = 0; vt < 2; ++vt) {
        bf16x8 av = *(const bf16x8*)(vb + (vt * 32 + r31) * 256 + ((2 * ks2 + hh) ^ swv) * 16);
        O[vt] = mfma(av, pf, O[vt]);
      }
    }
    __builtin_amdgcn_sched_barrier(0);
    asm volatile("s_waitcnt vmcnt(0)" ::: "memory");
    __builtin_amdgcn_s_barrier();
  }
#undef AGLDS
  const float ltot = xsum32(lsum);
  const float inv = 1.f / ltot;
  float* sX = (float*)smem;
  if (c == 1) {
#pragma unroll
    for (int vt = 0; vt < 2; ++vt)
#pragma unroll
      for (int i = 0; i < 16; ++i) sX[(qs * 32 + vt * 16 + i) * 64 + lane] = O[vt][i] * inv * lam;
  }
  __syncthreads();
  if (c == 0) {
    float ss = 0.f;
#pragma unroll
    for (int vt = 0; vt < 2; ++vt)
#pragma unroll
      for (int i = 0; i < 16; ++i) { float o = O[vt][i] * inv - sX[(qs * 32 + vt * 16 + i) * 64 + lane]; O[vt][i] = o; ss += o * o; }
    ss = xsum32(ss);
    const float rs = rsqrtf(ss * (1.f / 64.f) + EPSV) * (1.f - lam_init);
    const int qpos = q0 + qs * 32 + r31;
    const int row = qpos < 8192 ? b * 8192 + qpos : 16384 + b * 256 + (qpos - 8192);
    u16* BR = (u16*)(p.ws + OFF_R2 + R2_BR);
#pragma unroll
    for (int vt = 0; vt < 2; ++vt)
#pragma unroll
      for (int i = 0; i < 16; ++i) {
        int v = vt * 32 + rowmap(i, hh);
        BR[(size_t)row * 1024 + 256 + h * 64 + v] = f2bf(O[vt][i] * rs * p.da_subln[l * 64 + v]);
      }
  }
  __syncthreads();
}

DEV void f2_item(const P& p, int item, char* smem) {
  const int tid = ltid(), lane = tid & 63, w = tid >> 6, r31 = lane & 31, hh = lane >> 5;
  int seq, g, s2, N1, base;
  if (item < 1024) { seq = item >> 9; g = (item >> 7) & 3; s2 = item & 127; N1 = 64; base = seq * 8192; }
  else { int q = item - 1024; seq = 2 + (q >> 9); g = (q >> 7) & 3; s2 = q & 127; N1 = 2; base = 16384 + (seq - 2) * 256; }
  const u16* PS = (const u16*)(p.ws + OFF_R1 + R1_PS);
  u16* sT = (u16*)smem;
  u16* sAB = (u16*)(smem + 9216);
  float* sEx = (float*)(smem + 9216 + 17408);
  for (int i = 0; i < 2; ++i) {
    int ch = tid + i * 256, s1 = ch >> 3, cc = ch & 7;
    u32x4 v = {0, 0, 0, 0};
    if (s1 < N1) v = *(const u32x4*)(PS + (size_t)(base + 128 * s1 + s2) * PSW + 1792 + g * 64 + cc * 8);
    *(u32x4*)(sT + s1 * 72 + cc * 8) = v;
  }
  __syncthreads();
  {
    const int mi = w & 1, nh = w >> 1;
    f32x16 a1[1][2];
#pragma unroll
    for (int ni = 0; ni < 2; ++ni)
#pragma unroll
      for (int i = 0; i < 16; ++i) a1[0][ni][i] = 0.f;
    mma_lds<1, 2>(sT, 72, mi * 32, (const u16*)(p.ws + OFF_TB1), 64, nh * 64, 64, a1, lane);
#pragma unroll
    for (int ni = 0; ni < 2; ++ni)
#pragma unroll
      for (int i = 0; i < 16; ++i) sAB[(ni * 32 + r31) * 136 + nh * 64 + mi * 32 + rowmap(i, hh)] = f2bf(a1[0][ni][i]);
  }
  __syncthreads();
  {
    f32x16 a2[1][2];
#pragma unroll
    for (int ni = 0; ni < 2; ++ni)
#pragma unroll
      for (int i = 0; i < 16; ++i) a2[0][ni][i] = 0.f;
    mma_lds<1, 2>((const u16*)(p.ws + (N1 == 64 ? OFF_TA264 : OFF_TA22)), 128, w * 32, sAB, 136, 0, 128, a2, lane);
#pragma unroll
    for (int ni = 0; ni < 2; ++ni)
#pragma unroll
      for (int i = 0; i < 16; ++i) sEx[(w * 32 + rowmap(i, hh)) * 65 + ni * 32 + r31] = a2[0][ni][i];
  }
  __syncthreads();
  {
    const float* TW = (const float*)(p.ws + OFF_TW);
    u16* XRE = (u16*)(p.ws + OFF_R1 + R1_XRE);
    u16* XIM = (u16*)(p.ws + OFF_R1 + R1_XIM);
    for (int i = 0; i < 16; ++i) {
      int e = tid + i * 256, ka = e >> 6, k2 = e & 63;
      if (ka < N1) {
        float re = sEx[ka * 65 + k2], im = sEx[(64 + ka) * 65 + k2];
        int idx = (ka * s2 * (N1 == 64 ? 1 : 32)) & 8191;
        float cs = TW[2 * idx], sn = TW[2 * idx + 1];
        size_t o = ((size_t)((seq * 4 + g) * 64 + ka) * 128 + s2) * 64 + k2;
        XRE[o] = f2bf(re * cs + im * sn);
        XIM[o] = f2bf(im * cs - re * sn);
      }
    }
  }
  __syncthreads();
}

DEV void f2ctx_item(const P& p, int item, char* smem) {
  const int tid = ltid(), lane = tid & 63, w = tid >> 6, r31 = lane & 31, hh = lane >> 5;
  const int seq = 2 + (item >> 4), g = (item >> 2) & 3, grp = item & 3, base = 16384 + (seq - 2) * 256;
  const u16* PS = (const u16*)(p.ws + OFF_R1 + R1_PS);
  u16* sT = (u16*)smem;
  float* sEx = (float*)(smem + 9216 + 17408);
  for (int i = 0; i < 2; ++i) {
    int ch = tid + i * 256, rr = ch >> 3, cc = ch & 7, s1 = rr >> 5, j = rr & 31;
    *(u32x4*)(sT + rr * 72 + cc * 8) = *(const u32x4*)(PS + (size_t)(base + 128 * s1 + grp * 32 + j) * PSW + 1792 + g * 64 + cc * 8);
  }
  __syncthreads();
  {
    const int mi = w & 1, nh = w >> 1;
    f32x16 a1[1][2];
#pragma unroll
    for (int ni = 0; ni < 2; ++ni)
#pragma unroll
      for (int i = 0; i < 16; ++i) a1[0][ni][i] = 0.f;
    mma_lds<1, 2>(sT, 72, mi * 32, (const u16*)(p.ws + OFF_TB1), 64, nh * 64, 64, a1, lane);
#pragma unroll
    for (int ni = 0; ni < 2; ++ni)
#pragma unroll
      for (int i = 0; i < 16; ++i) sEx[(mi * 32 + rowmap(i, hh)) * 130 + nh * 64 + ni * 32 + r31] = a1[0][ni][i];
  }
  __syncthreads();
  {
    const float* TW = (const float*)(p.ws + OFF_TW);
    u16* XRE = (u16*)(p.ws + OFF_R1 + R1_XRE);
    u16* XIM = (u16*)(p.ws + OFF_R1 + R1_XIM);
    for (int i = 0; i < 16; ++i) {
      int e = tid + i * 256, ka = e >> 11, j = (e >> 6) & 31, k2 = e & 63;
      int s2 = grp * 32 + j;
      float a0 = sEx[j * 130 + k2], b0 = sEx[j * 130 + 64 + k2], a1v = sEx[(32 + j) * 130 + k2], b1v = sEx[(32 + j) * 130 + 64 + k2];
      float re = ka ? a0 - a1v : a0 + a1v, im = ka ? b0 - b1v : b0 + b1v;
      int idx = (ka * s2 * 32) & 8191;
      float cs = TW[2 * idx], sn = TW[2 * idx + 1];
      size_t o = ((size_t)((seq * 4 + g) * 64 + ka) * 128 + s2) * 64 + k2;
      XRE[o] = f2bf(re * cs + im * sn);
      XIM[o] = f2bf(im * cs - re * sn);
    }
  }
  __syncthreads();
}

DEV void f3_item(const P& p, int item, char* smem) {
  const int tid = ltid(), lane = tid & 63, w = tid >> 6, r31 = lane & 31, hh = lane >> 5;
  int seq, g, ka, N1, base; float scale;
  if (item < 512) { seq = item >> 8; g = (item >> 6) & 3; ka = item & 63; N1 = 64; base = seq * 8192; scale = 1.f / 724.0773439350247f; }
  else { int q = item - 512; seq = 2 + (q >> 3); g = (q >> 1) & 3; ka = q & 1; N1 = 2; base = 16384 + (seq - 2) * 256; scale = 1.f / 128.f; }
  u16* sB = (u16*)smem;
  const u16* XRE = (const u16*)(p.ws + OFF_R1 + R1_XRE) + (size_t)((seq * 4 + g) * 64 + ka) * 128 * 64;
  const u16* XIM = (const u16*)(p.ws + OFF_R1 + R1_XIM) + (size_t)((seq * 4 + g) * 64 + ka) * 128 * 64;
  {
    int s2 = tid & 127, cgh = tid >> 7;
    for (int i = 0; i < 4; ++i) {
      int cg_ = cgh * 4 + i;
      u32x4 ur = *(const u32x4*)(XRE + s2 * 64 + cg_ * 8);
      u32x4 ui = *(const u32x4*)(XIM + s2 * 64 + cg_ * 8);
#pragma unroll
      for (int e = 0; e < 4; ++e) {
        sB[(cg_ * 8 + 2 * e) * 264 + s2] = (u16)(ur[e] & 0xffff);
        sB[(cg_ * 8 + 2 * e + 1) * 264 + s2] = (u16)(ur[e] >> 16);
        sB[(cg_ * 8 + 2 * e) * 264 + 128 + s2] = (u16)(ui[e] & 0xffff);
        sB[(cg_ * 8 + 2 * e + 1) * 264 + 128 + s2] = (u16)(ui[e] >> 16);
      }
    }
  }
  __syncthreads();
  f32x16 acc[1][2];
#pragma unroll
  for (int ni = 0; ni < 2; ++ni)
#pragma unroll
    for (int i = 0; i < 16; ++i) acc[0][ni][i] = 0.f;
  mma_lds<1, 2>((const u16*)(p.ws + OFF_TCS), 256, w * 32, sB, 264, 0, 256, acc, lane);
  u16* BR = (u16*)(p.ws + OFF_R2 + R2_BR);
#pragma unroll
  for (int ni = 0; ni < 2; ++ni)
#pragma unroll
    for (int i = 0; i < 16; ++i) {
      int kb = w * 32 + rowmap(i, hh), k2 = ni * 32 + r31;
      int row = base + ka + N1 * kb;
      BR[(size_t)row * 1024 + 512 + g * 64 + k2] = f2bf(acc[0][ni][i] * scale);
    }
  __syncthreads();
}

DEV void sgu_item(const P& p, int l, int item, char* smem) {
  const int tid = ltid(), lane = tid & 63, w = tid >> 6, r31 = lane & 31, hh = lane >> 5;
  const int tl = item >> 2, g = item & 3, r0 = tl * 128;
  const u16* PS = (const u16*)(p.ws + OFF_R1 + R1_PS);
  u16* sA = (u16*)smem;
  u16* sB = (u16*)(smem + 34816);
  float* sSt = (float*)(smem + 34816 + 17408);
  {
    int tok = tid >> 1, half = tid & 1;
    const u16* src = PS + (size_t)(r0 + tok) * PSW + 2304 + half * 128;
    float s = 0, sq = 0;
    for (int j = 0; j < 16; ++j) {
      u32x4 u = *(const u32x4*)(src + j * 8);
#pragma unroll
      for (int e = 0; e < 4; ++e) { float a = geluf_(bflo(u[e])), b2 = geluf_(bfhi(u[e])); s += a + b2; sq += a * a + b2 * b2; }
    }
    s += __shfl_xor(s, 1); sq += __shfl_xor(sq, 1);
    float mean = s * (1.f / 256.f);
    float var = fmaxf(sq * (1.f / 256.f) - mean * mean, 0.f);
    if (half == 0) { sSt[tok * 2] = mean; sSt[tok * 2 + 1] = rsqrtf(var + EPSV); }
  }
  __syncthreads();
  {
    int q = tid & 127, cgh = tid >> 7;
    float mean = sSt[q * 2], rstd = sSt[q * 2 + 1];
    for (int i = 0; i < 4; ++i) {
      int cg_ = cgh * 4 + i;
      u32x4 u = *(const u32x4*)(PS + (size_t)(r0 + q) * PSW + 2304 + g * 64 + cg_ * 8);
#pragma unroll
      for (int e = 0; e < 4; ++e) {
        int d0 = cg_ * 8 + 2 * e;
        float a = (geluf_(bflo(u[e])) - mean) * rstd * p.sg_norm[l * 256 + g * 64 + d0];
        float b2 = (geluf_(bfhi(u[e])) - mean) * rstd * p.sg_norm[l * 256 + g * 64 + d0 + 1];
        sB[d0 * 136 + q] = f2bf(a);
        sB[(d0 + 1) * 136 + q] = f2bf(b2);
      }
    }
    const float* W = p.sg_w + (size_t)(l * 4 + g) * 128 * 128;
    for (int i = 0; i < 8; ++i) {
      int pr = (tid >> 4) + 16 * i, cc = (tid & 15) * 8;
      f32x4 a = *(const f32x4*)(W + pr * 128 + cc), b2 = *(const f32x4*)(W + pr * 128 + cc + 4);
      *(u32x4*)(sA + pr * 136 + cc) = u32x4{pack2(a[0], a[1]), pack2(a[2], a[3]), pack2(b2[0], b2[1]), pack2(b2[2], b2[3])};
    }
  }
  __syncthreads();
  f32x16 acc[1][2];
#pragma unroll
  for (int ni = 0; ni < 2; ++ni)
#pragma unroll
    for (int i = 0; i < 16; ++i) acc[0][ni][i] = 0.f;
  mma_lds<1, 2>(sA, 136, w * 32, sB, 136, 0, 128, acc, lane);
  u16* BR = (u16*)(p.ws + OFF_R2 + R2_BR);
#pragma unroll
  for (int ni = 0; ni < 2; ++ni)
#pragma unroll
    for (int i = 0; i < 16; ++i) {
      int pp = w * 32 + rowmap(i, hh), d = ni * 32 + r31;
      float u = geluf_(bf2f(PS[(size_t)(r0 + pp) * PSW + 2048 + g * 64 + d]));
      float val = (acc[0][ni][i] + p.sg_b[(l * 4 + g) * 128 + pp]) * u;
      BR[(size_t)(r0 + pp) * 1024 + 768 + g * 64 + d] = f2bf(val);
    }
  __syncthreads();
}

__global__ void __launch_bounds__(256, 2) mega(P p) {
  extern __shared__ __attribute__((aligned(16))) char smem[];
  cg::grid_group grid = cg::this_grid();
  __shared__ unsigned xb_st[4];
  if (threadIdx.x < 4) xb_st[threadIdx.x] = 0u;
  __syncthreads();
  XcdBarrier xb = xcd_barrier_post((unsigned*)(p.ws + OFF_BAR), (volatile LAS unsigned*)xb_st);
  int phase = 0;
  const int bid = blockIdx.x, nb = gridDim.x;
#ifndef DUP
#define DUP 0
#endif
#define PH_BEGIN if (phase >= p.ph0 && phase < p.ph1) {
#define REP_BEGIN(kind) for (int rep_ = 0; rep_ < 1 + ((DUP >> (kind)) & 1); ++rep_) { if (rep_) xcd_barrier(xb);
#define REP_END }
#define PH_END } ++phase; if (p.coop) { if (p.coop == 2 && phase == 1) grid.sync(); else xcd_barrier(xb); }

  PH_BEGIN
  for (int it = bid; it < 768 + 21 + 4320; it += nb) {
    if (it < 768) mod_item(p, it, smem);
    else if (it < 789) tab_item(p, it - 768);
    else conv_item(p, 0, it - 789, smem);
  }
  PH_END
  PH_BEGIN
  for (int it = bid; it < NROW / 4; it += nb) rowpass_item(p, 0, 0, it);
  PH_END

  for (int l = 0; l < 4; ++l) {
    const float lam_init = 0.8f - 0.6f * expf(-0.3f * (float)l);
    const bool last = l == 3;
    PH_BEGIN
REP_BEGIN(0)
    banded(bid, nb, 132, 21, 7, [&](int mt, int nt) { gemm1_item(p, mt, nt, smem); });
REP_END
    PH_END
    PH_BEGIN
REP_BEGIN(1)
    for (int it = bid; it < 132 + 528 + 528 + 1024 + 32; it += nb) {
      if (it < 132) attnprep_item(p, it, smem);
      else if (it < 660) mla_item(p, l, it - 132, smem);
      else if (it < 1188) { if (!(last && it - 660 >= 512)) sgu_item(p, l, it - 660, smem); }
      else if (it < 2212) f2_item(p, it - 1188, smem);
      else if (!last) f2ctx_item(p, it - 2212, smem);
    }
REP_END
    PH_END
    PH_BEGIN
    {
      float s01 = 0.f, s23 = 0.f;
      for (int i = 0; i < 32; ++i) {
        s01 += p.da_lam[l * 128 + i] * p.da_lam[l * 128 + 32 + i];
        s23 += p.da_lam[l * 128 + 64 + i] * p.da_lam[l * 128 + 96 + i];
      }
      const float lam = expf(s01) - expf(s23) + lam_init;
      {
        const int x = bid & 7, j = bid >> 3, per = nb >> 3;
        for (int r_ = 0; r_ < 1 + ((DUP >> 2) & 1); ++r_) {
          for (int q = j; q < 128; q += per) attn_item(p, l, x * 128 + q, smem, lam, lam_init);
          if (!last) for (int q = j; q < 4; q += per) attn_item(p, l, 1024 + x * 4 + q, smem, lam, lam_init);
        }
      }
      if (!last) for (int it = bid - (nb - 16); it >= 0 && it < 16; it += nb) mlc_item(p, l, 512 + it, smem);
      for (int it = bid; it < 64 + 528; it += nb) {
        if (it < 64) { for (int r_ = 0; r_ < 1 + ((DUP >> 9) & 1); ++r_) scan_item(p, it); }
        else if (!(last && it - 64 >= 512)) { for (int r_ = 0; r_ < 1 + ((DUP >> 10) & 1); ++r_) f3_item(p, it - 64, smem); }
      }
    }
    PH_END
    PH_BEGIN
REP_BEGIN(3)
    for (int it = bid; it < 512; it += nb) mlc_item(p, l, it, smem);
REP_END
    PH_END
    PH_BEGIN
REP_BEGIN(4)
    banded(bid, nb, 128, 8, 8, [&](int mt, int nt) { merge_item<2>(p, mt, nt, smem); });
    if (!last) for (int it = bid; it < 64; it += nb) merge_item<1>(p, 128 + (it >> 4), it & 15, smem);
REP_END
    PH_END
    PH_BEGIN
REP_BEGIN(5)
    banded(bid, nb, 128, 8, 8, [&](int mt, int nt) { gemm_f32_big((const u16*)(p.ws + OFF_R2 + R2_Z), 1024, (const u16*)(p.ws + OFF_WT + WT_OUT), (float*)(p.ws + OFF_R1), mt, nt, smem); });
    if (!last) for (int it = bid; it < 64; it += nb)
      gemm_f32_small((const u16*)(p.ws + OFF_R2 + R2_Z), 1024, (const u16*)(p.ws + OFF_WT + WT_OUT), (float*)(p.ws + OFF_R1), it, smem);
REP_END
    PH_END
    PH_BEGIN
    for (int it = bid; it < NROW / 4; it += nb) rowpass_item(p, l, 1, it);
    PH_END
    PH_BEGIN
REP_BEGIN(6)
    banded(bid, nb, 67, 44, 11, [&](int mt, int nt) { upact_item(p, l, mt, nt, smem); });
REP_END
    PH_END
    PH_BEGIN
REP_BEGIN(8)
    banded(bid, nb, 128, 8, 8, [&](int mt, int nt) { gemm_f32_big((const u16*)(p.ws + OFF_R2), 2816, (const u16*)(p.ws + OFF_WT + WT_DOWN), (float*)(p.ws + OFF_R1), mt, nt, smem); });
    if (!last) for (int it = bid; it < 64; it += nb)
      gemm_f32_small((const u16*)(p.ws + OFF_R2), 2816, (const u16*)(p.ws + OFF_WT + WT_DOWN), (float*)(p.ws + OFF_R1), it, smem);
REP_END
    PH_END
    PH_BEGIN
    {
      const int nconv = l < 3 ? 4320 : 0;
      for (int it = bid; it < NROW / 4 + nconv; it += nb) {
        if (it < NROW / 4) rowpass_item(p, l, 2, it);
        else { for (int r_ = 0; r_ < 1 + ((DUP >> 11) & 1); ++r_) conv_item(p, l + 1, it - NROW / 4, smem); }
      }
    }
    PH_END
  }
}

extern "C" void kernel_launch(void* const* d_in, const int* in_sizes, int n_in, void* d_out, int out_size, void* d_ws, size_t ws_size,
                              hipStream_t stream) {
  static int grid_blocks = 0;
  if (!grid_blocks) {
    if (hipFuncSetAttribute((const void*)mega, hipFuncAttributeMaxDynamicSharedMemorySize, LDS_BYTES) != hipSuccess) {
      fprintf(stderr, "hipFuncSetAttribute failed\n");
    }
    int dev = 0, cus = 0, per_cu = 0;
    hipGetDevice(&dev);
    hipDeviceGetAttribute(&cus, hipDeviceAttributeMultiprocessorCount, dev);
    hipOccupancyMaxActiveBlocksPerMultiprocessor(&per_cu, (const void*)mega, 256, LDS_BYTES);
    if (per_cu > 2) per_cu = 2;
    if (per_cu < 1) per_cu = 1;
    grid_blocks = cus * per_cu;
  }
  P p{};
  const float** f = (const float**)&p;
  for (int i = 0; i < 23; ++i) f[i] = (const float*)d_in[i];
  p.out = (float*)d_out;
  p.ws = (char*)d_ws;
  p.ph0 = 0; p.ph1 = 1 << 30; p.coop = 1; p.pad = 0;
  hipMemsetAsync((char*)d_ws + OFF_BAR, 0, 16384, stream);
  void* args[] = {&p};
  hipError_t e = hipLaunchCooperativeKernel((const void*)mega, dim3(grid_blocks), dim3(256), args, LDS_BYTES, stream);
  if (e != hipSuccess) fprintf(stderr, "cooperative launch failed: %s (grid %d)\n", hipGetErrorString(e), grid_blocks);
}
```

```cpp
#include <hip/hip_runtime.h>
#include <hip/hip_cooperative_groups.h>
#include <stdint.h>
#include <stdio.h>
namespace cg = cooperative_groups;

typedef unsigned short u16;
typedef short bf16x8 __attribute__((ext_vector_type(8)));
typedef float f32x16 __attribute__((ext_vector_type(16)));
typedef unsigned int u32x4 __attribute__((ext_vector_type(4)));
typedef unsigned int u32x2 __attribute__((ext_vector_type(2)));
typedef float f32x4 __attribute__((ext_vector_type(4)));
#define DEV __device__ __forceinline__

constexpr int NROW = 16896;
constexpr int PSW = 2688;
constexpr int KPOS = 8448;
constexpr int LDS_BYTES = 73728;
constexpr float EPSV = 1e-6f;

constexpr size_t OFF_MOD = 0;
constexpr size_t OFF_TB1 = 294912;
constexpr size_t OFF_TA264 = OFF_TB1 + 16384;
constexpr size_t OFF_TA22 = OFF_TA264 + 32768;
constexpr size_t OFF_TCS = OFF_TA22 + 32768;
constexpr size_t OFF_TW = OFF_TCS + 65536;
constexpr size_t OFF_RT = OFF_TW + 65536;
constexpr size_t OFF_BAR = OFF_RT + 8192;
constexpr size_t OFF_KMAX = OFF_BAR + 15360;
constexpr size_t OFF_XC = OFF_BAR + 16384;
constexpr size_t OFF_H = OFF_XC + 2097152;
constexpr size_t OFF_WT = OFF_H + 34603008;
constexpr size_t WT_IN = 0;
constexpr size_t WT_BR = (size_t)6784 * 1024 * 2;
constexpr size_t WT_OUT = WT_BR + (size_t)4 * 1024 * 256 * 2;
constexpr size_t WT_UP = WT_OUT + (size_t)1024 * 1024 * 2;
constexpr size_t WT_DOWN = WT_UP + (size_t)5632 * 1024 * 2;
constexpr size_t WT_BYTES = WT_DOWN + (size_t)1024 * 2816 * 2;
constexpr size_t OFF_R1 = OFF_WT + WT_BYTES;
constexpr size_t R1_BYTES = (size_t)NROW * 5632 * 2;
constexpr size_t R1_PS = 0;
constexpr size_t R1_QR = (size_t)NROW * PSW * 2;
constexpr size_t R1_KR = R1_QR + 8650752;
constexpr size_t R1_VT = R1_KR + 8650752;
constexpr size_t R1_XRE = R1_VT + 8650752;
constexpr size_t R1_XIM = R1_XRE + 16777216;
constexpr size_t R1_DC = R1_XIM + 16777216;
constexpr size_t R1_DEC = R1_DC + (size_t)16 * 66 * 4160 * 4;
constexpr size_t R1_CP = R1_DEC + 8192;
constexpr size_t R1_END = R1_CP + (size_t)16 * 66 * 4160 * 2;
static_assert(R1_END <= R1_BYTES, "R1 overflow");
constexpr size_t OFF_R2 = OFF_R1 + R1_BYTES;
constexpr size_t R2_BR = 0;
constexpr size_t R2_Z = 34603008;

struct P {
  const float *x, *c, *ctx, *c_ctx, *w_ada, *b_ada, *norm_g, *w_in, *ml_conv_w, *ml_conv_b, *ml_gate_b, *ml_norm,
      *da_lam, *da_subln, *sg_norm, *sg_w, *sg_b, *w_branch, *w_out, *ffn_up, *ffn_conv_w, *ffn_conv_b, *ffn_down;
  float* out;
  char* ws;
  int ph0, ph1, coop, pad;
};

DEV int ltid() { int t = threadIdx.x; asm volatile("" : "+v"(t)); return t; }

#define XB_TMO      128
#define XB_XCNT(j)  (256  + 64 * (j))
#define XB_XSUB(j)  (1280 + 64 * (j))
#define XB_XGEN(j)  (2304 + 64 * (j))
#define XB_TOP      3328
#define XB_TOPGEN   3392
#define XCD_BAR_WORDS 3456
#define XB_SPIN_CAP (1u << 23)
#define LAS __attribute__((address_space(3)))
DEV unsigned xb_ld(unsigned* p) { return __hip_atomic_load(p, __ATOMIC_RELAXED, __HIP_MEMORY_SCOPE_AGENT); }
DEV unsigned xb_add(unsigned* p, unsigned v) { return __hip_atomic_fetch_add(p, v, __ATOMIC_RELAXED, __HIP_MEMORY_SCOPE_AGENT); }
DEV unsigned xb_xcc_id() { return (unsigned)__builtin_amdgcn_s_getreg((3 << 11) | 20) & 0xFu; }
#define XB_SPIN(cond, bar) do { unsigned _sp = 0; while (cond) { __builtin_amdgcn_s_sleep(1); \
    if ((++_sp & 255u) == 0u) { if (xb_ld(&(bar)[XB_TMO])) break; if (_sp > XB_SPIN_CAP) { atomicAdd(&(bar)[XB_TMO], 1u); break; } } } } while (0)
struct XcdBarrier { unsigned* bar; unsigned x; volatile LAS unsigned* st; };
DEV XcdBarrier xcd_barrier_post(unsigned* bar, volatile LAS unsigned* st) {
  XcdBarrier b; b.bar = bar; b.x = xb_xcc_id(); b.st = st;
  if (threadIdx.x == 0) (void)xb_add(&bar[XB_XCNT(b.x)], 1u);
  return b;
}
DEV void xcd_barrier_complete(unsigned* bar, unsigned x, unsigned& nloc, unsigned& nx) {
  const unsigned G = gridDim.x * gridDim.y * gridDim.z;
  unsigned sum, cnt, mine, sp = 0u;
  for (;;) {
    sum = 0u; cnt = 0u; mine = 0u;
#pragma unroll
    for (unsigned j = 0; j < 16; ++j) { const unsigned c = xb_ld(&bar[XB_XCNT(j)]); sum += c; cnt += (c > 0u) ? 1u : 0u; mine = (j == x) ? c : mine; }
    if (sum == G) break;
    __builtin_amdgcn_s_sleep(1);
    if ((++sp & 255u) == 0u) { if (xb_ld(&bar[XB_TMO])) break; if (sp > XB_SPIN_CAP) { atomicAdd(&bar[XB_TMO], 1u); break; } }
  }
  nloc = mine > 0u ? mine : 1u; nx = cnt > 0u ? cnt : 1u;
}
DEV void xcd_barrier(const XcdBarrier& b) {
  asm volatile("s_waitcnt vmcnt(0)" ::: "memory");
  __syncthreads();
  if (threadIdx.x == 0) {
    unsigned* bar = b.bar;
    __builtin_amdgcn_s_waitcnt(0);
    unsigned nloc = b.st[0], nx = b.st[1];
    if (nloc == 0u) { xcd_barrier_complete(bar, b.x, nloc, nx); b.st[0] = nloc; b.st[1] = nx; }
    const unsigned old = xb_add(&bar[XB_XSUB(b.x)], 1u);
    const unsigned gen = old / nloc;
    if (old + 1u == (gen + 1u) * nloc) {
      __builtin_amdgcn_fence(__ATOMIC_RELEASE, "agent");
      asm volatile("s_waitcnt vmcnt(0)" ::: "memory");
      const unsigned og = xb_add(&bar[XB_TOP], 1u);
      const unsigned tg = og / nx;
      if (og + 1u == (tg + 1u) * nx) xb_add(&bar[XB_TOPGEN], 1u);
      else XB_SPIN(xb_ld(&bar[XB_TOPGEN]) == tg, bar);
      __builtin_amdgcn_fence(__ATOMIC_ACQUIRE, "agent");
      xb_add(&bar[XB_XGEN(b.x)], 1u);
      asm volatile("s_waitcnt vmcnt(0)" ::: "memory");
    } else {
      XB_SPIN(xb_ld(&bar[XB_XGEN(b.x)]) == gen, bar);
      __builtin_amdgcn_fence(__ATOMIC_ACQUIRE, "agent");
      asm volatile("s_waitcnt vmcnt(0)" ::: "memory");
    }
  }
  __syncthreads();
}

DEV float bf2f(u16 h) { return __uint_as_float(((unsigned)h) << 16); }
typedef __bf16 hwbf16x2 __attribute__((ext_vector_type(2)));
typedef float f32x2 __attribute__((ext_vector_type(2)));
DEV unsigned pack2(float a, float b) { f32x2 v = {a, b}; hwbf16x2 r = __builtin_convertvector(v, hwbf16x2); return __builtin_bit_cast(unsigned, r); }
DEV u16 f2bf(float f) { return (u16)pack2(f, f); }
DEV float bflo(unsigned u) { return __uint_as_float(u << 16); }
DEV float bfhi(unsigned u) { return __uint_as_float(u & 0xffff0000u); }
DEV float sigmoidf_(float x) { return __builtin_amdgcn_rcpf(1.f + __expf(-x)); }
DEV float siluf_(float x) { return x * __builtin_amdgcn_rcpf(1.f + __expf(-x)); }
DEV float geluf_(float x) { return x * __builtin_amdgcn_rcpf(1.f + __expf(-1.5957691216057308f * (x + 0.044715f * x * x * x))); }
DEV float xmax32(float v) { auto r = __builtin_amdgcn_permlane32_swap(__float_as_uint(v), __float_as_uint(v), false, false); return fmaxf(__uint_as_float(r[0]), __uint_as_float(r[1])); }
DEV float xsum32(float v) { auto r = __builtin_amdgcn_permlane32_swap(__float_as_uint(v), __float_as_uint(v), false, false); return __uint_as_float(r[0]) + __uint_as_float(r[1]); }
DEV int rowmap(int i, int hh) { return (i & 3) + 8 * (i >> 2) + 4 * hh; }
DEV f32x16 mfma(bf16x8 a, bf16x8 b, f32x16 c) { return __builtin_amdgcn_mfma_f32_32x32x16_bf16(a, b, c, 0, 0, 0); }

template <int MI, int NI>
DEV void mma_lds(const u16* sA, int lda, int rowA0, const u16* sB, int ldb, int rowB0, int K, f32x16 (&acc)[MI][NI], int lane) {
  const int r = lane & 31, h = lane >> 5;
  for (int k0 = 0; k0 < K; k0 += 16) {
    bf16x8 a[MI], b[NI];
#pragma unroll
    for (int mi = 0; mi < MI; ++mi) a[mi] = *(const bf16x8*)(sA + (size_t)(rowA0 + mi * 32 + r) * lda + k0 + h * 8);
#pragma unroll
    for (int ni = 0; ni < NI; ++ni) b[ni] = *(const bf16x8*)(sB + (size_t)(rowB0 + ni * 32 + r) * ldb + k0 + h * 8);
#pragma unroll
    for (int mi = 0; mi < MI; ++mi)
#pragma unroll
      for (int ni = 0; ni < NI; ++ni) acc[mi][ni] = mfma(a[mi], b[ni], acc[mi][ni]);
  }
}

DEV int rowmap16(int i, int lane) { return ((i >> 3) & 1) * 16 + (lane >> 4) * 4 + (i & 3); }
DEV int colmap16(int i, int lane) { return ((i >> 2) & 1) * 16 + (lane & 15); }
template <int NI>
DEV void gemm_main(const u16* __restrict__ A, int lda, const u16* __restrict__ Bt, int ldb, int K, f32x16 (&acc)[2][NI], char* smem, int bsplit = 0) {
  constexpr int ABYTES = 128 * 128, STG = ABYTES + NI * 64 * 128;
  const int tid = ltid(), lane = tid & 63, w = tid >> 6, wr = w >> 1, wc = w & 1;
  const int r15 = lane & 15, q4 = lane >> 4;
  const int nk = K / 64;
  const unsigned lbase = (unsigned)(size_t)smem + tid * 16;
  const int sw = (r15 >> 1) & 7;
  const int co = ((tid & 7) ^ ((tid >> 4) & 7)) * 8;
  const u16* Ap = A + (size_t)(tid >> 3) * lda + co;
  const u16* Bp = Bt + (size_t)(tid >> 3) * ldb + co;
  f32x4 c[4][NI * 2];
#pragma unroll
  for (int m = 0; m < 4; ++m)
#pragma unroll
    for (int n = 0; n < NI * 2; ++n)
#pragma unroll
      for (int j = 0; j < 4; ++j) c[m][n][j] = acc[m >> 1][n >> 1][((m & 1) * 2 + (n & 1)) * 4 + j];
#define GLDS(kt, stg)                                                                                             \
  {                                                                                                               \
    _Pragma("unroll") for (int i = 0; i < 4; ++i)                                                                 \
      __builtin_amdgcn_global_load_lds((const unsigned*)(Ap + (size_t)(i * 32) * lda + (kt) * 64), (LAS unsigned*)(lbase + (stg) * STG + i * 4096), 16, 0, 0); \
    _Pragma("unroll") for (int i = 0; i < NI * 2; ++i)                                                            \
      __builtin_amdgcn_global_load_lds((const unsigned*)(Bp + (size_t)(i * 32 + (i >= NI ? bsplit : 0)) * ldb + (kt) * 64), (LAS unsigned*)(lbase + (stg) * STG + ABYTES + i * 4096), 16, 0, 0); \
  }
  GLDS(0, 0);
  asm volatile("s_waitcnt vmcnt(0)" ::: "memory");
  __builtin_amdgcn_s_barrier();
  for (int kt = 0; kt < nk; ++kt) {
    if (kt + 1 < nk) GLDS(kt + 1, (kt + 1) & 1);
    __builtin_amdgcn_sched_barrier(0);
    const char* base = smem + (kt & 1) * STG;
#pragma unroll
    for (int kk = 0; kk < 2; ++kk) {
      bf16x8 a[4], b[NI * 2];
      const int so = ((kk * 4 + q4) ^ sw) * 16;
#pragma unroll
      for (int m = 0; m < 4; ++m) a[m] = *(const bf16x8*)(base + (wr * 64 + m * 16 + r15) * 128 + so);
#pragma unroll
      for (int n = 0; n < NI * 2; ++n) b[n] = *(const bf16x8*)(base + ABYTES + (wc * NI * 32 + n * 16 + r15) * 128 + so);
#pragma unroll
      for (int m = 0; m < 4; ++m)
#pragma unroll
        for (int n = 0; n < NI * 2; ++n) c[m][n] = __builtin_amdgcn_mfma_f32_16x16x32_bf16(a[m], b[n], c[m][n], 0, 0, 0);
    }
    __builtin_amdgcn_sched_barrier(0);
    asm volatile("s_waitcnt vmcnt(0)" ::: "memory");
    __builtin_amdgcn_s_barrier();
  }
#undef GLDS
#pragma unroll
  for (int m = 0; m < 4; ++m)
#pragma unroll
    for (int n = 0; n < NI * 2; ++n)
#pragma unroll
      for (int j = 0; j < 4; ++j) acc[m >> 1][n >> 1][((m & 1) * 2 + (n & 1)) * 4 + j] = c[m][n][j];
}

template <int NI>
DEV void zero_acc(f32x16 (&acc)[2][NI]) {
#pragma unroll
  for (int mi = 0; mi < 2; ++mi)
#pragma unroll
    for (int ni = 0; ni < NI; ++ni)
#pragma unroll
      for (int i = 0; i < 16; ++i) acc[mi][ni][i] = 0.f;
}

DEV void gemm_big_p(const u16* const (&Ap)[4], const u16* const (&Bp)[2], int K, f32x16 (&acc)[4][2], char* smem) {
  constexpr int ABYTES = 256 * 64, STG = ABYTES + 128 * 64;
  const int tid = ltid(), lane = tid & 63, w = tid >> 6, wr = w >> 1, wc = w & 1;
  const int r15 = lane & 15, q4 = lane >> 4;
  const int nk = K / 32;
  const unsigned lbase = (unsigned)(size_t)smem + tid * 16;
  const int so = (q4 ^ ((0x78 >> (((r15 >> 2) & 3) * 2)) & 3)) * 16;
  f32x4 c[8][4];
#pragma unroll
  for (int m = 0; m < 8; ++m)
#pragma unroll
    for (int n = 0; n < 4; ++n)
#pragma unroll
      for (int j = 0; j < 4; ++j) c[m][n][j] = acc[m >> 1][n >> 1][((m & 1) * 2 + (n & 1)) * 4 + j];
#define GLDS(kt, stg)                                                                                             \
  {                                                                                                               \
    _Pragma("unroll") for (int i = 0; i < 4; ++i)                                                                 \
      __builtin_amdgcn_global_load_lds((const unsigned*)(Ap[i] + (kt) * 32), (LAS unsigned*)(lbase + (stg) * STG + i * 4096), 16, 0, 0); \
    _Pragma("unroll") for (int i = 0; i < 2; ++i)                                                                 \
      __builtin_amdgcn_global_load_lds((const unsigned*)(Bp[i] + (kt) * 32), (LAS unsigned*)(lbase + (stg) * STG + ABYTES + i * 4096), 16, 0, 0); \
  }
  GLDS(0, 0);
  if (nk > 1) { GLDS(1, 1); asm volatile("s_waitcnt vmcnt(6)" ::: "memory"); }
  else asm volatile("s_waitcnt vmcnt(0)" ::: "memory");
  __builtin_amdgcn_s_barrier();
  int cur = 0;
  for (int kt = 0; kt < nk; ++kt) {
    int nxt2 = cur + 2; if (nxt2 >= 3) nxt2 -= 3;
    if (kt + 2 < nk) GLDS(kt + 2, nxt2);
    __builtin_amdgcn_sched_barrier(0);
    const char* base = smem + cur * STG;
    {
      bf16x8 a[8], b[4];
#pragma unroll
      for (int m = 0; m < 8; ++m) a[m] = *(const bf16x8*)(base + (wr * 128 + m * 16 + r15) * 64 + so);
#pragma unroll
      for (int n = 0; n < 4; ++n) b[n] = *(const bf16x8*)(base + ABYTES + (wc * 64 + n * 16 + r15) * 64 + so);
#pragma unroll
      for (int m = 0; m < 8; ++m)
#pragma unroll
        for (int n = 0; n < 4; ++n) c[m][n] = __builtin_amdgcn_mfma_f32_16x16x32_bf16(a[m], b[n], c[m][n], 0, 0, 0);
    }
    __builtin_amdgcn_sched_barrier(0);
    if (kt + 2 < nk) asm volatile("s_waitcnt vmcnt(6)" ::: "memory");
    else asm volatile("s_waitcnt vmcnt(0)" ::: "memory");
    __builtin_amdgcn_s_barrier();
    cur = cur + 1 == 3 ? 0 : cur + 1;
  }
#undef GLDS
#pragma unroll
  for (int m = 0; m < 8; ++m)
#pragma unroll
    for (int n = 0; n < 4; ++n)
#pragma unroll
      for (int j = 0; j < 4; ++j) acc[m >> 1][n >> 1][((m & 1) * 2 + (n & 1)) * 4 + j] = c[m][n][j];
}
DEV void gemm_big(const u16* __restrict__ A, int lda, const u16* __restrict__ Bt, int ldb, int K, f32x16 (&acc)[4][2], char* smem) {
  const int tid = ltid();
  const int co = ((tid & 3) ^ ((0x78 >> (((tid >> 4) & 3) * 2)) & 3)) * 8;
  const u16* a0 = A + (size_t)(tid >> 2) * lda + co;
  const u16* b0 = Bt + (size_t)(tid >> 2) * ldb + co;
  const u16* const Ap[4] = {a0, a0 + (size_t)64 * lda, a0 + (size_t)128 * lda, a0 + (size_t)192 * lda};
  const u16* const Bp[2] = {b0, b0 + (size_t)64 * ldb};
  gemm_big_p(Ap, Bp, K, acc, smem);
}
DEV void zero_big(f32x16 (&acc)[4][2]) {
#pragma unroll
  for (int mi = 0; mi < 4; ++mi)
#pragma unroll
    for (int ni = 0; ni < 2; ++ni)
#pragma unroll
      for (int i = 0; i < 16; ++i) acc[mi][ni][i] = 0.f;
}
template <class F>
DEV void banded(int bid, int nb, int MT, int NT, int W, F f) {
  const int TOT = MT * NT, x = bid & 7, j = bid >> 3, per = nb >> 3, chunk = (TOT + 7) >> 3;
  for (int q = j; q < chunk; q += per) {
    int t = x * chunk + q;
    if (t >= TOT) break;
    int band = t / (MT * W), r = t - band * MT * W;
    int mt = r / W, nt = band * W + r - mt * W;
    f(mt, nt);
  }
}

DEV void mod_item(const P& p, int item, char* smem) {
  float* sS = (float*)smem;
  float* sR = sS + 3072;
  const int tid = ltid();
  for (int i = tid; i < 3072; i += 256) {
    int v = i >> 10, k = i & 1023;
    float c = v < 2 ? p.c[v * 1024 + k] : p.c_ctx[k];
    sS[i] = c * __builtin_amdgcn_rcpf(1.f + __expf(-c));
  }
  __syncthreads();
  const int l = item / 48, cgp = item % 48, cc = tid & 31, kq = tid >> 5;
  const float* w = p.w_ada + (size_t)l * 1024 * 6144 + cgp * 128 + cc * 4;
  f32x4 a0 = {0.f, 0.f, 0.f, 0.f}, a1 = a0, a2 = a0;
#pragma unroll 8
  for (int k = kq * 128; k < kq * 128 + 128; ++k) {
    const f32x4 wv = *(const f32x4*)(w + (size_t)k * 6144);
    const float s0 = sS[k], s1 = sS[1024 + k], s2 = sS[2048 + k];
    a0 += wv * s0; a1 += wv * s1; a2 += wv * s2;
  }
#pragma unroll
  for (int e = 0; e < 4; ++e) {
    sR[(kq * 3 + 0) * 128 + cc * 4 + e] = a0[e];
    sR[(kq * 3 + 1) * 128 + cc * 4 + e] = a1[e];
    sR[(kq * 3 + 2) * 128 + cc * 4 + e] = a2[e];
  }
  __syncthreads();
  for (int o = tid; o < 384; o += 256) {
    int v = o >> 7, c2 = o & 127;
    float s_ = 0;
    for (int q = 0; q < 8; ++q) s_ += sR[(q * 3 + v) * 128 + c2];
    int col2 = cgp * 128 + c2;
    ((float*)(p.ws + OFF_MOD))[(l * 3 + v) * 6144 + col2] = s_ + p.b_ada[l * 6144 + col2];
  }
  __syncthreads();
}

DEV void tab_item(const P& p, int item) {
  u16* TB1 = (u16*)(p.ws + OFF_TB1);
  u16* TA264 = (u16*)(p.ws + OFF_TA264);
  u16* TA22 = (u16*)(p.ws + OFF_TA22);
  u16* TCS = (u16*)(p.ws + OFF_TCS);
  float* TW = (float*)(p.ws + OFF_TW);
  float* RT = (float*)(p.ws + OFF_RT);
  const int tid0 = ltid();
  for (int i = 0; i < 16; ++i) {
    int e = item * 4096 + i * 256 + tid0;
    float s, c;
    if (e < 8192) {
      int n = e >> 6, d = e & 63, m = ((n & 63) * d) & 63;
      sincospif(m / 32.f, &s, &c);
      TB1[e] = f2bf(n < 64 ? c : -s);
    } else if (e < 24576) {
      int q = e - 8192, r = q >> 7, j = q & 127, ka = r & 63, s1 = j & 63, m = (ka * s1) & 63;
      sincospif(m / 32.f, &s, &c);
      bool im = r >= 64, sec = j >= 64;
      float v = !im ? (sec ? s : c) : (sec ? c : -s);
      TA264[q] = f2bf(v);
    } else if (e < 40960) {
      int q = e - 24576, r = q >> 7, j = q & 127, ka = r & 63, s1 = j & 63;
      bool im = r >= 64, sec = j >= 64;
      float v = 0.f;
      if (ka < 2 && s1 < 2 && (im == sec)) v = (ka & s1) ? -1.f : 1.f;
      TA22[q] = f2bf(v);
    } else if (e < 73728) {
      int q = e - 40960, kb = q >> 8, j = q & 255, s2 = j & 127, m = (kb * s2) & 127;
      sincospif(m / 64.f, &s, &c);
      TCS[q] = f2bf(j < 128 ? c : s);
    } else if (e < 81920) {
      int q = e - 73728;
      sincospif(q / 4096.f, &s, &c);
      TW[2 * q] = c; TW[2 * q + 1] = s;
    } else if (e < 82944) {
      int q = e - 81920, pos = q >> 3, fi = q & 7;
      float fr = exp2f(-(float)fi * 0.125f * 13.287712379549449f);
      float ang = (float)pos * fr;
      double t = (double)ang * 0.3183098861837907;
      t -= 2.0 * floor(t * 0.5);
      sincospif((float)t, &s, &c);
      RT[2 * q] = c; RT[2 * q + 1] = s;
    }
  }
}

DEV void conv_item(const P& p, int l, int item, char* smem) {
  float* tile = (float*)smem;
  const int tid = ltid();
  char* WT = p.ws + OFF_WT;
  const float* src; u16* dst; int K, Nsrc, kt, nt, mode = 0;
  if (item < 1696) { src = p.w_in + (size_t)l * 1024 * 6672; K = 1024; Nsrc = 6672; dst = (u16*)(WT + WT_IN); kt = item % 16; nt = item / 16; mode = 1; }
  else if (item < 1952) { int q = item - 1696; int g = q >> 6; q &= 63; src = p.w_branch + (size_t)(l * 4 + g) * 256 * 1024; K = 256; Nsrc = 1024; dst = (u16*)(WT + WT_BR) + (size_t)g * 1024 * 256; kt = q % 4; nt = q / 4; }
  else if (item < 2208) { int q = item - 1952; src = p.w_out + (size_t)l * 1024 * 1024; K = 1024; Nsrc = 1024; dst = (u16*)(WT + WT_OUT); kt = q % 16; nt = q / 16; }
  else if (item < 3616) { int q = item - 2208; src = p.ffn_up + (size_t)l * 1024 * 5632; K = 1024; Nsrc = 5632; dst = (u16*)(WT + WT_UP); kt = q % 16; nt = q / 16; }
  else { int q = item - 3616; src = p.ffn_down + (size_t)l * 2816 * 1024; K = 2816; Nsrc = 1024; dst = (u16*)(WT + WT_DOWN); kt = q % 44; nt = q / 44; }
  int nd = nt * 64 + (tid & 15) * 4, ns = nd; bool valid = true;
  if (mode) {
    if (nd < 1024) ns = nd;
    else if (nd < 2560) ns = nd + 16;
    else if (nd < 2576) ns = 1024 + nd - 2560;
    else if (nd < 2688) valid = false;
    else ns = nd - 112;
  }
#pragma unroll
  for (int i = 0; i < 4; ++i) {
    int kk = (tid >> 4) + 16 * i;
    f32x4 v = {0.f, 0.f, 0.f, 0.f};
    if (valid) v = *(const f32x4*)(src + (size_t)(kt * 64 + kk) * Nsrc + ns);
    float* t = tile + kk * 65 + (tid & 15) * 4;
    t[0] = v[0]; t[1] = v[1]; t[2] = v[2]; t[3] = v[3];
  }
  __syncthreads();
  const int n = tid >> 2, kq = tid & 3;
  unsigned pk[8];
#pragma unroll
  for (int j = 0; j < 8; ++j) pk[j] = pack2(tile[(kq * 16 + 2 * j) * 65 + n], tile[(kq * 16 + 2 * j + 1) * 65 + n]);
  u32x4* d = (u32x4*)(dst + (size_t)(nt * 64 + n) * K + kt * 64 + kq * 16);
  d[0] = u32x4{pk[0], pk[1], pk[2], pk[3]};
  d[1] = u32x4{pk[4], pk[5], pk[6], pk[7]};
  __syncthreads();
}

DEV float dpp_add(float v, int ctrl_is) { return v; }
DEV float wave_sum(float v) {
  int x = __float_as_int(v);
  v += __int_as_float(__builtin_amdgcn_update_dpp(0, x, 0xB1, 0xF, 0xF, true));
  x = __float_as_int(v);
  v += __int_as_float(__builtin_amdgcn_update_dpp(0, x, 0x4E, 0xF, 0xF, true));
  x = __float_as_int(v);
  v += __int_as_float(__builtin_amdgcn_update_dpp(0, x, 0x141, 0xF, 0xF, true));
  x = __float_as_int(v);
  v += __int_as_float(__builtin_amdgcn_update_dpp(0, x, 0x140, 0xF, 0xF, true));
  x = __float_as_int(v);
  return __int_as_float(__builtin_amdgcn_readlane(x, 0)) + __int_as_float(__builtin_amdgcn_readlane(x, 16)) +
         __int_as_float(__builtin_amdgcn_readlane(x, 32)) + __int_as_float(__builtin_amdgcn_readlane(x, 48));
}

DEV void rowpass_item(const P& p, int l, int mode, int item) {
  const int tid0 = ltid(); const int w = tid0 >> 6, lane = tid0 & 63, r = item * 4 + w;
  const int vec = r < 8192 ? 0 : (r < 16384 ? 1 : 2);
  float* X = r < 16384 ? p.out + (size_t)r * 1024 : (float*)(p.ws + OFF_XC) + (size_t)(r - 16384) * 1024;
  const float* MOD = (const float*)(p.ws + OFF_MOD);
  const int lh = (mode == 2) ? l + 1 : l;
  const bool doh = lh < 4;
  const int lhc = doh ? lh : 3;
  const float* xsrc = mode == 0 ? (r < 16384 ? p.x + (size_t)r * 1024 : p.ctx + (size_t)(r - 16384) * 1024) : X;
  const float* Y = (const float*)(p.ws + OFF_R1) + (size_t)r * 1024;
  const float* gate = MOD + (size_t)(l * 3 + vec) * 6144 + (mode == 1 ? 2 : 5) * 1024;
  const float* gp = p.norm_g + (size_t)(l * 4 + (mode == 1 ? 1 : 3)) * 1024;
  const float* g = p.norm_g + (size_t)(lhc * 4 + (mode == 1 ? 2 : 0)) * 1024;
  const float* sc = MOD + (size_t)(lhc * 3 + vec) * 6144 + (mode == 1 ? 4 : 1) * 1024;
  const float* sh = MOD + (size_t)(lhc * 3 + vec) * 6144 + (mode == 1 ? 3 : 0) * 1024;
  f32x4 xq[4], yq[4], gq[4], nq[4], hq[4], s1q[4], s0q[4];
#pragma unroll
  for (int i = 0; i < 4; ++i) {
    xq[i] = *(const f32x4*)(xsrc + i * 256 + lane * 4);
    if (mode != 0) {
      yq[i] = *(const f32x4*)(Y + i * 256 + lane * 4);
      gq[i] = *(const f32x4*)(gate + i * 256 + lane * 4);
      nq[i] = *(const f32x4*)(gp + i * 256 + lane * 4);
    }
    hq[i] = *(const f32x4*)(g + i * 256 + lane * 4);
    s1q[i] = *(const f32x4*)(sc + i * 256 + lane * 4);
    s0q[i] = *(const f32x4*)(sh + i * 256 + lane * 4);
  }
  if (mode != 0) {
    float ss = 0;
#pragma unroll
    for (int i = 0; i < 4; ++i)
#pragma unroll
      for (int j = 0; j < 4; ++j) ss += yq[i][j] * yq[i][j];
    ss = wave_sum(ss);
    const float rs = rsqrtf(ss * (1.f / 1024.f) + EPSV);
#pragma unroll
    for (int i = 0; i < 4; ++i)
#pragma unroll
      for (int j = 0; j < 4; ++j) xq[i][j] += gq[i][j] * (yq[i][j] * rs * nq[i][j]);
  }
#pragma unroll
  for (int i = 0; i < 4; ++i) *(f32x4*)(X + i * 256 + lane * 4) = xq[i];
  if (doh) {
    float ss = 0;
#pragma unroll
    for (int i = 0; i < 4; ++i)
#pragma unroll
      for (int j = 0; j < 4; ++j) ss += xq[i][j] * xq[i][j];
    ss = wave_sum(ss);
    const float rs = rsqrtf(ss * (1.f / 1024.f) + EPSV);
    u16* H = (u16*)(p.ws + OFF_H) + (size_t)r * 1024;
#pragma unroll
    for (int i = 0; i < 4; ++i) {
      float h0 = xq[i][0] * rs * hq[i][0] * (1.f + s1q[i][0]) + s0q[i][0];
      float h1 = xq[i][1] * rs * hq[i][1] * (1.f + s1q[i][1]) + s0q[i][1];
      float h2 = xq[i][2] * rs * hq[i][2] * (1.f + s1q[i][2]) + s0q[i][2];
      float h3 = xq[i][3] * rs * hq[i][3] * (1.f + s1q[i][3]) + s0q[i][3];
      *(u32x2*)(H + i * 256 + lane * 4) = u32x2{pack2(h0, h1), pack2(h2, h3)};
    }
  }
}

DEV void gemm1_item(const P& p, int mt, int nt, char* smem) {
  f32x16 acc[2][2]; zero_acc<2>(acc);
  gemm_main<2>((const u16*)(p.ws + OFF_H) + (size_t)mt * 128 * 1024, 1024, (const u16*)(p.ws + OFF_WT + WT_IN) + (size_t)nt * 128 * 1024, 1024, 1024, acc, smem);
  const int tid0 = ltid(); const int lane = tid0 & 63, w = tid0 >> 6, wr = w >> 1, wc = w & 1, r31 = lane & 31, hh = lane >> 5;
  u16* PS = (u16*)(p.ws + OFF_R1 + R1_PS);
#pragma unroll
  for (int mi = 0; mi < 2; ++mi)
#pragma unroll
    for (int ni = 0; ni < 2; ++ni)
#pragma unroll
      for (int i = 0; i < 16; ++i) {
        int row = mt * 128 + wr * 64 + mi * 32 + rowmap16(i, lane), col = nt * 128 + wc * 64 + ni * 32 + colmap16(i, lane);
        PS[(size_t)row * PSW + col] = f2bf(acc[mi][ni][i]);
      }
}

template <int NI>
DEV void merge_item(const P& p, int mt, int nt, char* smem) {
  f32x16 z[2][NI]; zero_acc<NI>(z);
  const u16* H = (const u16*)(p.ws + OFF_H) + (size_t)mt * 128 * 1024;
  const u16* BR = (const u16*)(p.ws + OFF_R2 + R2_BR) + (size_t)mt * 128 * 1024;
  const u16* WinT = (const u16*)(p.ws + OFF_WT + WT_IN);
  const u16* WbrT = (const u16*)(p.ws + OFF_WT + WT_BR);
#pragma unroll 1
  for (int g = 0; g < 4; ++g) {
    unsigned yp[2][NI][8];
    {
      f32x16 ay[2][NI]; zero_acc<NI>(ay);
      gemm_main<NI>(BR + g * 256, 1024, WbrT + (size_t)(g * 1024 + nt * NI * 64) * 256, 256, 256, ay, smem);
#pragma unroll
      for (int mi = 0; mi < 2; ++mi)
#pragma unroll
        for (int ni = 0; ni < NI; ++ni)
#pragma unroll
          for (int j = 0; j < 8; ++j) yp[mi][ni][j] = pack2(ay[mi][ni][2 * j], ay[mi][ni][2 * j + 1]);
      __builtin_amdgcn_sched_barrier(0);
    }
    f32x16 ag[2][NI]; zero_acc<NI>(ag);
    gemm_main<NI>(H, 1024, WinT + (size_t)(2688 + g * 1024 + nt * NI * 64) * 1024, 1024, 1024, ag, smem);
#pragma unroll
    for (int mi = 0; mi < 2; ++mi)
#pragma unroll
      for (int ni = 0; ni < NI; ++ni)
#pragma unroll
        for (int j = 0; j < 8; ++j) {
          const unsigned y2 = yp[mi][ni][j];
          z[mi][ni][2 * j] += sigmoidf_(ag[mi][ni][2 * j]) * bflo(y2);
          z[mi][ni][2 * j + 1] += sigmoidf_(ag[mi][ni][2 * j + 1]) * bfhi(y2);
        }
  }
  const int tid0 = ltid(); const int lane = tid0 & 63, w = tid0 >> 6, wr = w >> 1, wc = w & 1, r31 = lane & 31, hh = lane >> 5;
  u16* Z = (u16*)(p.ws + OFF_R2 + R2_Z);
#pragma unroll
  for (int mi = 0; mi < 2; ++mi)
#pragma unroll
    for (int ni = 0; ni < NI; ++ni)
#pragma unroll
      for (int i = 0; i < 16; ++i) {
        int row = mt * 128 + wr * 64 + mi * 32 + rowmap16(i, lane), col = nt * NI * 64 + wc * NI * 32 + ni * 32 + colmap16(i, lane);
        Z[(size_t)row * 1024 + col] = f2bf(z[mi][ni][i]);
      }
}

DEV void gemm_f32_big(const u16* A, int K, const u16* Bt, float* O, int mt, int nt, char* smem) {
  f32x16 acc[2][2]; zero_acc<2>(acc);
  gemm_main<2>(A + (size_t)mt * 128 * K, K, Bt + (size_t)nt * 128 * K, K, K, acc, smem);
  const int tid0 = ltid(); const int lane = tid0 & 63, w = tid0 >> 6, wr = w >> 1, wc = w & 1, r31 = lane & 31, hh = lane >> 5;
#pragma unroll
  for (int mi = 0; mi < 2; ++mi)
#pragma unroll
    for (int ni = 0; ni < 2; ++ni)
#pragma unroll
      for (int i = 0; i < 16; ++i) {
        int row = mt * 128 + wr * 64 + mi * 32 + rowmap16(i, lane), col = nt * 128 + wc * 64 + ni * 32 + colmap16(i, lane);
        O[(size_t)row * 1024 + col] = acc[mi][ni][i];
      }
}
DEV void gemm_f32_small(const u16* A, int K, const u16* Bt, float* O, int item, char* smem) {
  const int mt = item >> 4, nt = item & 15;
  f32x16 acc[2][1]; zero_acc<1>(acc);
  gemm_main<1>(A + (size_t)(16384 + mt * 128) * K, K, Bt + (size_t)nt * 64 * K, K, K, acc, smem);
  const int tid0 = ltid(); const int lane = tid0 & 63, w = tid0 >> 6, wr = w >> 1, wc = w & 1, r31 = lane & 31, hh = lane >> 5;
#pragma unroll
  for (int mi = 0; mi < 2; ++mi)
#pragma unroll
    for (int i = 0; i < 16; ++i) {
      int row = 16384 + mt * 128 + wr * 64 + mi * 32 + rowmap16(i, lane), col = nt * 64 + wc * 32 + colmap16(i, lane);
      O[(size_t)row * 1024 + col] = acc[mi][0][i];
    }
}

DEV void seq_bounds(int r, int& s0, int& s1) {
  if (r < 16384) { s0 = r & ~8191; s1 = s0 + 8192; } else { s0 = 16384 + ((r - 16384) & ~255); s1 = s0 + 256; }
}

DEV void upact_item(const P& p, int l, int mt, int nt, char* smem) {
  const int tid = ltid();
  const int srow = mt * 254 - 1;
  const u16* H = (const u16*)(p.ws + OFF_H);
  const u16* W = (const u16*)(p.ws + OFF_WT + WT_UP);
  const u16* Ap[4];
#pragma unroll
  for (int i = 0; i < 4; ++i) {
    int gr = srow + (tid >> 2) + 64 * i;
    gr = gr < 0 ? 0 : (gr > NROW - 1 ? NROW - 1 : gr);
    Ap[i] = H + (size_t)gr * 1024 + ((tid & 3) ^ ((0x78 >> (((tid >> 4) & 3) * 2)) & 3)) * 8;
  }
  const int co = ((tid & 3) ^ ((0x78 >> (((tid >> 4) & 3) * 2)) & 3)) * 8;
  const u16* const Bp[2] = {W + (size_t)(nt * 64 + (tid >> 2)) * 1024 + co, W + (size_t)(2816 + nt * 64 + (tid >> 2)) * 1024 + co};
  f32x16 acc[4][2]; zero_big(acc);
  {
    const u16* const Ap2[4] = {Ap[0], Ap[1], Ap[2], Ap[3]};
    gemm_big_p(Ap2, Bp, 1024, acc, smem);
  }
  const int lane = tid & 63, w = tid >> 6, wr = w >> 1, wc = w & 1, r31 = lane & 31, hh = lane >> 5;
  u16* sU = (u16*)smem;
#pragma unroll
  for (int mi = 0; mi < 4; ++mi)
#pragma unroll
    for (int ni = 0; ni < 2; ++ni)
#pragma unroll
      for (int i = 0; i < 16; ++i) sU[(wr * 128 + mi * 32 + rowmap16(i, lane)) * 136 + wc * 64 + ni * 32 + colmap16(i, lane)] = f2bf(acc[mi][ni][i]);
  __syncthreads();
  const int cg_ = tid & 7, col = nt * 64 + cg_ * 8;
  const float* cw = p.ffn_conv_w + (size_t)l * 3 * 2816 + col;
  const float* cb = p.ffn_conv_b + (size_t)l * 2816 + col;
  float w0[8], w1[8], w2[8], bb[8];
#pragma unroll
  for (int q = 0; q < 2; ++q) {
    f32x4 t0 = *(const f32x4*)(cw + q * 4), t1 = *(const f32x4*)(cw + 2816 + q * 4), t2 = *(const f32x4*)(cw + 5632 + q * 4), t3 = *(const f32x4*)(cb + q * 4);
#pragma unroll
    for (int e = 0; e < 4; ++e) { w0[q * 4 + e] = t0[e]; w1[q * 4 + e] = t1[e]; w2[q * 4 + e] = t2[e]; bb[q * 4 + e] = t3[e]; }
  }
  u16* ACT = (u16*)(p.ws + OFF_R2);
  for (int k = 0; k < 8; ++k) {
    const int idx = tid + k * 256, rr = 1 + (idx >> 3);
    const int R = srow + rr;
    if (rr <= 254 && R < NROW) {
      int s0, s1; seq_bounds(R, s0, s1);
      const u32x4 z4 = {0, 0, 0, 0};
      const u32x4 am = (R - 1 >= s0) ? *(const u32x4*)(sU + (rr - 1) * 136 + cg_ * 8) : z4;
      const u32x4 a0 = *(const u32x4*)(sU + rr * 136 + cg_ * 8);
      const u32x4 ap = (R + 1 < s1) ? *(const u32x4*)(sU + (rr + 1) * 136 + cg_ * 8) : z4;
      const u32x4 gg = *(const u32x4*)(sU + rr * 136 + 64 + cg_ * 8);
      float o[8];
#pragma unroll
      for (int j = 0; j < 4; ++j) {
        float v0 = w0[2 * j] * bflo(am[j]) + w1[2 * j] * bflo(a0[j]) + w2[2 * j] * bflo(ap[j]) + bb[2 * j];
        float v1 = w0[2 * j + 1] * bfhi(am[j]) + w1[2 * j + 1] * bfhi(a0[j]) + w2[2 * j + 1] * bfhi(ap[j]) + bb[2 * j + 1];
        o[2 * j] = siluf_(v0) * bflo(gg[j]);
        o[2 * j + 1] = siluf_(v1) * bfhi(gg[j]);
      }
      *(u32x4*)(ACT + (size_t)R * 2816 + col) = u32x4{pack2(o[0], o[1]), pack2(o[2], o[3]), pack2(o[4], o[5]), pack2(o[6], o[7])};
    }
  }
  __syncthreads();
}

DEV void attnprep_item(const P& p, int tl, char* smem) {
  const int tid = ltid();
  const u16* PS = (const u16*)(p.ws + OFF_R1 + R1_PS);
  u16* QR = (u16*)(p.ws + OFF_R1 + R1_QR);
  u16* KR = (u16*)(p.ws + OFF_R1 + R1_KR);
  u16* VT = (u16*)(p.ws + OFF_R1 + R1_VT);
  const float* RT = (const float*)(p.ws + OFF_RT);
  const int r0 = tl * 128;
  const bool lat = r0 < 16384;
  const int b = lat ? (r0 >> 13) : ((r0 - 16384) >> 8);
  const int pos0 = lat ? (r0 & 8191) : 8192 + ((r0 - 16384) & 255);
  const float QS = 0.17677669529663687f * 1.4426950408889634f;
  unsigned* sKm = (unsigned*)(smem + 70656);
  if (tid < 8) sKm[tid] = 0u;
  __syncthreads();
  for (int it = 0; it < 4; ++it) {
    int task = tid + it * 256, tok = task >> 3, hc = task & 7, h = hc >> 1, c = hc & 1;
    int r = r0 + tok, pos = pos0 + tok;
    int rowi = (pos >> 6) & 127, coli = pos & 63;
    for (int qk = 0; qk < 2; ++qk) {
      const u16* src = PS + (size_t)r * PSW + (qk ? 1280 : 1024) + h * 64 + c * 32;
      float v[32];
#pragma unroll
      for (int j = 0; j < 4; ++j) {
        u32x4 u = *(const u32x4*)(src + j * 8);
#pragma unroll
        for (int e = 0; e < 4; ++e) { v[j * 8 + 2 * e] = bflo(u[e]); v[j * 8 + 2 * e + 1] = bfhi(u[e]); }
      }
      float o[32];
      if (lat) {
#pragma unroll
        for (int a = 0; a < 2; ++a) {
          int pa = a == 0 ? rowi : coli;
#pragma unroll
          for (int i = 0; i < 8; ++i) {
            float cs = RT[(pa * 8 + i) * 2], sn = RT[(pa * 8 + i) * 2 + 1];
            float x1 = v[a * 16 + i], x2 = v[a * 16 + 8 + i];
            o[a * 16 + i] = x1 * cs - x2 * sn;
            o[a * 16 + 8 + i] = x2 * cs + x1 * sn;
          }
        }
      } else {
#pragma unroll
        for (int i = 0; i < 32; ++i) o[i] = v[i];
      }
      const float sc = qk ? 1.f : QS;
      if (qk) {
        float ssk = 0.f;
#pragma unroll
        for (int i = 0; i < 32; ++i) { float t = bf2f(f2bf(o[i])); ssk += t * t; }
        ssk = fmaxf(ssk, __shfl_xor(ssk, 8)); ssk = fmaxf(ssk, __shfl_xor(ssk, 16)); ssk = fmaxf(ssk, __shfl_xor(ssk, 32));
        if ((tid & 63) < 8) atomicMax(&sKm[hc], __float_as_uint(ssk));
      }
      u16* dst = (qk ? KR : QR) + ((size_t)((b * 4 + h) * 2 + c) * KPOS + pos) * 32;
#pragma unroll
      for (int j = 0; j < 4; ++j)
        *(u32x4*)(dst + j * 8) = u32x4{pack2(o[j * 8] * sc, o[j * 8 + 1] * sc), pack2(o[j * 8 + 2] * sc, o[j * 8 + 3] * sc),
                                       pack2(o[j * 8 + 4] * sc, o[j * 8 + 5] * sc), pack2(o[j * 8 + 6] * sc, o[j * 8 + 7] * sc)};
    }
  }
  u16* sV = (u16*)smem;
  for (int it = 0; it < 16; ++it) {
    int ch = tid + it * 256, tok = ch & 127, cc = ch >> 7;
    u32x4 u = *(const u32x4*)(PS + (size_t)(r0 + tok) * PSW + 1536 + cc * 8);
    const int tokp = (tok & ~12) | ((tok & 4) << 1) | ((tok & 8) >> 1);
#pragma unroll
    for (int e = 0; e < 4; ++e) {
      sV[(cc * 8 + 2 * e) * 136 + tokp] = (u16)(u[e] & 0xffff);
      sV[(cc * 8 + 2 * e + 1) * 136 + tokp] = (u16)(u[e] >> 16);
    }
  }
  __syncthreads();
  if (tid < 8) atomicMax((unsigned*)(p.ws + OFF_KMAX) + (b * 4 + (tid >> 1)) * 2 + (tid & 1), sKm[tid]);
  {
    int hv = tid;
    u16* dst = VT + ((size_t)(b * 4) * 64 + hv) * KPOS + pos0;
#pragma unroll
    for (int j = 0; j < 16; ++j) *(u32x4*)(dst + j * 8) = *(const u32x4*)(sV + hv * 136 + j * 8);
  }
  __syncthreads();
}

DEV void ml_gates(const P& p, int l, int h, int r0, float* sG) {
  const int tid = ltid(), lane = tid & 63, w = tid >> 6;
  const u16* PS = (const u16*)(p.ws + OFF_R1 + R1_PS);
  {
    int t = tid & 127, d = tid >> 7;
    const u16* g = PS + (size_t)(r0 + t) * PSW + 2560 + d * 8;
    float ig = bf2f(g[h]) + p.ml_gate_b[((l * 2 + d) * 2 + 0) * 4 + h];
    float fg = bf2f(g[4 + h]) + p.ml_gate_b[((l * 2 + d) * 2 + 1) * 4 + h];
    float lf = fminf(fg, 0.f) - __logf(1.f + __expf(-fabsf(fg)));
    sG[d * 128 + t] = ig;
    sG[(4 + d) * 128 + t] = lf;
  }
  __syncthreads();
  if (w == 0) {
    float a = sG[4 * 128 + 2 * lane], b2 = sG[4 * 128 + 2 * lane + 1];
    float s = a + b2, incl = s;
#pragma unroll
    for (int off = 1; off < 64; off <<= 1) { float t = __shfl_up(incl, off); if (lane >= off) incl += t; }
    float excl = incl - s;
    sG[2 * 128 + 2 * lane] = excl + a;
    sG[2 * 128 + 2 * lane + 1] = excl + a + b2;
  } else if (w == 1) {
    float a = sG[5 * 128 + 2 * lane], b2 = sG[5 * 128 + 2 * lane + 1];
    float s = a + b2, incl = s;
#pragma unroll
    for (int off = 1; off < 64; off <<= 1) { float t = __shfl_down(incl, off); if (lane + off < 64) incl += t; }
    float excl = incl - s;
    sG[3 * 128 + 2 * lane + 1] = excl + b2;
    sG[3 * 128 + 2 * lane] = excl + b2 + a;
  }
  __syncthreads();
}

DEV void ml_conv8(const P& p, int l, const u16* PS, int r, int s0, int s1, int col, float scale, float* o) {
  u32x4 z4 = {0, 0, 0, 0};
  u32x4 am = (r - 1 >= s0) ? *(const u32x4*)(PS + (size_t)(r - 1) * PSW + col) : z4;
  u32x4 a0 = *(const u32x4*)(PS + (size_t)r * PSW + col);
  u32x4 ap = (r + 1 < s1) ? *(const u32x4*)(PS + (size_t)(r + 1) * PSW + col) : z4;
  const float* cw = p.ml_conv_w + (size_t)l * 3 * 512 + col;
  const float* cb = p.ml_conv_b + (size_t)l * 512 + col;
  f32x4 w0[2], w1[2], w2[2], bb[2];
#pragma unroll
  for (int q = 0; q < 2; ++q) {
    w0[q] = *(const f32x4*)(cw + q * 4); w1[q] = *(const f32x4*)(cw + 512 + q * 4); w2[q] = *(const f32x4*)(cw + 1024 + q * 4);
    bb[q] = *(const f32x4*)(cb + q * 4);
  }
#pragma unroll
  for (int j = 0; j < 4; ++j) {
    const int q = j >> 1, e = (j & 1) * 2;
    float v0 = w0[q][e] * bflo(am[j]) + w1[q][e] * bflo(a0[j]) + w2[q][e] * bflo(ap[j]) + bb[q][e];
    float v1 = w0[q][e + 1] * bfhi(am[j]) + w1[q][e + 1] * bfhi(a0[j]) + w2[q][e + 1] * bfhi(ap[j]) + bb[q][e + 1];
    o[2 * j] = siluf_(v0) * scale;
    o[2 * j + 1] = siluf_(v1) * scale;
  }
}

DEV void ml_decode(int item, int& b, int& h, int& cidx, int& r0) {
  if (item < 512) { b = item >> 8; h = (item >> 6) & 3; cidx = item & 63; }
  else { int q = item - 512; b = q >> 3; h = (q >> 1) & 3; cidx = 64 + (q & 1); }
  r0 = cidx < 64 ? b * 8192 + cidx * 128 : 16384 + b * 256 + (cidx - 64) * 128;
}

DEV void mla_item(const P& p, int l, int item, char* smem) {
  const int tid = ltid(), lane = tid & 63, w = tid >> 6, r31 = lane & 31, hh = lane >> 5;
  int b, h, cidx, r0; ml_decode(item, b, h, cidx, r0);
  int s0, s1; seq_bounds(r0, s0, s1);
  const u16* PS = (const u16*)(p.ws + OFF_R1 + R1_PS);
  float* sG = (float*)smem;
  float* sRed = (float*)(smem + 4096);
  u16* sB = (u16*)(smem + 5120);
  u16* sA0 = sB + 64 * 136;
  u16* sA1 = sA0 + 64 * 136;
  ml_gates(p, l, h, r0, sG);
  {
    int d = tid >> 7, s = tid & 127;
    float wd = d == 0 ? __expf(sG[2 * 128 + 127] - sG[2 * 128 + s] + sG[s]) : __expf(sG[3 * 128] - sG[3 * 128 + s] + sG[128 + s]);
    sG[(6 + d) * 128 + s] = wd;
  }
  __syncthreads();
  {
    int s = tid & 127, cgh = tid >> 7;
    float w0 = sG[6 * 128 + s], w1 = sG[7 * 128 + s];
    for (int i = 0; i < 4; ++i) {
      int cg_ = cgh * 4 + i;
      float o[8];
      ml_conv8(p, l, PS, r0 + s, s0, s1, 256 + h * 64 + cg_ * 8, 1.f, o);
#pragma unroll
      for (int j = 0; j < 8; ++j) sB[(cg_ * 8 + j) * 136 + s] = f2bf(o[j]);
      u32x4 u = *(const u32x4*)(PS + (size_t)(r0 + s) * PSW + 512 + h * 64 + cg_ * 8);
#pragma unroll
      for (int e = 0; e < 4; ++e) {
        float v0 = bflo(u[e]), v1 = bfhi(u[e]);
        sA0[(cg_ * 8 + 2 * e) * 136 + s] = f2bf(w0 * v0);
        sA0[(cg_ * 8 + 2 * e + 1) * 136 + s] = f2bf(w0 * v1);
        sA1[(cg_ * 8 + 2 * e) * 136 + s] = f2bf(w1 * v0);
        sA1[(cg_ * 8 + 2 * e + 1) * 136 + s] = f2bf(w1 * v1);
      }
    }
  }
  __syncthreads();
  const int d = w >> 1, ni = w & 1;
  f32x16 acc[2][1];
#pragma unroll
  for (int mi = 0; mi < 2; ++mi)
#pragma unroll
    for (int i = 0; i < 16; ++i) acc[mi][0][i] = 0.f;
  mma_lds<2, 1>(d ? sA1 : sA0, 136, 0, sB, 136, ni * 32, 128, acc, lane);
  float* DC = (float*)(p.ws + OFF_R1 + R1_DC);
  {
    float* dst = DC + ((size_t)(((b * 4 + h) * 2 + d) * 66 + cidx)) * 4160;
#pragma unroll
    for (int mi = 0; mi < 2; ++mi)
#pragma unroll
      for (int i = 0; i < 16; ++i) dst[(mi * 32 + rowmap(i, hh)) * 64 + ni * 32 + r31] = acc[mi][0][i];
    if (cidx >= 64) {
      u16* CPb = (u16*)(p.ws + OFF_R1 + R1_CP) + (size_t)(((b * 4 + h) * 2 + d) * 66) * 4160;
      if ((d == 0) == (cidx == 64)) {
#pragma unroll
        for (int mi = 0; mi < 2; ++mi)
#pragma unroll
          for (int i = 0; i < 16; ++i) {
            const int e_ = (mi * 32 + rowmap(i, hh)) * 64 + ni * 32 + r31;
            CPb[(size_t)(cidx ^ 1) * 4160 + e_] = f2bf(acc[mi][0][i]);
            CPb[(size_t)cidx * 4160 + e_] = (u16)0;
          }
      }
    }
  }
  {
    int k = tid & 63, dd = (tid >> 6) & 1, half = tid >> 7;
    float s = 0;
    for (int j = half * 64; j < half * 64 + 64; ++j) s += sG[(6 + dd) * 128 + j] * bf2f(sB[k * 136 + j]);
    sRed[tid] = s;
  }
  __syncthreads();
  if (tid < 128) {
    int k = tid & 63, dd = tid >> 6;
    DC[((size_t)(((b * 4 + h) * 2 + dd) * 66 + cidx)) * 4160 + 64 * 64 + k] = sRed[tid] + sRed[tid + 128];
    if (cidx >= 64) {
      u16* CPb = (u16*)(p.ws + OFF_R1 + R1_CP) + (size_t)(((b * 4 + h) * 2 + dd) * 66) * 4160;
      if ((dd == 0) == (cidx == 64)) {
        CPb[(size_t)(cidx ^ 1) * 4160 + 64 * 64 + k] = f2bf(sRed[tid] + sRed[tid + 128]);
        CPb[(size_t)cidx * 4160 + 64 * 64 + k] = (u16)0;
      }
    }
  }
  if (tid == 0) {
    float* DEC = (float*)(p.ws + OFF_R1 + R1_DEC);
    DEC[((b * 4 + h) * 2 + 0) * 66 + cidx] = expf(sG[2 * 128 + 127]);
    DEC[((b * 4 + h) * 2 + 1) * 66 + cidx] = expf(sG[3 * 128]);
  }
  __syncthreads();
}

DEV void scan_item(const P& p, int item) {
  const int seq = item >> 2, quarter = item & 3, d = seq & 1;
  const float* DC = (const float*)(p.ws + OFF_R1 + R1_DC) + (size_t)seq * 66 * 4160;
  const float* DEC = (const float*)(p.ws + OFF_R1 + R1_DEC) + seq * 66;
  u16* CP = (u16*)(p.ws + OFF_R1 + R1_CP) + (size_t)seq * 66 * 4160;
  float st[5];
  int e[5];
  const int tid0 = ltid();
#pragma unroll
  for (int i = 0; i < 5; ++i) { st[i] = 0.f; int q = tid0 + i * 256; e[i] = q < 1040 ? quarter * 1040 + q : quarter * 1040; }
  const bool last_ok = tid0 + 4 * 256 < 1040;
  for (int s0 = 0; s0 < 66; s0 += 6) {
    float dc[6][5], dec[6];
    int cx[6];
#pragma unroll
    for (int u = 0; u < 6; ++u) {
      int step = s0 + u;
      cx[u] = d == 0 ? (step < 2 ? 64 + step : step - 2) : (step < 2 ? 65 - step : 63 - (step - 2));
      dec[u] = DEC[cx[u]];
#pragma unroll
      for (int i = 0; i < 5; ++i) dc[u][i] = DC[(size_t)cx[u] * 4160 + e[i]];
    }
#pragma unroll
    for (int u = 0; u < 6; ++u) {
#pragma unroll
      for (int i = 0; i < 5; ++i) {
        if ((i < 4 || last_ok) && s0 + u >= 2) CP[(size_t)cx[u] * 4160 + e[i]] = f2bf(st[i]);
        st[i] = dec[u] * st[i] + dc[u][i];
      }
    }
  }
}

DEV void mlc_item(const P& p, int l, int item, char* smem) {
  const int tid = ltid(), lane = tid & 63, w = tid >> 6, r31 = lane & 31, hh = lane >> 5;
  int b, h, cidx, r0; ml_decode(item, b, h, cidx, r0);
  int s0, s1; seq_bounds(r0, s0, s1);
  const u16* PS = (const u16*)(p.ws + OFF_R1 + R1_PS);
  float* sG = (float*)smem;
  float* sN = (float*)(smem + 4096);
  u16* sK = (u16*)(smem + 4608);
  u16* sQ = sK + 128 * 72;
  u16* sC = sQ;
  u16* sVT = sQ + 128 * 72;
  ml_gates(p, l, h, r0, sG);
  {
    int d = tid >> 7, s = tid & 127;
    sG[(6 + d) * 128 + s] = sG[d * 128 + s] - sG[(2 + d) * 128 + s];
  }
  {
    for (int i = 0; i < 4; ++i) {
      int ch = tid + i * 256, s = ch >> 3, cg_ = ch & 7;
      float o[8];
      ml_conv8(p, l, PS, r0 + s, s0, s1, 256 + h * 64 + cg_ * 8, 1.f, o);
      *(u32x4*)(sK + s * 72 + cg_ * 8) = u32x4{pack2(o[0], o[1]), pack2(o[2], o[3]), pack2(o[4], o[5]), pack2(o[6], o[7])};
      ml_conv8(p, l, PS, r0 + s, s0, s1, h * 64 + cg_ * 8, 0.125f, o);
      *(u32x4*)(sQ + s * 72 + cg_ * 8) = u32x4{pack2(o[0], o[1]), pack2(o[2], o[3]), pack2(o[4], o[5]), pack2(o[6], o[7])};
    }
    int s = tid & 127, cgh = tid >> 7;
    for (int i = 0; i < 4; ++i) {
      int cg_ = cgh * 4 + i;
      u32x4 u = *(const u32x4*)(PS + (size_t)(r0 + s) * PSW + 512 + h * 64 + cg_ * 8);
#pragma unroll
      for (int e = 0; e < 4; ++e) {
        sVT[(cg_ * 8 + 2 * e) * 136 + s] = (u16)(u[e] & 0xffff);
        sVT[(cg_ * 8 + 2 * e + 1) * 136 + s] = (u16)(u[e] >> 16);
      }
    }
  }
  __syncthreads();
  bf16x8 qf[4];
#pragma unroll
  for (int ks = 0; ks < 4; ++ks) qf[ks] = *(const bf16x8*)(sQ + (w * 32 + r31) * 72 + ks * 16 + hh * 8);
  __syncthreads();
  {
    const u16* CP = (const u16*)(p.ws + OFF_R1 + R1_CP);
    for (int d = 0; d < 2; ++d) {
      const u16* src = CP + ((size_t)(((b * 4 + h) * 2 + d) * 66 + cidx)) * 4160;
      for (int ch = tid; ch < 64 * 8; ch += 256) {
        int rr = ch >> 3, cc = ch & 7;
        *(u32x4*)(sC + (d * 64 + rr) * 72 + cc * 8) = *(const u32x4*)(src + rr * 64 + cc * 8);
      }
      if (tid < 64) sN[d * 64 + tid] = bf2f(src[64 * 64 + tid]);
    }
  }
  __syncthreads();
  const int qloc = w * 32 + r31;
  f32x16 Hs[2];
#pragma unroll
  for (int vt = 0; vt < 2; ++vt)
#pragma unroll
    for (int i = 0; i < 16; ++i) Hs[vt][i] = 0.f;
#pragma unroll 1
  for (int d = 0; d < 2; ++d) {
    f32x16 R[2];
#pragma unroll
    for (int vt = 0; vt < 2; ++vt) {
#pragma unroll
      for (int i = 0; i < 16; ++i) R[vt][i] = 0.f;
#pragma unroll
      for (int ks = 0; ks < 4; ++ks) {
        bf16x8 a = *(const bf16x8*)(sC + (d * 64 + vt * 32 + r31) * 72 + ks * 16 + hh * 8);
        R[vt] = mfma(a, qf[ks], R[vt]);
      }
    }
    float nq = 0.f;
#pragma unroll
    for (int ks = 0; ks < 4; ++ks)
#pragma unroll
      for (int j = 0; j < 8; ++j) nq += sN[d * 64 + ks * 16 + hh * 8 + j] * bf2f((u16)qf[ks][j]);
    nq = xsum32(nq);
    const float Bq = sG[(2 + d) * 128 + qloc];
    const float eb = __expf(Bq);
    const int sgn = d == 0 ? 1 : -1;
#pragma unroll
    for (int vt = 0; vt < 2; ++vt)
#pragma unroll
      for (int i = 0; i < 16; ++i) R[vt][i] *= eb;
    float den = 0.f;
#pragma unroll 1
    for (int kt = 0; kt < 4; ++kt) {
      f32x16 X;
#pragma unroll
      for (int i = 0; i < 16; ++i) X[i] = 0.f;
#pragma unroll
      for (int ks = 0; ks < 4; ++ks) {
        bf16x8 a = *(const bf16x8*)(sK + (kt * 32 + r31) * 72 + ks * 16 + hh * 8);
        X = mfma(a, qf[ks], X);
      }
      float pv[16];
#pragma unroll
      for (int i = 0; i < 16; ++i) {
        int key = kt * 32 + rowmap(i, hh);
        int tdiff = sgn * (qloc - key);
        float wgt = __expf(Bq + sG[(6 + d) * 128 + key] + (float)min(tdiff, 0) * 1e30f);
        pv[i] = X[i] * wgt;
        den += pv[i];
      }
#pragma unroll
      for (int s = 0; s < 2; ++s) {
        u32x4 pu = {pack2(pv[8 * s], pv[8 * s + 1]), pack2(pv[8 * s + 2], pv[8 * s + 3]), pack2(pv[8 * s + 4], pv[8 * s + 5]), pack2(pv[8 * s + 6], pv[8 * s + 7])};
        bf16x8 pf = __builtin_bit_cast(bf16x8, pu);
        const int ks2 = kt * 2 + s;
#pragma unroll
        for (int vt = 0; vt < 2; ++vt) {
          const u16* vp = sVT + (vt * 32 + r31) * 136 + 16 * ks2 + 4 * hh;
          u32x2 lo = *(const u32x2*)vp, hi = *(const u32x2*)(vp + 8);
          u32x4 au = {lo[0], lo[1], hi[0], hi[1]};
          R[vt] = mfma(__builtin_bit_cast(bf16x8, au), pf, R[vt]);
        }
      }
    }
    den = xsum32(den);
    den += eb * nq;
    float inv = 1.f / fmaxf(fabsf(den), 1.f);
#pragma unroll
    for (int vt = 0; vt < 2; ++vt)
#pragma unroll
      for (int i = 0; i < 16; ++i) Hs[vt][i] += R[vt][i] * inv;
  }
  float ss = 0;
#pragma unroll
  for (int vt = 0; vt < 2; ++vt)
#pragma unroll
    for (int i = 0; i < 16; ++i) ss += Hs[vt][i] * Hs[vt][i];
  ss = xsum32(ss);
  const float rs = rsqrtf(ss * (1.f / 64.f) + EPSV);
  u16* BR = (u16*)(p.ws + OFF_R2 + R2_BR);
  const int row = r0 + qloc;
#pragma unroll
  for (int vt = 0; vt < 2; ++vt)
#pragma unroll
    for (int i = 0; i < 16; ++i) {
      int v = vt * 32 + rowmap(i, hh);
      float o = bf2f(PS[(size_t)row * PSW + 768 + h * 64 + v]);
      float val = Hs[vt][i] * rs * p.ml_norm[l * 256 + h * 64 + v] * sigmoidf_(o);
      BR[(size_t)row * 1024 + h * 64 + v] = f2bf(val);
    }
  __syncthreads();
}

DEV void attn_item(const P& p, int l, int item, char* smem, float lam, float lam_init) {
  const int tid = ltid(), lane = tid & 63, w = tid >> 6, r31 = lane & 31, hh = lane >> 5;
  const int c = w & 1, qs = w >> 1;
  int b, h, q0, key0, ntile;
  if (item < 1024) { b = item >> 9; h = (item >> 7) & 3; q0 = (item & 127) * 64; key0 = 0; ntile = 132; }
  else { int q = item - 1024; b = q >> 4; h = (q >> 2) & 3; q0 = 8192 + (q & 3) * 64; key0 = 8192; ntile = 4; }
  const int bh = b * 4 + h;
  const u16* QR = (const u16*)(p.ws + OFF_R1 + R1_QR);
  const u16* KR = (const u16*)(p.ws + OFF_R1 + R1_KR);
  const u16* VT = (const u16*)(p.ws + OFF_R1 + R1_VT);
  bf16x8 qf[2];
  {
    const u16* qb = QR + ((size_t)(bh * 2 + c) * KPOS + q0 + qs * 32 + r31) * 32;
    qf[0] = *(const bf16x8*)(qb + hh * 8);
    qf[1] = *(const bf16x8*)(qb + 16 + hh * 8);
  }
  constexpr int KB = 16384, STG = 32768;
  const unsigned lbase = (unsigned)(size_t)smem + tid * 16;
  const u16* kp0 = KR + ((size_t)(bh * 2) * KPOS + key0 + (tid >> 2)) * 32 + ((tid & 3) ^ ((tid >> 4) & 3)) * 8;
  const u16* vp0 = VT + ((size_t)bh * 64 + (tid >> 4)) * KPOS + key0 + ((tid & 15) ^ ((tid >> 4) & 15)) * 8;
#define AGLDS(kt, stg)                                                                                            \
  {                                                                                                               \
    _Pragma("unroll") for (int i = 0; i < 4; ++i)                                                                 \
      __builtin_amdgcn_global_load_lds((const unsigned*)(kp0 + (size_t)(i >> 1) * KPOS * 32 + (size_t)((i & 1) * 64 + (kt) * 128) * 32), \
                                       (LAS unsigned*)(lbase + (stg) * STG + i * 4096), 16, 0, 0);                \
    _Pragma("unroll") for (int i = 0; i < 4; ++i)                                                                 \
      __builtin_amdgcn_global_load_lds((const unsigned*)(vp0 + (size_t)(i * 16) * KPOS + (kt) * 128),             \
                                       (LAS unsigned*)(lbase + (stg) * STG + KB + i * 4096), 16, 0, 0);           \
  }
  f32x16 O[2], NEGM;
#pragma unroll
  for (int i = 0; i < 16; ++i) { O[0][i] = 0.f; O[1][i] = 0.f; }
  float lsum = 0.f;
  {
    float qq = 0.f;
#pragma unroll
    for (int ks = 0; ks < 2; ++ks)
#pragma unroll
      for (int j = 0; j < 8; ++j) { float t = bf2f((u16)qf[ks][j]); qq += t * t; }
    qq = xsum32(qq);
    const float k2 = __uint_as_float(__hip_atomic_load((unsigned*)(p.ws + OFF_KMAX) + bh * 2 + c, __ATOMIC_RELAXED, __HIP_MEMORY_SCOPE_AGENT));
    const float mref = sqrtf(qq * k2) * 1.001f;
#pragma unroll
    for (int i = 0; i < 16; ++i) NEGM[i] = -mref;
  }
  const int nt2 = ntile >> 1;
  const int swk = (r31 >> 2) & 3, swv = r31 & 15;
  AGLDS(0, 0);
  asm volatile("s_waitcnt vmcnt(0)" ::: "memory");
  __builtin_amdgcn_s_barrier();
  for (int kt = 0; kt < nt2; ++kt) {
    if (kt + 1 < nt2) AGLDS(kt + 1, (kt + 1) & 1);
    __builtin_amdgcn_sched_barrier(0);
    const char* kb = smem + (kt & 1) * STG + c * 8192;
    const char* vb = smem + (kt & 1) * STG + KB;
    f32x16 X[4];
#pragma unroll
    for (int k2 = 0; k2 < 4; ++k2) {
      const char* kp_ = kb + (k2 * 32 + r31) * 64;
      X[k2] = mfma(*(const bf16x8*)(kp_ + ((hh) ^ swk) * 16), qf[0], NEGM);
      X[k2] = mfma(*(const bf16x8*)(kp_ + ((2 + hh) ^ swk) * 16), qf[1], X[k2]);
    }
    float ps = 0.f;
#pragma unroll
    for (int k2 = 0; k2 < 4; ++k2)
#pragma unroll
      for (int i = 0; i < 16; ++i) { float e = __builtin_amdgcn_exp2f(X[k2][i]); X[k2][i] = e; ps += e; }
    lsum += ps;
#pragma unroll
    for (int ks2 = 0; ks2 < 8; ++ks2) {
      const int k2 = ks2 >> 1, s_ = ks2 & 1;
      u32x4 pu = {pack2(X[k2][8 * s_], X[k2][8 * s_ + 1]), pack2(X[k2][8 * s_ + 2], X[k2][8 * s_ + 3]),
                  pack2(X[k2][8 * s_ + 4], X[k2][8 * s_ + 5]), pack2(X[k2][8 * s_ + 6], X[k2][8 * s_ + 7])};
      bf16x8 pf = __builtin_bit_cast(bf16x8, pu);
#pragma unroll
      for (int vt = 0; vt < 2; ++vt) {
        bf16x8 av = *(const bf16x8*)(vb + (vt * 32 + r31) * 256 + ((2 * ks2 + hh) ^ swv) * 16);
        O[vt] = mfma(av, pf, O[vt]);
      }
    }
    __builtin_amdgcn_sched_barrier(0);
    asm volatile("s_waitcnt vmcnt(0)" ::: "memory");
    __builtin_amdgcn_s_barrier();
  }
#undef AGLDS
  const float ltot = xsum32(lsum);
  const float inv = 1.f / ltot;
  float* sX = (float*)smem;
  if (c == 1) {
#pragma unroll
    for (int vt = 0; vt < 2; ++vt)
#pragma unroll
      for (int i = 0; i < 16; ++i) sX[(qs * 32 + vt * 16 + i) * 64 + lane] = O[vt][i] * inv * lam;
  }
  __syncthreads();
  if (c == 0) {
    float ss = 0.f;
#pragma unroll
    for (int vt = 0; vt < 2; ++vt)
#pragma unroll
      for (int i = 0; i < 16; ++i) { float o = O[vt][i] * inv - sX[(qs * 32 + vt * 16 + i) * 64 + lane]; O[vt][i] = o; ss += o * o; }
    ss = xsum32(ss);
    const float rs = rsqrtf(ss * (1.f / 64.f) + EPSV) * (1.f - lam_init);
    const int qpos = q0 + qs * 32 + r31;
    const int row = qpos < 8192 ? b * 8192 + qpos : 16384 + b * 256 + (qpos - 8192);
    u16* BR = (u16*)(p.ws + OFF_R2 + R2_BR);
#pragma unroll
    for (int vt = 0; vt < 2; ++vt)
#pragma unroll
      for (int i = 0; i < 16; ++i) {
        int v = vt * 32 + rowmap(i, hh);
        BR[(size_t)row * 1024 + 256 + h * 64 + v] = f2bf(O[vt][i] * rs * p.da_subln[l * 64 + v]);
      }
  }
  __syncthreads();
}

DEV void f2_item(const P& p, int item, char* smem) {
  const int tid = ltid(), lane = tid & 63, w = tid >> 6, r31 = lane & 31, hh = lane >> 5;
  int seq, g, s2, N1, base;
  if (item < 1024) { seq = item >> 9; g = (item >> 7) & 3; s2 = item & 127; N1 = 64; base = seq * 8192; }
  else { int q = item - 1024; seq = 2 + (q >> 9); g = (q >> 7) & 3; s2 = q & 127; N1 = 2; base = 16384 + (seq - 2) * 256; }
  const u16* PS = (const u16*)(p.ws + OFF_R1 + R1_PS);
  u16* sT = (u16*)smem;
  u16* sAB = (u16*)(smem + 9216);
  float* sEx = (float*)(smem + 9216 + 17408);
  for (int i = 0; i < 2; ++i) {
    int ch = tid + i * 256, s1 = ch >> 3, cc = ch & 7;
    u32x4 v = {0, 0, 0, 0};
    if (s1 < N1) v = *(const u32x4*)(PS + (size_t)(base + 128 * s1 + s2) * PSW + 1792 + g * 64 + cc * 8);
    *(u32x4*)(sT + s1 * 72 + cc * 8) = v;
  }
  __syncthreads();
  {
    const int mi = w & 1, nh = w >> 1;
    f32x16 a1[1][2];
#pragma unroll
    for (int ni = 0; ni < 2; ++ni)
#pragma unroll
      for (int i = 0; i < 16; ++i) a1[0][ni][i] = 0.f;
    mma_lds<1, 2>(sT, 72, mi * 32, (const u16*)(p.ws + OFF_TB1), 64, nh * 64, 64, a1, lane);
#pragma unroll
    for (int ni = 0; ni < 2; ++ni)
#pragma unroll
      for (int i = 0; i < 16; ++i) sAB[(ni * 32 + r31) * 136 + nh * 64 + mi * 32 + rowmap(i, hh)] = f2bf(a1[0][ni][i]);
  }
  __syncthreads();
  {
    f32x16 a2[1][2];
#pragma unroll
    for (int ni = 0; ni < 2; ++ni)
#pragma unroll
      for (int i = 0; i < 16; ++i) a2[0][ni][i] = 0.f;
    mma_lds<1, 2>((const u16*)(p.ws + (N1 == 64 ? OFF_TA264 : OFF_TA22)), 128, w * 32, sAB, 136, 0, 128, a2, lane);
#pragma unroll
    for (int ni = 0; ni < 2; ++ni)
#pragma unroll
      for (int i = 0; i < 16; ++i) sEx[(w * 32 + rowmap(i, hh)) * 65 + ni * 32 + r31] = a2[0][ni][i];
  }
  __syncthreads();
  {
    const float* TW = (const float*)(p.ws + OFF_TW);
    u16* XRE = (u16*)(p.ws + OFF_R1 + R1_XRE);
    u16* XIM = (u16*)(p.ws + OFF_R1 + R1_XIM);
    for (int i = 0; i < 16; ++i) {
      int e = tid + i * 256, ka = e >> 6, k2 = e & 63;
      if (ka < N1) {
        float re = sEx[ka * 65 + k2], im = sEx[(64 + ka) * 65 + k2];
        int idx = (ka * s2 * (N1 == 64 ? 1 : 32)) & 8191;
        float cs = TW[2 * idx], sn = TW[2 * idx + 1];
        size_t o = ((size_t)((seq * 4 + g) * 64 + ka) * 128 + s2) * 64 + k2;
        XRE[o] = f2bf(re * cs + im * sn);
        XIM[o] = f2bf(im * cs - re * sn);
      }
    }
  }
  __syncthreads();
}

DEV void f2ctx_item(const P& p, int item, char* smem) {
  const int tid = ltid(), lane = tid & 63, w = tid >> 6, r31 = lane & 31, hh = lane >> 5;
  const int seq = 2 + (item >> 4), g = (item >> 2) & 3, grp = item & 3, base = 16384 + (seq - 2) * 256;
  const u16* PS = (const u16*)(p.ws + OFF_R1 + R1_PS);
  u16* sT = (u16*)smem;
  float* sEx = (float*)(smem + 9216 + 17408);
  for (int i = 0; i < 2; ++i) {
    int ch = tid + i * 256, rr = ch >> 3, cc = ch & 7, s1 = rr >> 5, j = rr & 31;
    *(u32x4*)(sT + rr * 72 + cc * 8) = *(const u32x4*)(PS + (size_t)(base + 128 * s1 + grp * 32 + j) * PSW + 1792 + g * 64 + cc * 8);
  }
  __syncthreads();
  {
    const int mi = w & 1, nh = w >> 1;
    f32x16 a1[1][2];
#pragma unroll
    for (int ni = 0; ni < 2; ++ni)
#pragma unroll
      for (int i = 0; i < 16; ++i) a1[0][ni][i] = 0.f;
    mma_lds<1, 2>(sT, 72, mi * 32, (const u16*)(p.ws + OFF_TB1), 64, nh * 64, 64, a1, lane);
#pragma unroll
    for (int ni = 0; ni < 2; ++ni)
#pragma unroll
      for (int i = 0; i < 16; ++i) sEx[(mi * 32 + rowmap(i, hh)) * 130 + nh * 64 + ni * 32 + r31] = a1[0][ni][i];
  }
  __syncthreads();
  {
    const float* TW = (const float*)(p.ws + OFF_TW);
    u16* XRE = (u16*)(p.ws + OFF_R1 + R1_XRE);
    u16* XIM = (u16*)(p.ws + OFF_R1 + R1_XIM);
    for (int i = 0; i < 16; ++i) {
      int e = tid + i * 256, ka = e >> 11, j = (e >> 6) & 31, k2 = e & 63;
      int s2 = grp * 32 + j;
      float a0 = sEx[j * 130 + k2], b0 = sEx[j * 130 + 64 + k2], a1v = sEx[(32 + j) * 130 + k2], b1v = sEx[(32 + j) * 130 + 64 + k2];
      float re = ka ? a0 - a1v : a0 + a1v, im = ka ? b0 - b1v : b0 + b1v;
      int idx = (ka * s2 * 32) & 8191;
      float cs = TW[2 * idx], sn = TW[2 * idx + 1];
      size_t o = ((size_t)((seq * 4 + g) * 64 + ka) * 128 + s2) * 64 + k2;
      XRE[o] = f2bf(re * cs + im * sn);
      XIM[o] = f2bf(im * cs - re * sn);
    }
  }
  __syncthreads();
}

DEV void f3_item(const P& p, int item, char* smem) {
  const int tid = ltid(), lane = tid & 63, w = tid >> 6, r31 = lane & 31, hh = lane >> 5;
  int seq, g, ka, N1, base; float scale;
  if (item < 512) { seq = item >> 8; g = (item >> 6) & 3; ka = item & 63; N1 = 64; base = seq * 8192; scale = 1.f / 724.0773439350247f; }
  else { int q = item - 512; seq = 2 + (q >> 3); g = (q >> 1) & 3; ka = q & 1; N1 = 2; base = 16384 + (seq - 2) * 256; scale = 1.f / 128.f; }
  u16* sB = (u16*)smem;
  const u16* XRE = (const u16*)(p.ws + OFF_R1 + R1_XRE) + (size_t)((seq * 4 + g) * 64 + ka) * 128 * 64;
  const u16* XIM = (const u16*)(p.ws + OFF_R1 + R1_XIM) + (size_t)((seq * 4 + g) * 64 + ka) * 128 * 64;
  {
    int s2 = tid & 127, cgh = tid >> 7;
    for (int i = 0; i < 4; ++i) {
      int cg_ = cgh * 4 + i;
      u32x4 ur = *(const u32x4*)(XRE + s2 * 64 + cg_ * 8);
      u32x4 ui = *(const u32x4*)(XIM + s2 * 64 + cg_ * 8);
#pragma unroll
      for (int e = 0; e < 4; ++e) {
        sB[(cg_ * 8 + 2 * e) * 264 + s2] = (u16)(ur[e] & 0xffff);
        sB[(cg_ * 8 + 2 * e + 1) * 264 + s2] = (u16)(ur[e] >> 16);
        sB[(cg_ * 8 + 2 * e) * 264 + 128 + s2] = (u16)(ui[e] & 0xffff);
        sB[(cg_ * 8 + 2 * e + 1) * 264 + 128 + s2] = (u16)(ui[e] >> 16);
      }
    }
  }
  __syncthreads();
  f32x16 acc[1][2];
#pragma unroll
  for (int ni = 0; ni < 2; ++ni)
#pragma unroll
    for (int i = 0; i < 16; ++i) acc[0][ni][i] = 0.f;
  mma_lds<1, 2>((const u16*)(p.ws + OFF_TCS), 256, w * 32, sB, 264, 0, 256, acc, lane);
  u16* BR = (u16*)(p.ws + OFF_R2 + R2_BR);
#pragma unroll
  for (int ni = 0; ni < 2; ++ni)
#pragma unroll
    for (int i = 0; i < 16; ++i) {
      int kb = w * 32 + rowmap(i, hh), k2 = ni * 32 + r31;
      int row = base + ka + N1 * kb;
      BR[(size_t)row * 1024 + 512 + g * 64 + k2] = f2bf(acc[0][ni][i] * scale);
    }
  __syncthreads();
}

DEV void sgu_item(const P& p, int l, int item, char* smem) {
  const int tid = ltid(), lane = tid & 63, w = tid >> 6, r31 = lane & 31, hh = lane >> 5;
  const int tl = item >> 2, g = item & 3, r0 = tl * 128;
  const u16* PS = (const u16*)(p.ws + OFF_R1 + R1_PS);
  u16* sA = (u16*)smem;
  u16* sB = (u16*)(smem + 34816);
  float* sSt = (float*)(smem + 34816 + 17408);
  {
    int tok = tid >> 1, half = tid & 1;
    const u16* src = PS + (size_t)(r0 + tok) * PSW + 2304 + half * 128;
    float s = 0, sq = 0;
    for (int j = 0; j < 16; ++j) {
      u32x4 u = *(const u32x4*)(src + j * 8);
#pragma unroll
      for (int e = 0; e < 4; ++e) { float a = geluf_(bflo(u[e])), b2 = geluf_(bfhi(u[e])); s += a + b2; sq += a * a + b2 * b2; }
    }
    s += __shfl_xor(s, 1); sq += __shfl_xor(sq, 1);
    float mean = s * (1.f / 256.f);
    float var = fmaxf(sq * (1.f / 256.f) - mean * mean, 0.f);
    if (half == 0) { sSt[tok * 2] = mean; sSt[tok * 2 + 1] = rsqrtf(var + EPSV); }
  }
  __syncthreads();
  {
    int q = tid & 127, cgh = tid >> 7;
    float mean = sSt[q * 2], rstd = sSt[q * 2 + 1];
    for (int i = 0; i < 4; ++i) {
      int cg_ = cgh * 4 + i;
      u32x4 u = *(const u32x4*)(PS + (size_t)(r0 + q) * PSW + 2304 + g * 64 + cg_ * 8);
#pragma unroll
      for (int e = 0; e < 4; ++e) {
        int d0 = cg_ * 8 + 2 * e;
        float a = (geluf_(bflo(u[e])) - mean) * rstd * p.sg_norm[l * 256 + g * 64 + d0];
        float b2 = (geluf_(bfhi(u[e])) - mean) * rstd * p.sg_norm[l * 256 + g * 64 + d0 + 1];
        sB[d0 * 136 + q] = f2bf(a);
        sB[(d0 + 1) * 136 + q] = f2bf(b2);
      }
    }
    const float* W = p.sg_w + (size_t)(l * 4 + g) * 128 * 128;
    for (int i = 0; i < 8; ++i) {
      int pr = (tid >> 4) + 16 * i, cc = (tid & 15) * 8;
      f32x4 a = *(const f32x4*)(W + pr * 128 + cc), b2 = *(const f32x4*)(W + pr * 128 + cc + 4);
      *(u32x4*)(sA + pr * 136 + cc) = u32x4{pack2(a[0], a[1]), pack2(a[2], a[3]), pack2(b2[0], b2[1]), pack2(b2[2], b2[3])};
    }
  }
  __syncthreads();
  f32x16 acc[1][2];
#pragma unroll
  for (int ni = 0; ni < 2; ++ni)
#pragma unroll
    for (int i = 0; i < 16; ++i) acc[0][ni][i] = 0.f;
  mma_lds<1, 2>(sA, 136, w * 32, sB, 136, 0, 128, acc, lane);
  u16* BR = (u16*)(p.ws + OFF_R2 + R2_BR);
#pragma unroll
  for (int ni = 0; ni < 2; ++ni)
#pragma unroll
    for (int i = 0; i < 16; ++i) {
      int pp = w * 32 + rowmap(i, hh), d = ni * 32 + r31;
      float u = geluf_(bf2f(PS[(size_t)(r0 + pp) * PSW + 2048 + g * 64 + d]));
      float val = (acc[0][ni][i] + p.sg_b[(l * 4 + g) * 128 + pp]) * u;
      BR[(size_t)(r0 + pp) * 1024 + 768 + g * 64 + d] = f2bf(val);
    }
  __syncthreads();
}

__global__ void __launch_bounds__(256, 2) mega(P p) {
  extern __shared__ __attribute__((aligned(16))) char smem[];
  cg::grid_group grid = cg::this_grid();
  __shared__ unsigned xb_st[4];
  if (threadIdx.x < 4) xb_st[threadIdx.x] = 0u;
  __syncthreads();
  XcdBarrier xb = xcd_barrier_post((unsigned*)(p.ws + OFF_BAR), (volatile LAS unsigned*)xb_st);
  int phase = 0;
  const int bid = blockIdx.x, nb = gridDim.x;
#ifndef DUP
#define DUP 0
#endif
#define PH_BEGIN if (phase >= p.ph0 && phase < p.ph1) {
#define REP_BEGIN(kind) for (int rep_ = 0; rep_ < 1 + ((DUP >> (kind)) & 1); ++rep_) { if (rep_) xcd_barrier(xb);
#define REP_END }
#define PH_END } ++phase; if (p.coop) { if (p.coop == 2 && phase == 1) grid.sync(); else xcd_barrier(xb); }

  PH_BEGIN
  for (int it = bid; it < 192 + 21 + 4320; it += nb) {
    if (it < 192) mod_item(p, it, smem);
    else if (it < 213) tab_item(p, it - 192);
    else conv_item(p, 0, it - 213, smem);
  }
  PH_END
  PH_BEGIN
  for (int it = bid; it < NROW / 4; it += nb) rowpass_item(p, 0, 0, it);
  PH_END

  for (int l = 0; l < 4; ++l) {
    const float lam_init = 0.8f - 0.6f * expf(-0.3f * (float)l);
    const bool last = l == 3;
    PH_BEGIN
REP_BEGIN(0)
    banded(bid, nb, 132, 21, 7, [&](int mt, int nt) { gemm1_item(p, mt, nt, smem); });
REP_END
    PH_END
    PH_BEGIN
REP_BEGIN(1)
    for (int it = bid; it < 132 + 528 + 528 + 1024 + 32; it += nb) {
      if (it < 132) attnprep_item(p, it, smem);
      else if (it < 660) mla_item(p, l, it - 132, smem);
      else if (it < 1188) { if (!(last && it - 660 >= 512)) sgu_item(p, l, it - 660, smem); }
      else if (it < 2212) f2_item(p, it - 1188, smem);
      else if (!last) f2ctx_item(p, it - 2212, smem);
    }
REP_END
    PH_END
    PH_BEGIN
    {
      float s01 = 0.f, s23 = 0.f;
      for (int i = 0; i < 32; ++i) {
        s01 += p.da_lam[l * 128 + i] * p.da_lam[l * 128 + 32 + i];
        s23 += p.da_lam[l * 128 + 64 + i] * p.da_lam[l * 128 + 96 + i];
      }
      const float lam = expf(s01) - expf(s23) + lam_init;
      {
        const int x = bid & 7, j = bid >> 3, per = nb >> 3;
        for (int r_ = 0; r_ < 1 + ((DUP >> 2) & 1); ++r_) {
          for (int q = j; q < 128; q += per) attn_item(p, l, x * 128 + q, smem, lam, lam_init);
          if (!last) for (int q = j; q < 4; q += per) attn_item(p, l, 1024 + x * 4 + q, smem, lam, lam_init);
        }
      }
      if (!last) for (int it = bid - (nb - 16); it >= 0 && it < 16; it += nb) mlc_item(p, l, 512 + it, smem);
      for (int it = bid; it < 64 + 528; it += nb) {
        if (it < 64) { for (int r_ = 0; r_ < 1 + ((DUP >> 9) & 1); ++r_) scan_item(p, it); }
        else if (!(last && it - 64 >= 512)) { for (int r_ = 0; r_ < 1 + ((DUP >> 10) & 1); ++r_) f3_item(p, it - 64, smem); }
      }
    }
    PH_END
    PH_BEGIN
REP_BEGIN(3)
    for (int it = bid; it < 512; it += nb) mlc_item(p, l, it, smem);
REP_END
    PH_END
    PH_BEGIN
REP_BEGIN(4)
    banded(bid, nb, 128, 8, 8, [&](int mt, int nt) { merge_item<2>(p, mt, nt, smem); });
    if (!last) for (int it = bid; it < 64; it += nb) merge_item<1>(p, 128 + (it >> 4), it & 15, smem);
REP_END
    PH_END
    PH_BEGIN
REP_BEGIN(5)
    banded(bid, nb, 128, 8, 8, [&](int mt, int nt) { gemm_f32_big((const u16*)(p.ws + OFF_R2 + R2_Z), 1024, (const u16*)(p.ws + OFF_WT + WT_OUT), (float*)(p.ws + OFF_R1), mt, nt, smem); });
    if (!last) for (int it = bid; it < 64; it += nb)
      gemm_f32_small((const u16*)(p.ws + OFF_R2 + R2_Z), 1024, (const u16*)(p.ws + OFF_WT + WT_OUT), (float*)(p.ws + OFF_R1), it, smem);
REP_END
    PH_END
    PH_BEGIN
    for (int it = bid; it < NROW / 4; it += nb) rowpass_item(p, l, 1, it);
    PH_END
    PH_BEGIN
REP_BEGIN(6)
    banded(bid, nb, 67, 44, 11, [&](int mt, int nt) { upact_item(p, l, mt, nt, smem); });
REP_END
    PH_END
    PH_BEGIN
REP_BEGIN(8)
    banded(bid, nb, 128, 8, 8, [&](int mt, int nt) { gemm_f32_big((const u16*)(p.ws + OFF_R2), 2816, (const u16*)(p.ws + OFF_WT + WT_DOWN), (float*)(p.ws + OFF_R1), mt, nt, smem); });
    if (!last) for (int it = bid; it < 64; it += nb)
      gemm_f32_small((const u16*)(p.ws + OFF_R2), 2816, (const u16*)(p.ws + OFF_WT + WT_DOWN), (float*)(p.ws + OFF_R1), it, smem);
REP_END
    PH_END
    PH_BEGIN
    {
      const int nconv = l < 3 ? 4320 : 0;
      for (int it = bid; it < NROW / 4 + nconv; it += nb) {
        if (it < NROW / 4) rowpass_item(p, l, 2, it);
        else { for (int r_ = 0; r_ < 1 + ((DUP >> 11) & 1); ++r_) conv_item(p, l + 1, it - NROW / 4, smem); }
      }
    }
    PH_END
  }
}

extern "C" void kernel_launch(void* const* d_in, const int* in_sizes, int n_in, void* d_out, int out_size, void* d_ws, size_t ws_size,
                              hipStream_t stream) {
  static int grid_blocks = 0;
  if (!grid_blocks) {
    if (hipFuncSetAttribute((const void*)mega, hipFuncAttributeMaxDynamicSharedMemorySize, LDS_BYTES) != hipSuccess) {
      fprintf(stderr, "hipFuncSetAttribute failed\n");
    }
    int dev = 0, cus = 0, per_cu = 0;
    hipGetDevice(&dev);
    hipDeviceGetAttribute(&cus, hipDeviceAttributeMultiprocessorCount, dev);
    hipOccupancyMaxActiveBlocksPerMultiprocessor(&per_cu, (const void*)mega, 256, LDS_BYTES);
    if (per_cu > 2) per_cu = 2;
    if (per_cu < 1) per_cu = 1;
    grid_blocks = cus * per_cu;
  }
  P p{};
  const float** f = (const float**)&p;
  for (int i = 0; i < 23; ++i) f[i] = (const float*)d_in[i];
  p.out = (float*)d_out;
  p.ws = (char*)d_ws;
  p.ph0 = 0; p.ph1 = 1 << 30; p.coop = 1; p.pad = 0;
  hipMemsetAsync((char*)d_ws + OFF_BAR, 0, 16384, stream);
  void* args[] = {&p};
  hipError_t e = hipLaunchCooperativeKernel((const void*)mega, dim3(grid_blocks), dim3(256), args, LDS_BYTES, stream);
  if (e != hipSuccess) fprintf(stderr, "cooperative launch failed: %s (grid %d)\n", hipGetErrorString(e), grid_blocks);
}
```

```cpp
#include <hip/hip_runtime.h>
#include <hip/hip_cooperative_groups.h>
#include <stdint.h>
#include <stdio.h>
namespace cg = cooperative_groups;

typedef unsigned short u16;
typedef short bf16x8 __attribute__((ext_vector_type(8)));
typedef float f32x16 __attribute__((ext_vector_type(16)));
typedef unsigned int u32x4 __attribute__((ext_vector_type(4)));
typedef unsigned int u32x2 __attribute__((ext_vector_type(2)));
typedef float f32x4 __attribute__((ext_vector_type(4)));
#define DEV __device__ __forceinline__

constexpr int NROW = 16896;
constexpr int PSW = 2688;
constexpr int KPOS = 8448;
constexpr int LDS_BYTES = 73728;
constexpr float EPSV = 1e-6f;

constexpr size_t OFF_MOD = 0;
constexpr size_t OFF_TB1 = 294912;
constexpr size_t OFF_TA264 = OFF_TB1 + 16384;
constexpr size_t OFF_TA22 = OFF_TA264 + 32768;
constexpr size_t OFF_TCS = OFF_TA22 + 32768;
constexpr size_t OFF_TW = OFF_TCS + 65536;
constexpr size_t OFF_RT = OFF_TW + 65536;
constexpr size_t OFF_BAR = OFF_RT + 8192;
constexpr size_t OFF_KMAX = OFF_BAR + 15360;
constexpr size_t OFF_XC = OFF_BAR + 16384;
constexpr size_t OFF_H = OFF_XC + 2097152;
constexpr size_t OFF_WT = OFF_H + 34603008;
constexpr size_t WT_IN = 0;
constexpr size_t WT_BR = (size_t)6784 * 1024 * 2;
constexpr size_t WT_OUT = WT_BR + (size_t)4 * 1024 * 256 * 2;
constexpr size_t WT_UP = WT_OUT + (size_t)1024 * 1024 * 2;
constexpr size_t WT_DOWN = WT_UP + (size_t)5632 * 1024 * 2;
constexpr size_t WT_BYTES = WT_DOWN + (size_t)1024 * 2816 * 2;
constexpr size_t OFF_R1 = OFF_WT + WT_BYTES;
constexpr size_t R1_BYTES = (size_t)NROW * 5632 * 2;
constexpr size_t R1_PS = 0;
constexpr size_t R1_QR = (size_t)NROW * PSW * 2;
constexpr size_t R1_KR = R1_QR + 8650752;
constexpr size_t R1_VT = R1_KR + 8650752;
constexpr size_t R1_XRE = R1_VT + 8650752;
constexpr size_t R1_XIM = R1_XRE + 16777216;
constexpr size_t R1_DC = R1_XIM + 16777216;
constexpr size_t R1_DEC = R1_DC + (size_t)16 * 66 * 4160 * 4;
constexpr size_t R1_CP = R1_DEC + 8192;
constexpr size_t R1_END = R1_CP + (size_t)16 * 66 * 4160 * 2;
static_assert(R1_END <= R1_BYTES, "R1 overflow");
constexpr size_t OFF_R2 = OFF_R1 + R1_BYTES;
constexpr size_t R2_BR = 0;
constexpr size_t R2_Z = 34603008;

struct P {
  const float *x, *c, *ctx, *c_ctx, *w_ada, *b_ada, *norm_g, *w_in, *ml_conv_w, *ml_conv_b, *ml_gate_b, *ml_norm,
      *da_lam, *da_subln, *sg_norm, *sg_w, *sg_b, *w_branch, *w_out, *ffn_up, *ffn_conv_w, *ffn_conv_b, *ffn_down;
  float* out;
  char* ws;
  int ph0, ph1, coop, pad;
};

DEV int ltid() { int t = threadIdx.x; asm volatile("" : "+v"(t)); return t; }

#define XB_TMO      128
#define XB_XCNT(j)  (256  + 64 * (j))
#define XB_XSUB(j)  (1280 + 64 * (j))
#define XB_XGEN(j)  (2304 + 64 * (j))
#define XB_TOP      3328
#define XB_TOPGEN   3392
#define XCD_BAR_WORDS 3456
#define XB_SPIN_CAP (1u << 23)
#define LAS __attribute__((address_space(3)))
DEV unsigned xb_ld(unsigned* p) { return __hip_atomic_load(p, __ATOMIC_RELAXED, __HIP_MEMORY_SCOPE_AGENT); }
DEV unsigned xb_add(unsigned* p, unsigned v) { return __hip_atomic_fetch_add(p, v, __ATOMIC_RELAXED, __HIP_MEMORY_SCOPE_AGENT); }
DEV unsigned xb_xcc_id() { return (unsigned)__builtin_amdgcn_s_getreg((3 << 11) | 20) & 0xFu; }
#define XB_SPIN(cond, bar) do { unsigned _sp = 0; while (cond) { __builtin_amdgcn_s_sleep(1); \
    if ((++_sp & 255u) == 0u) { if (xb_ld(&(bar)[XB_TMO])) break; if (_sp > XB_SPIN_CAP) { atomicAdd(&(bar)[XB_TMO], 1u); break; } } } } while (0)
struct XcdBarrier { unsigned* bar; unsigned x; volatile LAS unsigned* st; };
DEV XcdBarrier xcd_barrier_post(unsigned* bar, volatile LAS unsigned* st) {
  XcdBarrier b; b.bar = bar; b.x = xb_xcc_id(); b.st = st;
  if (threadIdx.x == 0) (void)xb_add(&bar[XB_XCNT(b.x)], 1u);
  return b;
}
DEV void xcd_barrier_complete(unsigned* bar, unsigned x, unsigned& nloc, unsigned& nx) {
  const unsigned G = gridDim.x * gridDim.y * gridDim.z;
  unsigned sum, cnt, mine, sp = 0u;
  for (;;) {
    sum = 0u; cnt = 0u; mine = 0u;
#pragma unroll
    for (unsigned j = 0; j < 16; ++j) { const unsigned c = xb_ld(&bar[XB_XCNT(j)]); sum += c; cnt += (c > 0u) ? 1u : 0u; mine = (j == x) ? c : mine; }
    if (sum == G) break;
    __builtin_amdgcn_s_sleep(1);
    if ((++sp & 255u) == 0u) { if (xb_ld(&bar[XB_TMO])) break; if (sp > XB_SPIN_CAP) { atomicAdd(&bar[XB_TMO], 1u); break; } }
  }
  nloc = mine > 0u ? mine : 1u; nx = cnt > 0u ? cnt : 1u;
}
DEV void xcd_barrier(const XcdBarrier& b) {
  asm volatile("s_waitcnt vmcnt(0)" ::: "memory");
  __syncthreads();
  if (threadIdx.x == 0) {
    unsigned* bar = b.bar;
    __builtin_amdgcn_s_waitcnt(0);
    unsigned nloc = b.st[0], nx = b.st[1];
    if (nloc == 0u) { xcd_barrier_complete(bar, b.x, nloc, nx); b.st[0] = nloc; b.st[1] = nx; }
    const unsigned old = xb_add(&bar[XB_XSUB(b.x)], 1u);
    const unsigned gen = old / nloc;
    if (old + 1u == (gen + 1u) * nloc) {
      __builtin_amdgcn_fence(__ATOMIC_RELEASE, "agent");
      asm volatile("s_waitcnt vmcnt(0)" ::: "memory");
      const unsigned og = xb_add(&bar[XB_TOP], 1u);
      const unsigned tg = og / nx;
      if (og + 1u == (tg + 1u) * nx) xb_add(&bar[XB_TOPGEN], 1u);
      else XB_SPIN(xb_ld(&bar[XB_TOPGEN]) == tg, bar);
      __builtin_amdgcn_fence(__ATOMIC_ACQUIRE, "agent");
      xb_add(&bar[XB_XGEN(b.x)], 1u);
      asm volatile("s_waitcnt vmcnt(0)" ::: "memory");
    } else {
      XB_SPIN(xb_ld(&bar[XB_XGEN(b.x)]) == gen, bar);
      __builtin_amdgcn_fence(__ATOMIC_ACQUIRE, "agent");
      asm volatile("s_waitcnt vmcnt(0)" ::: "memory");
    }
  }
  __syncthreads();
}

DEV float bf2f(u16 h) { return __uint_as_float(((unsigned)h) << 16); }
typedef __bf16 hwbf16x2 __attribute__((ext_vector_type(2)));
typedef float f32x2 __attribute__((ext_vector_type(2)));
DEV unsigned pack2(float a, float b) { f32x2 v = {a, b}; hwbf16x2 r = __builtin_convertvector(v, hwbf16x2); return __builtin_bit_cast(unsigned, r); }
DEV u16 f2bf(float f) { return (u16)pack2(f, f); }
DEV float bflo(unsigned u) { return __uint_as_float(u << 16); }
DEV float bfhi(unsigned u) { return __uint_as_float(u & 0xffff0000u); }
DEV float sigmoidf_(float x) { return __builtin_amdgcn_rcpf(1.f + __expf(-x)); }
DEV float siluf_(float x) { return x * __builtin_amdgcn_rcpf(1.f + __expf(-x)); }
DEV float geluf_(float x) { return x * __builtin_amdgcn_rcpf(1.f + __expf(-1.5957691216057308f * (x + 0.044715f * x * x * x))); }
DEV float xmax32(float v) { auto r = __builtin_amdgcn_permlane32_swap(__float_as_uint(v), __float_as_uint(v), false, false); return fmaxf(__uint_as_float(r[0]), __uint_as_float(r[1])); }
DEV float xsum32(float v) { auto r = __builtin_amdgcn_permlane32_swap(__float_as_uint(v), __float_as_uint(v), false, false); return __uint_as_float(r[0]) + __uint_as_float(r[1]); }
DEV int rowmap(int i, int hh) { return (i & 3) + 8 * (i >> 2) + 4 * hh; }
DEV f32x16 mfma(bf16x8 a, bf16x8 b, f32x16 c) { return __builtin_amdgcn_mfma_f32_32x32x16_bf16(a, b, c, 0, 0, 0); }

template <int MI, int NI>
DEV void mma_lds(const u16* sA, int lda, int rowA0, const u16* sB, int ldb, int rowB0, int K, f32x16 (&acc)[MI][NI], int lane) {
  const int r = lane & 31, h = lane >> 5;
  for (int k0 = 0; k0 < K; k0 += 16) {
    bf16x8 a[MI], b[NI];
#pragma unroll
    for (int mi = 0; mi < MI; ++mi) a[mi] = *(const bf16x8*)(sA + (size_t)(rowA0 + mi * 32 + r) * lda + k0 + h * 8);
#pragma unroll
    for (int ni = 0; ni < NI; ++ni) b[ni] = *(const bf16x8*)(sB + (size_t)(rowB0 + ni * 32 + r) * ldb + k0 + h * 8);
#pragma unroll
    for (int mi = 0; mi < MI; ++mi)
#pragma unroll
      for (int ni = 0; ni < NI; ++ni) acc[mi][ni] = mfma(a[mi], b[ni], acc[mi][ni]);
  }
}

DEV int rowmap16(int i, int lane) { return ((i >> 3) & 1) * 16 + (lane >> 4) * 4 + (i & 3); }
DEV int colmap16(int i, int lane) { return ((i >> 2) & 1) * 16 + (lane & 15); }
template <int NI>
DEV void gemm_main(const u16* __restrict__ A, int lda, const u16* __restrict__ Bt, int ldb, int K, f32x16 (&acc)[2][NI], char* smem, int bsplit = 0) {
  constexpr int ABYTES = 128 * 128, STG = ABYTES + NI * 64 * 128;
  const int tid = ltid(), lane = tid & 63, w = tid >> 6, wr = w >> 1, wc = w & 1;
  const int r15 = lane & 15, q4 = lane >> 4;
  const int nk = K / 64;
  const unsigned lbase = (unsigned)(size_t)smem + tid * 16;
  const int sw = (r15 >> 1) & 7;
  const int co = ((tid & 7) ^ ((tid >> 4) & 7)) * 8;
  const u16* Ap = A + (size_t)(tid >> 3) * lda + co;
  const u16* Bp = Bt + (size_t)(tid >> 3) * ldb + co;
  f32x4 c[4][NI * 2];
#pragma unroll
  for (int m = 0; m < 4; ++m)
#pragma unroll
    for (int n = 0; n < NI * 2; ++n)
#pragma unroll
      for (int j = 0; j < 4; ++j) c[m][n][j] = acc[m >> 1][n >> 1][((m & 1) * 2 + (n & 1)) * 4 + j];
#define GLDS(kt, stg)                                                                                             \
  {                                                                                                               \
    _Pragma("unroll") for (int i = 0; i < 4; ++i)                                                                 \
      __builtin_amdgcn_global_load_lds((const unsigned*)(Ap + (size_t)(i * 32) * lda + (kt) * 64), (LAS unsigned*)(lbase + (stg) * STG + i * 4096), 16, 0, 0); \
    _Pragma("unroll") for (int i = 0; i < NI * 2; ++i)                                                            \
      __builtin_amdgcn_global_load_lds((const unsigned*)(Bp + (size_t)(i * 32 + (i >= NI ? bsplit : 0)) * ldb + (kt) * 64), (LAS unsigned*)(lbase + (stg) * STG + ABYTES + i * 4096), 16, 0, 0); \
  }
  GLDS(0, 0);
  asm volatile("s_waitcnt vmcnt(0)" ::: "memory");
  __builtin_amdgcn_s_barrier();
  for (int kt = 0; kt < nk; ++kt) {
    if (kt + 1 < nk) GLDS(kt + 1, (kt + 1) & 1);
    __builtin_amdgcn_sched_barrier(0);
    const char* base = smem + (kt & 1) * STG;
#pragma unroll
    for (int kk = 0; kk < 2; ++kk) {
      bf16x8 a[4], b[NI * 2];
      const int so = ((kk * 4 + q4) ^ sw) * 16;
#pragma unroll
      for (int m = 0; m < 4; ++m) a[m] = *(const bf16x8*)(base + (wr * 64 + m * 16 + r15) * 128 + so);
#pragma unroll
      for (int n = 0; n < NI * 2; ++n) b[n] = *(const bf16x8*)(base + ABYTES + (wc * NI * 32 + n * 16 + r15) * 128 + so);
#pragma unroll
      for (int m = 0; m < 4; ++m)
#pragma unroll
        for (int n = 0; n < NI * 2; ++n) c[m][n] = __builtin_amdgcn_mfma_f32_16x16x32_bf16(a[m], b[n], c[m][n], 0, 0, 0);
    }
    __builtin_amdgcn_sched_barrier(0);
    asm volatile("s_waitcnt vmcnt(0)" ::: "memory");
    __builtin_amdgcn_s_barrier();
  }
#undef GLDS
#pragma unroll
  for (int m = 0; m < 4; ++m)
#pragma unroll
    for (int n = 0; n < NI * 2; ++n)
#pragma unroll
      for (int j = 0; j < 4; ++j) acc[m >> 1][n >> 1][((m & 1) * 2 + (n & 1)) * 4 + j] = c[m][n][j];
}

template <int NI>
DEV void zero_acc(f32x16 (&acc)[2][NI]) {
#pragma unroll
  for (int mi = 0; mi < 2; ++mi)
#pragma unroll
    for (int ni = 0; ni < NI; ++ni)
#pragma unroll
      for (int i = 0; i < 16; ++i) acc[mi][ni][i] = 0.f;
}

DEV void gemm_big_p(const u16* const (&Ap)[4], const u16* const (&Bp)[2], int K, f32x16 (&acc)[4][2], char* smem) {
  constexpr int ABYTES = 256 * 64, STG = ABYTES + 128 * 64;
  const int tid = ltid(), lane = tid & 63, w = tid >> 6, wr = w >> 1, wc = w & 1;
  const int r15 = lane & 15, q4 = lane >> 4;
  const int nk = K / 32;
  const unsigned lbase = (unsigned)(size_t)smem + tid * 16;
  const int so = (q4 ^ ((0x78 >> (((r15 >> 2) & 3) * 2)) & 3)) * 16;
  f32x4 c[8][4];
#pragma unroll
  for (int m = 0; m < 8; ++m)
#pragma unroll
    for (int n = 0; n < 4; ++n)
#pragma unroll
      for (int j = 0; j < 4; ++j) c[m][n][j] = acc[m >> 1][n >> 1][((m & 1) * 2 + (n & 1)) * 4 + j];
#define GLDS(kt, stg)                                                                                             \
  {                                                                                                               \
    _Pragma("unroll") for (int i = 0; i < 4; ++i)                                                                 \
      __builtin_amdgcn_global_load_lds((const unsigned*)(Ap[i] + (kt) * 32), (LAS unsigned*)(lbase + (stg) * STG + i * 4096), 16, 0, 0); \
    _Pragma("unroll") for (int i = 0; i < 2; ++i)                                                                 \
      __builtin_amdgcn_global_load_lds((const unsigned*)(Bp[i] + (kt) * 32), (LAS unsigned*)(lbase + (stg) * STG + ABYTES + i * 4096), 16, 0, 0); \
  }
  GLDS(0, 0);
  if (nk > 1) { GLDS(1, 1); asm volatile("s_waitcnt vmcnt(6)" ::: "memory"); }
  else asm volatile("s_waitcnt vmcnt(0)" ::: "memory");
  __builtin_amdgcn_s_barrier();
  int cur = 0;
  for (int kt = 0; kt < nk; ++kt) {
    int nxt2 = cur + 2; if (nxt2 >= 3) nxt2 -= 3;
    if (kt + 2 < nk) GLDS(kt + 2, nxt2);
    __builtin_amdgcn_sched_barrier(0);
    const char* base = smem + cur * STG;
    {
      bf16x8 a[8], b[4];
#pragma unroll
      for (int m = 0; m < 8; ++m) a[m] = *(const bf16x8*)(base + (wr * 128 + m * 16 + r15) * 64 + so);
#pragma unroll
      for (int n = 0; n < 4; ++n) b[n] = *(const bf16x8*)(base + ABYTES + (wc * 64 + n * 16 + r15) * 64 + so);
#pragma unroll
      for (int m = 0; m < 8; ++m)
#pragma unroll
        for (int n = 0; n < 4; ++n) c[m][n] = __builtin_amdgcn_mfma_f32_16x16x32_bf16(a[m], b[n], c[m][n], 0, 0, 0);
    }
    __builtin_amdgcn_sched_barrier(0);
    if (kt + 2 < nk) asm volatile("s_waitcnt vmcnt(6)" ::: "memory");
    else asm volatile("s_waitcnt vmcnt(0)" ::: "memory");
    __builtin_amdgcn_s_barrier();
    cur = cur + 1 == 3 ? 0 : cur + 1;
  }
#undef GLDS
#pragma unroll
  for (int m = 0; m < 8; ++m)
#pragma unroll
    for (int n = 0; n < 4; ++n)
#pragma unroll
      for (int j = 0; j < 4; ++j) acc[m >> 1][n >> 1][((m & 1) * 2 + (n & 1)) * 4 + j] = c[m][n][j];
}
DEV void gemm_big(const u16* __restrict__ A, int lda, const u16* __restrict__ Bt, int ldb, int K, f32x16 (&acc)[4][2], char* smem) {
  const int tid = ltid();
  const int co = ((tid & 3) ^ ((0x78 >> (((tid >> 4) & 3) * 2)) & 3)) * 8;
  const u16* a0 = A + (size_t)(tid >> 2) * lda + co;
  const u16* b0 = Bt + (size_t)(tid >> 2) * ldb + co;
  const u16* const Ap[4] = {a0, a0 + (size_t)64 * lda, a0 + (size_t)128 * lda, a0 + (size_t)192 * lda};
  const u16* const Bp[2] = {b0, b0 + (size_t)64 * ldb};
  gemm_big_p(Ap, Bp, K, acc, smem);
}
DEV void zero_big(f32x16 (&acc)[4][2]) {
#pragma unroll
  for (int mi = 0; mi < 4; ++mi)
#pragma unroll
    for (int ni = 0; ni < 2; ++ni)
#pragma unroll
      for (int i = 0; i < 16; ++i) acc[mi][ni][i] = 0.f;
}
template <class F>
DEV void banded(int bid, int nb, int MT, int NT, int W, F f) {
  const int TOT = MT * NT, x = bid & 7, j = bid >> 3, per = nb >> 3, chunk = (TOT + 7) >> 3;
  for (int q = j; q < chunk; q += per) {
    int t = x * chunk + q;
    if (t >= TOT) break;
    int band = t / (MT * W), r = t - band * MT * W;
    int mt = r / W, nt = band * W + r - mt * W;
    f(mt, nt);
  }
}

DEV void mod_item(const P& p, int item, char* smem) {
  float* sS = (float*)smem;
  float* sR = sS + 3072;
  const int tid = ltid();
  for (int i = tid; i < 3072; i += 256) {
    int v = i >> 10, k = i & 1023;
    float c = v < 2 ? p.c[v * 1024 + k] : p.c_ctx[k];
    sS[i] = c * __builtin_amdgcn_rcpf(1.f + __expf(-c));
  }
  __syncthreads();
  const int l = item / 48, cgp = item % 48, cc = tid & 31, kq = tid >> 5;
  const float* w = p.w_ada + (size_t)l * 1024 * 6144 + cgp * 128 + cc * 4;
  f32x4 a0 = {0.f, 0.f, 0.f, 0.f}, a1 = a0, a2 = a0;
#pragma unroll 8
  for (int k = kq * 128; k < kq * 128 + 128; ++k) {
    const f32x4 wv = *(const f32x4*)(w + (size_t)k * 6144);
    const float s0 = sS[k], s1 = sS[1024 + k], s2 = sS[2048 + k];
    a0 += wv * s0; a1 += wv * s1; a2 += wv * s2;
  }
#pragma unroll
  for (int e = 0; e < 4; ++e) {
    sR[(kq * 3 + 0) * 128 + cc * 4 + e] = a0[e];
    sR[(kq * 3 + 1) * 128 + cc * 4 + e] = a1[e];
    sR[(kq * 3 + 2) * 128 + cc * 4 + e] = a2[e];
  }
  __syncthreads();
  for (int o = tid; o < 384; o += 256) {
    int v = o >> 7, c2 = o & 127;
    float s_ = 0;
    for (int q = 0; q < 8; ++q) s_ += sR[(q * 3 + v) * 128 + c2];
    int col2 = cgp * 128 + c2;
    ((float*)(p.ws + OFF_MOD))[(l * 3 + v) * 6144 + col2] = s_ + p.b_ada[l * 6144 + col2];
  }
  __syncthreads();
}

DEV void tab_item(const P& p, int item) {
  u16* TB1 = (u16*)(p.ws + OFF_TB1);
  u16* TA264 = (u16*)(p.ws + OFF_TA264);
  u16* TA22 = (u16*)(p.ws + OFF_TA22);
  u16* TCS = (u16*)(p.ws + OFF_TCS);
  float* TW = (float*)(p.ws + OFF_TW);
  float* RT = (float*)(p.ws + OFF_RT);
  const int tid0 = ltid();
  for (int i = 0; i < 16; ++i) {
    int e = item * 4096 + i * 256 + tid0;
    float s, c;
    if (e < 8192) {
      int n = e >> 6, d = e & 63, m = ((n & 63) * d) & 63;
      sincospif(m / 32.f, &s, &c);
      TB1[e] = f2bf(n < 64 ? c : -s);
    } else if (e < 24576) {
      int q = e - 8192, r = q >> 7, j = q & 127, ka = r & 63, s1 = j & 63, m = (ka * s1) & 63;
      sincospif(m / 32.f, &s, &c);
      bool im = r >= 64, sec = j >= 64;
      float v = !im ? (sec ? s : c) : (sec ? c : -s);
      TA264[q] = f2bf(v);
    } else if (e < 40960) {
      int q = e - 24576, r = q >> 7, j = q & 127, ka = r & 63, s1 = j & 63;
      bool im = r >= 64, sec = j >= 64;
      float v = 0.f;
      if (ka < 2 && s1 < 2 && (im == sec)) v = (ka & s1) ? -1.f : 1.f;
      TA22[q] = f2bf(v);
    } else if (e < 73728) {
      int q = e - 40960, kb = q >> 8, j = q & 255, s2 = j & 127, m = (kb * s2) & 127;
      sincospif(m / 64.f, &s, &c);
      TCS[q] = f2bf(j < 128 ? c : s);
    } else if (e < 81920) {
      int q = e - 73728;
      sincospif(q / 4096.f, &s, &c);
      TW[2 * q] = c; TW[2 * q + 1] = s;
    } else if (e < 82944) {
      int q = e - 81920, pos = q >> 3, fi = q & 7;
      float fr = exp2f(-(float)fi * 0.125f * 13.287712379549449f);
      float ang = (float)pos * fr;
      double t = (double)ang * 0.3183098861837907;
      t -= 2.0 * floor(t * 0.5);
      sincospif((float)t, &s, &c);
      RT[2 * q] = c; RT[2 * q + 1] = s;
    }
  }
}

DEV void conv_item(const P& p, int l, int item, char* smem) {
  float* tile = (float*)smem;
  const int tid = ltid();
  char* WT = p.ws + OFF_WT;
  const float* src; u16* dst; int K, Nsrc, kt, nt, mode = 0;
  if (item < 1696) { src = p.w_in + (size_t)l * 1024 * 6672; K = 1024; Nsrc = 6672; dst = (u16*)(WT + WT_IN); kt = item % 16; nt = item / 16; mode = 1; }
  else if (item < 1952) { int q = item - 1696; int g = q >> 6; q &= 63; src = p.w_branch + (size_t)(l * 4 + g) * 256 * 1024; K = 256; Nsrc = 1024; dst = (u16*)(WT + WT_BR) + (size_t)g * 1024 * 256; kt = q % 4; nt = q / 4; }
  else if (item < 2208) { int q = item - 1952; src = p.w_out + (size_t)l * 1024 * 1024; K = 1024; Nsrc = 1024; dst = (u16*)(WT + WT_OUT); kt = q % 16; nt = q / 16; }
  else if (item < 3616) { int q = item - 2208; src = p.ffn_up + (size_t)l * 1024 * 5632; K = 1024; Nsrc = 5632; dst = (u16*)(WT + WT_UP); kt = q % 16; nt = q / 16; }
  else { int q = item - 3616; src = p.ffn_down + (size_t)l * 2816 * 1024; K = 2816; Nsrc = 1024; dst = (u16*)(WT + WT_DOWN); kt = q % 44; nt = q / 44; }
  int nd = nt * 64 + (tid & 15) * 4, ns = nd; bool valid = true;
  if (mode) {
    if (nd < 1024) ns = nd;
    else if (nd < 2560) ns = nd + 16;
    else if (nd < 2576) ns = 1024 + nd - 2560;
    else if (nd < 2688) valid = false;
    else ns = nd - 112;
  }
#pragma unroll
  for (int i = 0; i < 4; ++i) {
    int kk = (tid >> 4) + 16 * i;
    f32x4 v = {0.f, 0.f, 0.f, 0.f};
    if (valid) v = *(const f32x4*)(src + (size_t)(kt * 64 + kk) * Nsrc + ns);
    float* t = tile + kk * 65 + (tid & 15) * 4;
    t[0] = v[0]; t[1] = v[1]; t[2] = v[2]; t[3] = v[3];
  }
  __syncthreads();
  const int n = tid >> 2, kq = tid & 3;
  unsigned pk[8];
#pragma unroll
  for (int j = 0; j < 8; ++j) pk[j] = pack2(tile[(kq * 16 + 2 * j) * 65 + n], tile[(kq * 16 + 2 * j + 1) * 65 + n]);
  u32x4* d = (u32x4*)(dst + (size_t)(nt * 64 + n) * K + kt * 64 + kq * 16);
  d[0] = u32x4{pk[0], pk[1], pk[2], pk[3]};
  d[1] = u32x4{pk[4], pk[5], pk[6], pk[7]};
  __syncthreads();
}

DEV float dpp_add(float v, int ctrl_is) { return v; }
DEV float wave_sum(float v) {
  int x = __float_as_int(v);
  v += __int_as_float(__builtin_amdgcn_update_dpp(0, x, 0xB1, 0xF, 0xF, true));
  x = __float_as_int(v);
  v += __int_as_float(__builtin_amdgcn_update_dpp(0, x, 0x4E, 0xF, 0xF, true));
  x = __float_as_int(v);
  v += __int_as_float(__builtin_amdgcn_update_dpp(0, x, 0x141, 0xF, 0xF, true));
  x = __float_as_int(v);
  v += __int_as_float(__builtin_amdgcn_update_dpp(0, x, 0x140, 0xF, 0xF, true));
  x = __float_as_int(v);
  return __int_as_float(__builtin_amdgcn_readlane(x, 0)) + __int_as_float(__builtin_amdgcn_readlane(x, 16)) +
         __int_as_float(__builtin_amdgcn_readlane(x, 32)) + __int_as_float(__builtin_amdgcn_readlane(x, 48));
}

DEV void rowpass_item(const P& p, int l, int mode, int item) {
  const int tid0 = ltid(); const int w = tid0 >> 6, lane = tid0 & 63, r = item * 4 + w;
  const int vec = r < 8192 ? 0 : (r < 16384 ? 1 : 2);
  float* X = r < 16384 ? p.out + (size_t)r * 1024 : (float*)(p.ws + OFF_XC) + (size_t)(r - 16384) * 1024;
  const float* MOD = (const float*)(p.ws + OFF_MOD);
  const int lh = (mode == 2) ? l + 1 : l;
  const bool doh = lh < 4;
  const int lhc = doh ? lh : 3;
  const float* xsrc = mode == 0 ? (r < 16384 ? p.x + (size_t)r * 1024 : p.ctx + (size_t)(r - 16384) * 1024) : X;
  const float* Y = (const float*)(p.ws + OFF_R1) + (size_t)r * 1024;
  const float* gate = MOD + (size_t)(l * 3 + vec) * 6144 + (mode == 1 ? 2 : 5) * 1024;
  const float* gp = p.norm_g + (size_t)(l * 4 + (mode == 1 ? 1 : 3)) * 1024;
  const float* g = p.norm_g + (size_t)(lhc * 4 + (mode == 1 ? 2 : 0)) * 1024;
  const float* sc = MOD + (size_t)(lhc * 3 + vec) * 6144 + (mode == 1 ? 4 : 1) * 1024;
  const float* sh = MOD + (size_t)(lhc * 3 + vec) * 6144 + (mode == 1 ? 3 : 0) * 1024;
  f32x4 xq[4], yq[4], gq[4], nq[4], hq[4], s1q[4], s0q[4];
#pragma unroll
  for (int i = 0; i < 4; ++i) {
    xq[i] = *(const f32x4*)(xsrc + i * 256 + lane * 4);
    if (mode != 0) {
      yq[i] = *(const f32x4*)(Y + i * 256 + lane * 4);
      gq[i] = *(const f32x4*)(gate + i * 256 + lane * 4);
      nq[i] = *(const f32x4*)(gp + i * 256 + lane * 4);
    }
    hq[i] = *(const f32x4*)(g + i * 256 + lane * 4);
    s1q[i] = *(const f32x4*)(sc + i * 256 + lane * 4);
    s0q[i] = *(const f32x4*)(sh + i * 256 + lane * 4);
  }
  if (mode != 0) {
    float ss = 0;
#pragma unroll
    for (int i = 0; i < 4; ++i)
#pragma unroll
      for (int j = 0; j < 4; ++j) ss += yq[i][j] * yq[i][j];
    ss = wave_sum(ss);
    const float rs = rsqrtf(ss * (1.f / 1024.f) + EPSV);
#pragma unroll
    for (int i = 0; i < 4; ++i)
#pragma unroll
      for (int j = 0; j < 4; ++j) xq[i][j] += gq[i][j] * (yq[i][j] * rs * nq[i][j]);
  }
#pragma unroll
  for (int i = 0; i < 4; ++i) *(f32x4*)(X + i * 256 + lane * 4) = xq[i];
  if (doh) {
    float ss = 0;
#pragma unroll
    for (int i = 0; i < 4; ++i)
#pragma unroll
      for (int j = 0; j < 4; ++j) ss += xq[i][j] * xq[i][j];
    ss = wave_sum(ss);
    const float rs = rsqrtf(ss * (1.f / 1024.f) + EPSV);
    u16* H = (u16*)(p.ws + OFF_H) + (size_t)r * 1024;
#pragma unroll
    for (int i = 0; i < 4; ++i) {
      float h0 = xq[i][0] * rs * hq[i][0] * (1.f + s1q[i][0]) + s0q[i][0];
      float h1 = xq[i][1] * rs * hq[i][1] * (1.f + s1q[i][1]) + s0q[i][1];
      float h2 = xq[i][2] * rs * hq[i][2] * (1.f + s1q[i][2]) + s0q[i][2];
      float h3 = xq[i][3] * rs * hq[i][3] * (1.f + s1q[i][3]) + s0q[i][3];
      *(u32x2*)(H + i * 256 + lane * 4) = u32x2{pack2(h0, h1), pack2(h2, h3)};
    }
  }
}

DEV void rowpass_run(const P& p, int l, int mode, int bid, int nb) {
  const int tid0 = ltid(); const int w = tid0 >> 6, lane = tid0 & 63;
  const float* MOD = (const float*)(p.ws + OFF_MOD);
  const int lh = (mode == 2) ? l + 1 : l;
  const bool doh = lh < 4;
  const int lhc = doh ? lh : 3;
  const float* gp = p.norm_g + (size_t)(l * 4 + (mode == 1 ? 1 : 3)) * 1024;
  const float* g = p.norm_g + (size_t)(lhc * 4 + (mode == 1 ? 2 : 0)) * 1024;
  f32x4 gq[4], nq[4], hq[4], s1q[4], s0q[4];
#pragma unroll
  for (int i = 0; i < 4; ++i) {
    nq[i] = *(const f32x4*)(gp + i * 256 + lane * 4);
    hq[i] = *(const f32x4*)(g + i * 256 + lane * 4);
    gq[i] = nq[i]; s1q[i] = nq[i]; s0q[i] = nq[i];
  }
  int cur = -1;
  for (int it = bid; it < NROW / 4; it += nb) {
    const int r = it * 4 + w;
    const int vec = r < 8192 ? 0 : (r < 16384 ? 1 : 2);
    float* X = r < 16384 ? p.out + (size_t)r * 1024 : (float*)(p.ws + OFF_XC) + (size_t)(r - 16384) * 1024;
    const float* xsrc = mode == 0 ? (r < 16384 ? p.x + (size_t)r * 1024 : p.ctx + (size_t)(r - 16384) * 1024) : X;
    const float* Y = (const float*)(p.ws + OFF_R1) + (size_t)r * 1024;
    f32x4 xq[4], yq[4];
#pragma unroll
    for (int i = 0; i < 4; ++i) {
      xq[i] = *(const f32x4*)(xsrc + i * 256 + lane * 4);
      if (mode != 0) yq[i] = *(const f32x4*)(Y + i * 256 + lane * 4);
    }
    if (vec != cur) {
      cur = vec;
      const float* gate = MOD + (size_t)(l * 3 + vec) * 6144 + (mode == 1 ? 2 : 5) * 1024;
      const float* sc = MOD + (size_t)(lhc * 3 + vec) * 6144 + (mode == 1 ? 4 : 1) * 1024;
      const float* sh = MOD + (size_t)(lhc * 3 + vec) * 6144 + (mode == 1 ? 3 : 0) * 1024;
#pragma unroll
      for (int i = 0; i < 4; ++i) {
        if (mode != 0) gq[i] = *(const f32x4*)(gate + i * 256 + lane * 4);
        s1q[i] = *(const f32x4*)(sc + i * 256 + lane * 4);
        s0q[i] = *(const f32x4*)(sh + i * 256 + lane * 4);
      }
    }
    if (mode != 0) {
      float ss = 0;
#pragma unroll
      for (int i = 0; i < 4; ++i)
#pragma unroll
        for (int j = 0; j < 4; ++j) ss += yq[i][j] * yq[i][j];
      ss = wave_sum(ss);
      const float rs = rsqrtf(ss * (1.f / 1024.f) + EPSV);
#pragma unroll
      for (int i = 0; i < 4; ++i)
#pragma unroll
        for (int j = 0; j < 4; ++j) xq[i][j] += gq[i][j] * (yq[i][j] * rs * nq[i][j]);
    }
#pragma unroll
    for (int i = 0; i < 4; ++i) *(f32x4*)(X + i * 256 + lane * 4) = xq[i];
    if (doh) {
      float ss = 0;
#pragma unroll
      for (int i = 0; i < 4; ++i)
#pragma unroll
        for (int j = 0; j < 4; ++j) ss += xq[i][j] * xq[i][j];
      ss = wave_sum(ss);
      const float rs = rsqrtf(ss * (1.f / 1024.f) + EPSV);
      u16* H = (u16*)(p.ws + OFF_H) + (size_t)r * 1024;
#pragma unroll
      for (int i = 0; i < 4; ++i) {
        float h0 = xq[i][0] * rs * hq[i][0] * (1.f + s1q[i][0]) + s0q[i][0];
        float h1 = xq[i][1] * rs * hq[i][1] * (1.f + s1q[i][1]) + s0q[i][1];
        float h2 = xq[i][2] * rs * hq[i][2] * (1.f + s1q[i][2]) + s0q[i][2];
        float h3 = xq[i][3] * rs * hq[i][3] * (1.f + s1q[i][3]) + s0q[i][3];
        *(u32x2*)(H + i * 256 + lane * 4) = u32x2{pack2(h0, h1), pack2(h2, h3)};
      }
    }
  }
}

DEV void gemm1_item(const P& p, int mt, int nt, char* smem) {
  f32x16 acc[2][2]; zero_acc<2>(acc);
  gemm_main<2>((const u16*)(p.ws + OFF_H) + (size_t)mt * 128 * 1024, 1024, (const u16*)(p.ws + OFF_WT + WT_IN) + (size_t)nt * 128 * 1024, 1024, 1024, acc, smem);
  const int tid0 = ltid(); const int lane = tid0 & 63, w = tid0 >> 6, wr = w >> 1, wc = w & 1, r31 = lane & 31, hh = lane >> 5;
  u16* PS = (u16*)(p.ws + OFF_R1 + R1_PS);
#pragma unroll
  for (int mi = 0; mi < 2; ++mi)
#pragma unroll
    for (int ni = 0; ni < 2; ++ni)
#pragma unroll
      for (int i = 0; i < 16; ++i) {
        int row = mt * 128 + wr * 64 + mi * 32 + rowmap16(i, lane), col = nt * 128 + wc * 64 + ni * 32 + colmap16(i, lane);
        PS[(size_t)row * PSW + col] = f2bf(acc[mi][ni][i]);
      }
}

template <int NI>
DEV void merge_item(const P& p, int mt, int nt, char* smem) {
  f32x16 z[2][NI]; zero_acc<NI>(z);
  const u16* H = (const u16*)(p.ws + OFF_H) + (size_t)mt * 128 * 1024;
  const u16* BR = (const u16*)(p.ws + OFF_R2 + R2_BR) + (size_t)mt * 128 * 1024;
  const u16* WinT = (const u16*)(p.ws + OFF_WT + WT_IN);
  const u16* WbrT = (const u16*)(p.ws + OFF_WT + WT_BR);
#pragma unroll 1
  for (int g = 0; g < 4; ++g) {
    unsigned yp[2][NI][8];
    {
      f32x16 ay[2][NI]; zero_acc<NI>(ay);
      gemm_main<NI>(BR + g * 256, 1024, WbrT + (size_t)(g * 1024 + nt * NI * 64) * 256, 256, 256, ay, smem);
#pragma unroll
      for (int mi = 0; mi < 2; ++mi)
#pragma unroll
        for (int ni = 0; ni < NI; ++ni)
#pragma unroll
          for (int j = 0; j < 8; ++j) yp[mi][ni][j] = pack2(ay[mi][ni][2 * j], ay[mi][ni][2 * j + 1]);
      __builtin_amdgcn_sched_barrier(0);
    }
    f32x16 ag[2][NI]; zero_acc<NI>(ag);
    gemm_main<NI>(H, 1024, WinT + (size_t)(2688 + g * 1024 + nt * NI * 64) * 1024, 1024, 1024, ag, smem);
#pragma unroll
    for (int mi = 0; mi < 2; ++mi)
#pragma unroll
      for (int ni = 0; ni < NI; ++ni)
#pragma unroll
        for (int j = 0; j < 8; ++j) {
          const unsigned y2 = yp[mi][ni][j];
          z[mi][ni][2 * j] += sigmoidf_(ag[mi][ni][2 * j]) * bflo(y2);
          z[mi][ni][2 * j + 1] += sigmoidf_(ag[mi][ni][2 * j + 1]) * bfhi(y2);
        }
  }
  const int tid0 = ltid(); const int lane = tid0 & 63, w = tid0 >> 6, wr = w >> 1, wc = w & 1, r31 = lane & 31, hh = lane >> 5;
  u16* Z = (u16*)(p.ws + OFF_R2 + R2_Z);
#pragma unroll
  for (int mi = 0; mi < 2; ++mi)
#pragma unroll
    for (int ni = 0; ni < NI; ++ni)
#pragma unroll
      for (int i = 0; i < 16; ++i) {
        int row = mt * 128 + wr * 64 + mi * 32 + rowmap16(i, lane), col = nt * NI * 64 + wc * NI * 32 + ni * 32 + colmap16(i, lane);
        Z[(size_t)row * 1024 + col] = f2bf(z[mi][ni][i]);
      }
}

DEV void gemm_f32_big(const u16* A, int K, const u16* Bt, float* O, int mt, int nt, char* smem) {
  f32x16 acc[2][2]; zero_acc<2>(acc);
  gemm_main<2>(A + (size_t)mt * 128 * K, K, Bt + (size_t)nt * 128 * K, K, K, acc, smem);
  const int tid0 = ltid(); const int lane = tid0 & 63, w = tid0 >> 6, wr = w >> 1, wc = w & 1, r31 = lane & 31, hh = lane >> 5;
#pragma unroll
  for (int mi = 0; mi < 2; ++mi)
#pragma unroll
    for (int ni = 0; ni < 2; ++ni)
#pragma unroll
      for (int i = 0; i < 16; ++i) {
        int row = mt * 128 + wr * 64 + mi * 32 + rowmap16(i, lane), col = nt * 128 + wc * 64 + ni * 32 + colmap16(i, lane);
        O[(size_t)row * 1024 + col] = acc[mi][ni][i];
      }
}
DEV void gemm_f32_small(const u16* A, int K, const u16* Bt, float* O, int item, char* smem) {
  const int mt = item >> 4, nt = item & 15;
  f32x16 acc[2][1]; zero_acc<1>(acc);
  gemm_main<1>(A + (size_t)(16384 + mt * 128) * K, K, Bt + (size_t)nt * 64 * K, K, K, acc, smem);
  const int tid0 = ltid(); const int lane = tid0 & 63, w = tid0 >> 6, wr = w >> 1, wc = w & 1, r31 = lane & 31, hh = lane >> 5;
#pragma unroll
  for (int mi = 0; mi < 2; ++mi)
#pragma unroll
    for (int i = 0; i < 16; ++i) {
      int row = 16384 + mt * 128 + wr * 64 + mi * 32 + rowmap16(i, lane), col = nt * 64 + wc * 32 + colmap16(i, lane);
      O[(size_t)row * 1024 + col] = acc[mi][0][i];
    }
}

DEV void seq_bounds(int r, int& s0, int& s1) {
  if (r < 16384) { s0 = r & ~8191; s1 = s0 + 8192; } else { s0 = 16384 + ((r - 16384) & ~255); s1 = s0 + 256; }
}

DEV void upact_item(const P& p, int l, int mt, int nt, char* smem) {
  const int tid = ltid();
  const int srow = mt * 254 - 1;
  const u16* H = (const u16*)(p.ws + OFF_H);
  const u16* W = (const u16*)(p.ws + OFF_WT + WT_UP);
  const u16* Ap[4];
#pragma unroll
  for (int i = 0; i < 4; ++i) {
    int gr = srow + (tid >> 2) + 64 * i;
    gr = gr < 0 ? 0 : (gr > NROW - 1 ? NROW - 1 : gr);
    Ap[i] = H + (size_t)gr * 1024 + ((tid & 3) ^ ((0x78 >> (((tid >> 4) & 3) * 2)) & 3)) * 8;
  }
  const int co = ((tid & 3) ^ ((0x78 >> (((tid >> 4) & 3) * 2)) & 3)) * 8;
  const u16* const Bp[2] = {W + (size_t)(nt * 64 + (tid >> 2)) * 1024 + co, W + (size_t)(2816 + nt * 64 + (tid >> 2)) * 1024 + co};
  f32x16 acc[4][2]; zero_big(acc);
  {
    const u16* const Ap2[4] = {Ap[0], Ap[1], Ap[2], Ap[3]};
    gemm_big_p(Ap2, Bp, 1024, acc, smem);
  }
  const int lane = tid & 63, w = tid >> 6, wr = w >> 1, wc = w & 1, r31 = lane & 31, hh = lane >> 5;
  u16* sU = (u16*)smem;
#pragma unroll
  for (int mi = 0; mi < 4; ++mi)
#pragma unroll
    for (int ni = 0; ni < 2; ++ni)
#pragma unroll
      for (int i = 0; i < 16; ++i) sU[(wr * 128 + mi * 32 + rowmap16(i, lane)) * 136 + wc * 64 + ni * 32 + colmap16(i, lane)] = f2bf(acc[mi][ni][i]);
  __syncthreads();
  const int cg_ = tid & 7, col = nt * 64 + cg_ * 8;
  const float* cw = p.ffn_conv_w + (size_t)l * 3 * 2816 + col;
  const float* cb = p.ffn_conv_b + (size_t)l * 2816 + col;
  float w0[8], w1[8], w2[8], bb[8];
#pragma unroll
  for (int q = 0; q < 2; ++q) {
    f32x4 t0 = *(const f32x4*)(cw + q * 4), t1 = *(const f32x4*)(cw + 2816 + q * 4), t2 = *(const f32x4*)(cw + 5632 + q * 4), t3 = *(const f32x4*)(cb + q * 4);
#pragma unroll
    for (int e = 0; e < 4; ++e) { w0[q * 4 + e] = t0[e]; w1[q * 4 + e] = t1[e]; w2[q * 4 + e] = t2[e]; bb[q * 4 + e] = t3[e]; }
  }
  u16* ACT = (u16*)(p.ws + OFF_R2);
  for (int k = 0; k < 8; ++k) {
    const int idx = tid + k * 256, rr = 1 + (idx >> 3);
    const int R = srow + rr;
    if (rr <= 254 && R < NROW) {
      int s0, s1; seq_bounds(R, s0, s1);
      const u32x4 z4 = {0, 0, 0, 0};
      const u32x4 am = (R - 1 >= s0) ? *(const u32x4*)(sU + (rr - 1) * 136 + cg_ * 8) : z4;
      const u32x4 a0 = *(const u32x4*)(sU + rr * 136 + cg_ * 8);
      const u32x4 ap = (R + 1 < s1) ? *(const u32x4*)(sU + (rr + 1) * 136 + cg_ * 8) : z4;
      const u32x4 gg = *(const u32x4*)(sU + rr * 136 + 64 + cg_ * 8);
      float o[8];
#pragma unroll
      for (int j = 0; j < 4; ++j) {
        float v0 = w0[2 * j] * bflo(am[j]) + w1[2 * j] * bflo(a0[j]) + w2[2 * j] * bflo(ap[j]) + bb[2 * j];
        float v1 = w0[2 * j + 1] * bfhi(am[j]) + w1[2 * j + 1] * bfhi(a0[j]) + w2[2 * j + 1] * bfhi(ap[j]) + bb[2 * j + 1];
        o[2 * j] = siluf_(v0) * bflo(gg[j]);
        o[2 * j + 1] = siluf_(v1) * bfhi(gg[j]);
      }
      *(u32x4*)(ACT + (size_t)R * 2816 + col) = u32x4{pack2(o[0], o[1]), pack2(o[2], o[3]), pack2(o[4], o[5]), pack2(o[6], o[7])};
    }
  }
  __syncthreads();
}

DEV void attnprep_item(const P& p, int tl, char* smem) {
  const int tid = ltid();
  const u16* PS = (const u16*)(p.ws + OFF_R1 + R1_PS);
  u16* QR = (u16*)(p.ws + OFF_R1 + R1_QR);
  u16* KR = (u16*)(p.ws + OFF_R1 + R1_KR);
  u16* VT = (u16*)(p.ws + OFF_R1 + R1_VT);
  const float* RT = (const float*)(p.ws + OFF_RT);
  const int r0 = tl * 128;
  const bool lat = r0 < 16384;
  const int b = lat ? (r0 >> 13) : ((r0 - 16384) >> 8);
  const int pos0 = lat ? (r0 & 8191) : 8192 + ((r0 - 16384) & 255);
  const float QS = 0.17677669529663687f * 1.4426950408889634f;
  unsigned* sKm = (unsigned*)(smem + 70656);
  if (tid < 8) sKm[tid] = 0u;
  __syncthreads();
  for (int it = 0; it < 4; ++it) {
    int task = tid + it * 256, tok = task >> 3, hc = task & 7, h = hc >> 1, c = hc & 1;
    int r = r0 + tok, pos = pos0 + tok;
    int rowi = (pos >> 6) & 127, coli = pos & 63;
    for (int qk = 0; qk < 2; ++qk) {
      const u16* src = PS + (size_t)r * PSW + (qk ? 1280 : 1024) + h * 64 + c * 32;
      float v[32];
#pragma unroll
      for (int j = 0; j < 4; ++j) {
        u32x4 u = *(const u32x4*)(src + j * 8);
#pragma unroll
        for (int e = 0; e < 4; ++e) { v[j * 8 + 2 * e] = bflo(u[e]); v[j * 8 + 2 * e + 1] = bfhi(u[e]); }
      }
      float o[32];
      if (lat) {
#pragma unroll
        for (int a = 0; a < 2; ++a) {
          int pa = a == 0 ? rowi : coli;
#pragma unroll
          for (int i = 0; i < 8; ++i) {
            float cs = RT[(pa * 8 + i) * 2], sn = RT[(pa * 8 + i) * 2 + 1];
            float x1 = v[a * 16 + i], x2 = v[a * 16 + 8 + i];
            o[a * 16 + i] = x1 * cs - x2 * sn;
            o[a * 16 + 8 + i] = x2 * cs + x1 * sn;
          }
        }
      } else {
#pragma unroll
        for (int i = 0; i < 32; ++i) o[i] = v[i];
      }
      const float sc = qk ? 1.f : QS;
      if (qk) {
        float ssk = 0.f;
#pragma unroll
        for (int i = 0; i < 32; ++i) { float t = bf2f(f2bf(o[i])); ssk += t * t; }
        ssk = fmaxf(ssk, __shfl_xor(ssk, 8)); ssk = fmaxf(ssk, __shfl_xor(ssk, 16)); ssk = fmaxf(ssk, __shfl_xor(ssk, 32));
        if ((tid & 63) < 8) atomicMax(&sKm[hc], __float_as_uint(ssk));
      }
      u16* dst = (qk ? KR : QR) + ((size_t)((b * 4 + h) * 2 + c) * KPOS + pos) * 32;
#pragma unroll
      for (int j = 0; j < 4; ++j)
        *(u32x4*)(dst + j * 8) = u32x4{pack2(o[j * 8] * sc, o[j * 8 + 1] * sc), pack2(o[j * 8 + 2] * sc, o[j * 8 + 3] * sc),
                                       pack2(o[j * 8 + 4] * sc, o[j * 8 + 5] * sc), pack2(o[j * 8 + 6] * sc, o[j * 8 + 7] * sc)};
    }
  }
  u16* sV = (u16*)smem;
  for (int it = 0; it < 16; ++it) {
    int ch = tid + it * 256, tok = ch & 127, cc = ch >> 7;
    u32x4 u = *(const u32x4*)(PS + (size_t)(r0 + tok) * PSW + 1536 + cc * 8);
    const int tokp = (tok & ~12) | ((tok & 4) << 1) | ((tok & 8) >> 1);
#pragma unroll
    for (int e = 0; e < 4; ++e) {
      sV[(cc * 8 + 2 * e) * 136 + tokp] = (u16)(u[e] & 0xffff);
      sV[(cc * 8 + 2 * e + 1) * 136 + tokp] = (u16)(u[e] >> 16);
    }
  }
  __syncthreads();
  if (tid < 8) atomicMax((unsigned*)(p.ws + OFF_KMAX) + (b * 4 + (tid >> 1)) * 2 + (tid & 1), sKm[tid]);
  {
    int hv = tid;
    u16* dst = VT + ((size_t)(b * 4) * 64 + hv) * KPOS + pos0;
#pragma unroll
    for (int j = 0; j < 16; ++j) *(u32x4*)(dst + j * 8) = *(const u32x4*)(sV + hv * 136 + j * 8);
  }
  __syncthreads();
}

DEV void ml_gates(const P& p, int l, int h, int r0, float* sG) {
  const int tid = ltid(), lane = tid & 63, w = tid >> 6;
  const u16* PS = (const u16*)(p.ws + OFF_R1 + R1_PS);
  {
    int t = tid & 127, d = tid >> 7;
    const u16* g = PS + (size_t)(r0 + t) * PSW + 2560 + d * 8;
    float ig = bf2f(g[h]) + p.ml_gate_b[((l * 2 + d) * 2 + 0) * 4 + h];
    float fg = bf2f(g[4 + h]) + p.ml_gate_b[((l * 2 + d) * 2 + 1) * 4 + h];
    float lf = fminf(fg, 0.f) - __logf(1.f + __expf(-fabsf(fg)));
    sG[d * 128 + t] = ig;
    sG[(4 + d) * 128 + t] = lf;
  }
  __syncthreads();
  if (w == 0) {
    float a = sG[4 * 128 + 2 * lane], b2 = sG[4 * 128 + 2 * lane + 1];
    float s = a + b2, incl = s;
#pragma unroll
    for (int off = 1; off < 64; off <<= 1) { float t = __shfl_up(incl, off); if (lane >= off) incl += t; }
    float excl = incl - s;
    sG[2 * 128 + 2 * lane] = excl + a;
    sG[2 * 128 + 2 * lane + 1] = excl + a + b2;
  } else if (w == 1) {
    float a = sG[5 * 128 + 2 * lane], b2 = sG[5 * 128 + 2 * lane + 1];
    float s = a + b2, incl = s;
#pragma unroll
    for (int off = 1; off < 64; off <<= 1) { float t = __shfl_down(incl, off); if (lane + off < 64) incl += t; }
    float excl = incl - s;
    sG[3 * 128 + 2 * lane + 1] = excl + b2;
    sG[3 * 128 + 2 * lane] = excl + b2 + a;
  }
  __syncthreads();
}

DEV void ml_conv8(const P& p, int l, const u16* PS, int r, int s0, int s1, int col, float scale, float* o) {
  u32x4 z4 = {0, 0, 0, 0};
  u32x4 am = (r - 1 >= s0) ? *(const u32x4*)(PS + (size_t)(r - 1) * PSW + col) : z4;
  u32x4 a0 = *(const u32x4*)(PS + (size_t)r * PSW + col);
  u32x4 ap = (r + 1 < s1) ? *(const u32x4*)(PS + (size_t)(r + 1) * PSW + col) : z4;
  const float* cw = p.ml_conv_w + (size_t)l * 3 * 512 + col;
  const float* cb = p.ml_conv_b + (size_t)l * 512 + col;
  f32x4 w0[2], w1[2], w2[2], bb[2];
#pragma unroll
  for (int q = 0; q < 2; ++q) {
    w0[q] = *(const f32x4*)(cw + q * 4); w1[q] = *(const f32x4*)(cw + 512 + q * 4); w2[q] = *(const f32x4*)(cw + 1024 + q * 4);
    bb[q] = *(const f32x4*)(cb + q * 4);
  }
#pragma unroll
  for (int j = 0; j < 4; ++j) {
    const int q = j >> 1, e = (j & 1) * 2;
    float v0 = w0[q][e] * bflo(am[j]) + w1[q][e] * bflo(a0[j]) + w2[q][e] * bflo(ap[j]) + bb[q][e];
    float v1 = w0[q][e + 1] * bfhi(am[j]) + w1[q][e + 1] * bfhi(a0[j]) + w2[q][e + 1] * bfhi(ap[j]) + bb[q][e + 1];
    o[2 * j] = siluf_(v0) * scale;
    o[2 * j + 1] = siluf_(v1) * scale;
  }
}

DEV void ml_decode(int item, int& b, int& h, int& cidx, int& r0) {
  if (item < 512) { b = item >> 8; h = (item >> 6) & 3; cidx = item & 63; }
  else { int q = item - 512; b = q >> 3; h = (q >> 1) & 3; cidx = 64 + (q & 1); }
  r0 = cidx < 64 ? b * 8192 + cidx * 128 : 16384 + b * 256 + (cidx - 64) * 128;
}

DEV void mla_item(const P& p, int l, int item, char* smem) {
  const int tid = ltid(), lane = tid & 63, w = tid >> 6, r31 = lane & 31, hh = lane >> 5;
  int b, h, cidx, r0; ml_decode(item, b, h, cidx, r0);
  int s0, s1; seq_bounds(r0, s0, s1);
  const u16* PS = (const u16*)(p.ws + OFF_R1 + R1_PS);
  float* sG = (float*)smem;
  float* sRed = (float*)(smem + 4096);
  u16* sB = (u16*)(smem + 5120);
  u16* sA0 = sB + 64 * 136;
  u16* sA1 = sA0 + 64 * 136;
  ml_gates(p, l, h, r0, sG);
  {
    int d = tid >> 7, s = tid & 127;
    float wd = d == 0 ? __expf(sG[2 * 128 + 127] - sG[2 * 128 + s] + sG[s]) : __expf(sG[3 * 128] - sG[3 * 128 + s] + sG[128 + s]);
    sG[(6 + d) * 128 + s] = wd;
  }
  __syncthreads();
  {
    int s = tid & 127, cgh = tid >> 7;
    float w0 = sG[6 * 128 + s], w1 = sG[7 * 128 + s];
    for (int i = 0; i < 4; ++i) {
      int cg_ = cgh * 4 + i;
      float o[8];
      ml_conv8(p, l, PS, r0 + s, s0, s1, 256 + h * 64 + cg_ * 8, 1.f, o);
#pragma unroll
      for (int j = 0; j < 8; ++j) sB[(cg_ * 8 + j) * 136 + s] = f2bf(o[j]);
      u32x4 u = *(const u32x4*)(PS + (size_t)(r0 + s) * PSW + 512 + h * 64 + cg_ * 8);
#pragma unroll
      for (int e = 0; e < 4; ++e) {
        float v0 = bflo(u[e]), v1 = bfhi(u[e]);
        sA0[(cg_ * 8 + 2 * e) * 136 + s] = f2bf(w0 * v0);
        sA0[(cg_ * 8 + 2 * e + 1) * 136 + s] = f2bf(w0 * v1);
        sA1[(cg_ * 8 + 2 * e) * 136 + s] = f2bf(w1 * v0);
        sA1[(cg_ * 8 + 2 * e + 1) * 136 + s] = f2bf(w1 * v1);
      }
    }
  }
  __syncthreads();
  const int d = w >> 1, ni = w & 1;
  f32x16 acc[2][1];
#pragma unroll
  for (int mi = 0; mi < 2; ++mi)
#pragma unroll
    for (int i = 0; i < 16; ++i) acc[mi][0][i] = 0.f;
  mma_lds<2, 1>(d ? sA1 : sA0, 136, 0, sB, 136, ni * 32, 128, acc, lane);
  float* DC = (float*)(p.ws + OFF_R1 + R1_DC);
  {
    float* dst = DC + ((size_t)(((b * 4 + h) * 2 + d) * 66 + cidx)) * 4160;
#pragma unroll
    for (int mi = 0; mi < 2; ++mi)
#pragma unroll
      for (int i = 0; i < 16; ++i) dst[(mi * 32 + rowmap(i, hh)) * 64 + ni * 32 + r31] = acc[mi][0][i];
    if (cidx >= 64) {
      u16* CPb = (u16*)(p.ws + OFF_R1 + R1_CP) + (size_t)(((b * 4 + h) * 2 + d) * 66) * 4160;
      if ((d == 0) == (cidx == 64)) {
#pragma unroll
        for (int mi = 0; mi < 2; ++mi)
#pragma unroll
          for (int i = 0; i < 16; ++i) {
            const int e_ = (mi * 32 + rowmap(i, hh)) * 64 + ni * 32 + r31;
            CPb[(size_t)(cidx ^ 1) * 4160 + e_] = f2bf(acc[mi][0][i]);
            CPb[(size_t)cidx * 4160 + e_] = (u16)0;
          }
      }
    }
  }
  {
    int k = tid & 63, dd = (tid >> 6) & 1, half = tid >> 7;
    float s = 0;
    for (int j = half * 64; j < half * 64 + 64; ++j) s += sG[(6 + dd) * 128 + j] * bf2f(sB[k * 136 + j]);
    sRed[tid] = s;
  }
  __syncthreads();
  if (tid < 128) {
    int k = tid & 63, dd = tid >> 6;
    DC[((size_t)(((b * 4 + h) * 2 + dd) * 66 + cidx)) * 4160 + 64 * 64 + k] = sRed[tid] + sRed[tid + 128];
    if (cidx >= 64) {
      u16* CPb = (u16*)(p.ws + OFF_R1 + R1_CP) + (size_t)(((b * 4 + h) * 2 + dd) * 66) * 4160;
      if ((dd == 0) == (cidx == 64)) {
        CPb[(size_t)(cidx ^ 1) * 4160 + 64 * 64 + k] = f2bf(sRed[tid] + sRed[tid + 128]);
        CPb[(size_t)cidx * 4160 + 64 * 64 + k] = (u16)0;
      }
    }
  }
  if (tid == 0) {
    float* DEC = (float*)(p.ws + OFF_R1 + R1_DEC);
    DEC[((b * 4 + h) * 2 + 0) * 66 + cidx] = expf(sG[2 * 128 + 127]);
    DEC[((b * 4 + h) * 2 + 1) * 66 + cidx] = expf(sG[3 * 128]);
  }
  __syncthreads();
}

DEV void scan_item(const P& p, int item) {
  const int seq = item >> 2, quarter = item & 3, d = seq & 1;
  const float* DC = (const float*)(p.ws + OFF_R1 + R1_DC) + (size_t)seq * 66 * 4160;
  const float* DEC = (const float*)(p.ws + OFF_R1 + R1_DEC) + seq * 66;
  u16* CP = (u16*)(p.ws + OFF_R1 + R1_CP) + (size_t)seq * 66 * 4160;
  float st[5];
  int e[5];
  const int tid0 = ltid();
#pragma unroll
  for (int i = 0; i < 5; ++i) { st[i] = 0.f; int q = tid0 + i * 256; e[i] = q < 1040 ? quarter * 1040 + q : quarter * 1040; }
  const bool last_ok = tid0 + 4 * 256 < 1040;
  for (int s0 = 0; s0 < 66; s0 += 6) {
    float dc[6][5], dec[6];
    int cx[6];
#pragma unroll
    for (int u = 0; u < 6; ++u) {
      int step = s0 + u;
      cx[u] = d == 0 ? (step < 2 ? 64 + step : step - 2) : (step < 2 ? 65 - step : 63 - (step - 2));
      dec[u] = DEC[cx[u]];
#pragma unroll
      for (int i = 0; i < 5; ++i) dc[u][i] = DC[(size_t)cx[u] * 4160 + e[i]];
    }
#pragma unroll
    for (int u = 0; u < 6; ++u) {
#pragma unroll
      for (int i = 0; i < 5; ++i) {
        if ((i < 4 || last_ok) && s0 + u >= 2) CP[(size_t)cx[u] * 4160 + e[i]] = f2bf(st[i]);
        st[i] = dec[u] * st[i] + dc[u][i];
      }
    }
  }
}

DEV void mlc_item(const P& p, int l, int item, char* smem) {
  const int tid = ltid(), lane = tid & 63, w = tid >> 6, r31 = lane & 31, hh = lane >> 5;
  int b, h, cidx, r0; ml_decode(item, b, h, cidx, r0);
  int s0, s1; seq_bounds(r0, s0, s1);
  const u16* PS = (const u16*)(p.ws + OFF_R1 + R1_PS);
  float* sG = (float*)smem;
  float* sN = (float*)(smem + 4096);
  u16* sK = (u16*)(smem + 4608);
  u16* sQ = sK + 128 * 72;
  u16* sC = sQ;
  u16* sVT = sQ + 128 * 72;
  ml_gates(p, l, h, r0, sG);
  {
    int d = tid >> 7, s = tid & 127;
    sG[(6 + d) * 128 + s] = sG[d * 128 + s] - sG[(2 + d) * 128 + s];
  }
  {
    for (int i = 0; i < 4; ++i) {
      int ch = tid + i * 256, s = ch >> 3, cg_ = ch & 7;
      float o[8];
      ml_conv8(p, l, PS, r0 + s, s0, s1, 256 + h * 64 + cg_ * 8, 1.f, o);
      *(u32x4*)(sK + s * 72 + cg_ * 8) = u32x4{pack2(o[0], o[1]), pack2(o[2], o[3]), pack2(o[4], o[5]), pack2(o[6], o[7])};
      ml_conv8(p, l, PS, r0 + s, s0, s1, h * 64 + cg_ * 8, 0.125f, o);
      *(u32x4*)(sQ + s * 72 + cg_ * 8) = u32x4{pack2(o[0], o[1]), pack2(o[2], o[3]), pack2(o[4], o[5]), pack2(o[6], o[7])};
    }
    int s = tid & 127, cgh = tid >> 7;
    for (int i = 0; i < 4; ++i) {
      int cg_ = cgh * 4 + i;
      u32x4 u = *(const u32x4*)(PS + (size_t)(r0 + s) * PSW + 512 + h * 64 + cg_ * 8);
#pragma unroll
      for (int e = 0; e < 4; ++e) {
        sVT[(cg_ * 8 + 2 * e) * 136 + s] = (u16)(u[e] & 0xffff);
        sVT[(cg_ * 8 + 2 * e + 1) * 136 + s] = (u16)(u[e] >> 16);
      }
    }
  }
  __syncthreads();
  bf16x8 qf[4];
#pragma unroll
  for (int ks = 0; ks < 4; ++ks) qf[ks] = *(const bf16x8*)(sQ + (w * 32 + r31) * 72 + ks * 16 + hh * 8);
  __syncthreads();
  {
    const u16* CP = (const u16*)(p.ws + OFF_R1 + R1_CP);
    for (int d = 0; d < 2; ++d) {
      const u16* src = CP + ((size_t)(((b * 4 + h) * 2 + d) * 66 + cidx)) * 4160;
      for (int ch = tid; ch < 64 * 8; ch += 256) {
        int rr = ch >> 3, cc = ch & 7;
        *(u32x4*)(sC + (d * 64 + rr) * 72 + cc * 8) = *(const u32x4*)(src + rr * 64 + cc * 8);
      }
      if (tid < 64) sN[d * 64 + tid] = bf2f(src[64 * 64 + tid]);
    }
  }
  __syncthreads();
  const int qloc = w * 32 + r31;
  f32x16 Hs[2];
#pragma unroll
  for (int vt = 0; vt < 2; ++vt)
#pragma unroll
    for (int i = 0; i < 16; ++i) Hs[vt][i] = 0.f;
#pragma unroll 1
  for (int d = 0; d < 2; ++d) {
    f32x16 R[2];
#pragma unroll
    for (int vt = 0; vt < 2; ++vt) {
#pragma unroll
      for (int i = 0; i < 16; ++i) R[vt][i] = 0.f;
#pragma unroll
      for (int ks = 0; ks < 4; ++ks) {
        bf16x8 a = *(const bf16x8*)(sC + (d * 64 + vt * 32 + r31) * 72 + ks * 16 + hh * 8);
        R[vt] = mfma(a, qf[ks], R[vt]);
      }
    }
    float nq = 0.f;
#pragma unroll
    for (int ks = 0; ks < 4; ++ks)
#pragma unroll
      for (int j = 0; j < 8; ++j) nq += sN[d * 64 + ks * 16 + hh * 8 + j] * bf2f((u16)qf[ks][j]);
    nq = xsum32(nq);
    const float Bq = sG[(2 + d) * 128 + qloc];
    const float eb = __expf(Bq);
    const int sgn = d == 0 ? 1 : -1;
#pragma unroll
    for (int vt = 0; vt < 2; ++vt)
#pragma unroll
      for (int i = 0; i < 16; ++i) R[vt][i] *= eb;
    float den = 0.f;
#pragma unroll 1
    for (int kt = 0; kt < 4; ++kt) {
      f32x16 X;
#pragma unroll
      for (int i = 0; i < 16; ++i) X[i] = 0.f;
#pragma unroll
      for (int ks = 0; ks < 4; ++ks) {
        bf16x8 a = *(const bf16x8*)(sK + (kt * 32 + r31) * 72 + ks * 16 + hh * 8);
        X = mfma(a, qf[ks], X);
      }
      float pv[16];
#pragma unroll
      for (int i = 0; i < 16; ++i) {
        int key = kt * 32 + rowmap(i, hh);
        int tdiff = sgn * (qloc - key);
        float wgt = __expf(Bq + sG[(6 + d) * 128 + key] + (float)min(tdiff, 0) * 1e30f);
        pv[i] = X[i] * wgt;
        den += pv[i];
      }
#pragma unroll
      for (int s = 0; s < 2; ++s) {
        u32x4 pu = {pack2(pv[8 * s], pv[8 * s + 1]), pack2(pv[8 * s + 2], pv[8 * s + 3]), pack2(pv[8 * s + 4], pv[8 * s + 5]), pack2(pv[8 * s + 6], pv[8 * s + 7])};
        bf16x8 pf = __builtin_bit_cast(bf16x8, pu);
        const int ks2 = kt * 2 + s;
#pragma unroll
        for (int vt = 0; vt < 2; ++vt) {
          const u16* vp = sVT + (vt * 32 + r31) * 136 + 16 * ks2 + 4 * hh;
          u32x2 lo = *(const u32x2*)vp, hi = *(const u32x2*)(vp + 8);
          u32x4 au = {lo[0], lo[1], hi[0], hi[1]};
          R[vt] = mfma(__builtin_bit_cast(bf16x8, au), pf, R[vt]);
        }
      }
    }
    den = xsum32(den);
    den += eb * nq;
    float inv = 1.f / fmaxf(fabsf(den), 1.f);
#pragma unroll
    for (int vt = 0; vt < 2; ++vt)
#pragma unroll
      for (int i = 0; i < 16; ++i) Hs[vt][i] += R[vt][i] * inv;
  }
  float ss = 0;
#pragma unroll
  for (int vt = 0; vt < 2; ++vt)
#pragma unroll
    for (int i = 0; i < 16; ++i) ss += Hs[vt][i] * Hs[vt][i];
  ss = xsum32(ss);
  const float rs = rsqrtf(ss * (1.f / 64.f) + EPSV);
  u16* BR = (u16*)(p.ws + OFF_R2 + R2_BR);
  const int row = r0 + qloc;
#pragma unroll
  for (int vt = 0; vt < 2; ++vt)
#pragma unroll
    for (int i = 0; i < 16; ++i) {
      int v = vt * 32 + rowmap(i, hh);
      float o = bf2f(PS[(size_t)row * PSW + 768 + h * 64 + v]);
      float val = Hs[vt][i] * rs * p.ml_norm[l * 256 + h * 64 + v] * sigmoidf_(o);
      BR[(size_t)row * 1024 + h * 64 + v] = f2bf(val);
    }
  __syncthreads();
}

DEV void attn_item(const P& p, int l, int item, char* smem, float lam, float lam_init) {
  const int tid = ltid(), lane = tid & 63, w = tid >> 6, r31 = lane & 31, hh = lane >> 5;
  const int c = w & 1, qs = w >> 1;
  int b, h, q0, key0, ntile;
  if (item < 1024) { b = item >> 9; h = (item >> 7) & 3; q0 = (item & 127) * 64; key0 = 0; ntile = 132; }
  else { int q = item - 1024; b = q >> 4; h = (q >> 2) & 3; q0 = 8192 + (q & 3) * 64; key0 = 8192; ntile = 4; }
  const int bh = b * 4 + h;
  const u16* QR = (const u16*)(p.ws + OFF_R1 + R1_QR);
  const u16* KR = (const u16*)(p.ws + OFF_R1 + R1_KR);
  const u16* VT = (const u16*)(p.ws + OFF_R1 + R1_VT);
  bf16x8 qf[2];
  {
    const u16* qb = QR + ((size_t)(bh * 2 + c) * KPOS + q0 + qs * 32 + r31) * 32;
    qf[0] = *(const bf16x8*)(qb + hh * 8);
    qf[1] = *(const bf16x8*)(qb + 16 + hh * 8);
  }
  constexpr int KB = 16384, STG = 32768;
  const unsigned lbase = (unsigned)(size_t)smem + tid * 16;
  const u16* kp0 = KR + ((size_t)(bh * 2) * KPOS + key0 + (tid >> 2)) * 32 + ((tid & 3) ^ ((tid >> 4) & 3)) * 8;
  const u16* vp0 = VT + ((size_t)bh * 64 + (tid >> 4)) * KPOS + key0 + ((tid & 15) ^ ((tid >> 4) & 15)) * 8;
#define AGLDS(kt, stg)                                                                                            \
  {                                                                                                               \
    _Pragma("unroll") for (int i = 0; i < 4; ++i)                                                                 \
      __builtin_amdgcn_global_load_lds((const unsigned*)(kp0 + (size_t)(i >> 1) * KPOS * 32 + (size_t)((i & 1) * 64 + (kt) * 128) * 32), \
                                       (LAS unsigned*)(lbase + (stg) * STG + i * 4096), 16, 0, 0);                \
    _Pragma("unroll") for (int i = 0; i < 4; ++i)                                                                 \
      __builtin_amdgcn_global_load_lds((const unsigned*)(vp0 + (size_t)(i * 16) * KPOS + (kt) * 128),             \
                                       (LAS unsigned*)(lbase + (stg) * STG + KB + i * 4096), 16, 0, 0);           \
  }
  f32x16 O[2], NEGM;
#pragma unroll
  for (int i = 0; i < 16; ++i) { O[0][i] = 0.f; O[1][i] = 0.f; }
  float lsum = 0.f;
  {
    float qq = 0.f;
#pragma unroll
    for (int ks = 0; ks < 2; ++ks)
#pragma unroll
      for (int j = 0; j < 8; ++j) { float t = bf2f((u16)qf[ks][j]); qq += t * t; }
    qq = xsum32(qq);
    const float k2 = __uint_as_float(__hip_atomic_load((unsigned*)(p.ws + OFF_KMAX) + bh * 2 + c, __ATOMIC_RELAXED, __HIP_MEMORY_SCOPE_AGENT));
    const float mref = sqrtf(qq * k2) * 1.001f;
#pragma unroll
    for (int i = 0; i < 16; ++i) NEGM[i] = -mref;
  }
  const int nt2 = ntile >> 1;
  const int swk = (r31 >> 2) & 3, swv = r31 & 15;
  AGLDS(0, 0);
  asm volatile("s_waitcnt vmcnt(0)" ::: "memory");
  __builtin_amdgcn_s_barrier();
  for (int kt = 0; kt < nt2; ++kt) {
    if (kt + 1 < nt2) AGLDS(kt + 1, (kt + 1) & 1);
    __builtin_amdgcn_sched_barrier(0);
    const char* kb = smem + (kt & 1) * STG + c * 8192;
    const char* vb = smem + (kt & 1) * STG + KB;
    f32x16 X[4];
#pragma unroll
    for (int k2 = 0; k2 < 4; ++k2) {
      const char* kp_ = kb + (k2 * 32 + r31) * 64;
      X[k2] = mfma(*(const bf16x8*)(kp_ + ((hh) ^ swk) * 16), qf[0], NEGM);
      X[k2] = mfma(*(const bf16x8*)(kp_ + ((2 + hh) ^ swk) * 16), qf[1], X[k2]);
    }
    float ps = 0.f;
#pragma unroll
    for (int k2 = 0; k2 < 4; ++k2)
#pragma unroll
      for (int i = 0; i < 16; ++i) { float e = __builtin_amdgcn_exp2f(X[k2][i]); X[k2][i] = e; ps += e; }
    lsum += ps;
#pragma unroll
    for (int ks2 = 0; ks2 < 8; ++ks2) {
      const int k2 = ks2 >> 1, s_ = ks2 & 1;
      u32x4 pu = {pack2(X[k2][8 * s_], X[k2][8 * s_ + 1]), pack2(X[k2][8 * s_ + 2], X[k2][8 * s_ + 3]),
                  pack2(X[k2][8 * s_ + 4], X[k2][8 * s_ + 5]), pack2(X[k2][8 * s_ + 6], X[k2][8 * s_ + 7])};
      bf16x8 pf = __builtin_bit_cast(bf16x8, pu);
#pragma unroll
      for (int vt = 0; vt < 2; ++vt) {
        bf16x8 av = *(const bf16x8*)(vb + (vt * 32 + r31) * 256 + ((2 * ks2 + hh) ^ swv) * 16);
        O[vt] = mfma(av, pf, O[vt]);
      }
    }
    __builtin_amdgcn_sched_barrier(0);
    asm volatile("s_waitcnt vmcnt(0)" ::: "memory");
    __builtin_amdgcn_s_barrier();
  }
#undef AGLDS
  const float ltot = xsum32(lsum);
  const float inv = 1.f / ltot;
  float* sX = (float*)smem;
  if (c == 1) {
#pragma unroll
    for (int vt = 0; vt < 2; ++vt)
#pragma unroll
      for (int i = 0; i < 16; ++i) sX[(qs * 32 + vt * 16 + i) * 64 + lane] = O[vt][i] * inv * lam;
  }
  __syncthreads();
  if (c == 0) {
    float ss = 0.f;
#pragma unroll
    for (int vt = 0; vt < 2; ++vt)
#pragma unroll
      for (int i = 0; i < 16; ++i) { float o = O[vt][i] * inv - sX[(qs * 32 + vt * 16 + i) * 64 + lane]; O[vt][i] = o; ss += o * o; }
    ss = xsum32(ss);
    const float rs = rsqrtf(ss * (1.f / 64.f) + EPSV) * (1.f - lam_init);
    const int qpos = q0 + qs * 32 + r31;
    const int row = qpos < 8192 ? b * 8192 + qpos : 16384 + b * 256 + (qpos - 8192);
    u16* BR = (u16*)(p.ws + OFF_R2 + R2_BR);
#pragma unroll
    for (int vt = 0; vt < 2; ++vt)
#pragma unroll
      for (int i = 0; i < 16; ++i) {
        int v = vt * 32 + rowmap(i, hh);
        BR[(size_t)row * 1024 + 256 + h * 64 + v] = f2bf(O[vt][i] * rs * p.da_subln[l * 64 + v]);
      }
  }
  __syncthreads();
}

DEV void f2_item(const P& p, int item, char* smem) {
  const int tid = ltid(), lane = tid & 63, w = tid >> 6, r31 = lane & 31, hh = lane >> 5;
  int seq, g, s2, N1, base;
  if (item < 1024) { seq = item >> 9; g = (item >> 7) & 3; s2 = item & 127; N1 = 64; base = seq * 8192; }
  else { int q = item - 1024; seq = 2 + (q >> 9); g = (q >> 7) & 3; s2 = q & 127; N1 = 2; base = 16384 + (seq - 2) * 256; }
  const u16* PS = (const u16*)(p.ws + OFF_R1 + R1_PS);
  u16* sT = (u16*)smem;
  u16* sAB = (u16*)(smem + 9216);
  float* sEx = (float*)(smem + 9216 + 17408);
  for (int i = 0; i < 2; ++i) {
    int ch = tid + i * 256, s1 = ch >> 3, cc = ch & 7;
    u32x4 v = {0, 0, 0, 0};
    if (s1 < N1) v = *(const u32x4*)(PS + (size_t)(base + 128 * s1 + s2) * PSW + 1792 + g * 64 + cc * 8);
    *(u32x4*)(sT + s1 * 72 + cc * 8) = v;
  }
  __syncthreads();
  {
    const int mi = w & 1, nh = w >> 1;
    f32x16 a1[1][2];
#pragma unroll
    for (int ni = 0; ni < 2; ++ni)
#pragma unroll
      for (int i = 0; i < 16; ++i) a1[0][ni][i] = 0.f;
    mma_lds<1, 2>(sT, 72, mi * 32, (const u16*)(p.ws + OFF_TB1), 64, nh * 64, 64, a1, lane);
#pragma unroll
    for (int ni = 0; ni < 2; ++ni)
#pragma unroll
      for (int i = 0; i < 16; ++i) sAB[(ni * 32 + r31) * 136 + nh * 64 + mi * 32 + rowmap(i, hh)] = f2bf(a1[0][ni][i]);
  }
  __syncthreads();
  {
    f32x16 a2[1][2];
#pragma unroll
    for (int ni = 0; ni < 2; ++ni)
#pragma unroll
      for (int i = 0; i < 16; ++i) a2[0][ni][i] = 0.f;
    mma_lds<1, 2>((const u16*)(p.ws + (N1 == 64 ? OFF_TA264 : OFF_TA22)), 128, w * 32, sAB, 136, 0, 128, a2, lane);
#pragma unroll
    for (int ni = 0; ni < 2; ++ni)
#pragma unroll
      for (int i = 0; i < 16; ++i) sEx[(w * 32 + rowmap(i, hh)) * 65 + ni * 32 + r31] = a2[0][ni][i];
  }
  __syncthreads();
  {
    const float* TW = (const float*)(p.ws + OFF_TW);
    u16* XRE = (u16*)(p.ws + OFF_R1 + R1_XRE);
    u16* XIM = (u16*)(p.ws + OFF_R1 + R1_XIM);
    for (int i = 0; i < 16; ++i) {
      int e = tid + i * 256, ka = e >> 6, k2 = e & 63;
      if (ka < N1) {
        float re = sEx[ka * 65 + k2], im = sEx[(64 + ka) * 65 + k2];
        int idx = (ka * s2 * (N1 == 64 ? 1 : 32)) & 8191;
        float cs = TW[2 * idx], sn = TW[2 * idx + 1];
        size_t o = ((size_t)((seq * 4 + g) * 64 + ka) * 128 + s2) * 64 + k2;
        XRE[o] = f2bf(re * cs + im * sn);
        XIM[o] = f2bf(im * cs - re * sn);
      }
    }
  }
  __syncthreads();
}

DEV void f2ctx_item(const P& p, int item, char* smem) {
  const int tid = ltid(), lane = tid & 63, w = tid >> 6, r31 = lane & 31, hh = lane >> 5;
  const int seq = 2 + (item >> 4), g = (item >> 2) & 3, grp = item & 3, base = 16384 + (seq - 2) * 256;
  const u16* PS = (const u16*)(p.ws + OFF_R1 + R1_PS);
  u16* sT = (u16*)smem;
  float* sEx = (float*)(smem + 9216 + 17408);
  for (int i = 0; i < 2; ++i) {
    int ch = tid + i * 256, rr = ch >> 3, cc = ch & 7, s1 = rr >> 5, j = rr & 31;
    *(u32x4*)(sT + rr * 72 + cc * 8) = *(const u32x4*)(PS + (size_t)(base + 128 * s1 + grp * 32 + j) * PSW + 1792 + g * 64 + cc * 8);
  }
  __syncthreads();
  {
    const int mi = w & 1, nh = w >> 1;
    f32x16 a1[1][2];
#pragma unroll
    for (int ni = 0; ni < 2; ++ni)
#pragma unroll
      for (int i = 0; i < 16; ++i) a1[0][ni][i] = 0.f;
    mma_lds<1, 2>(sT, 72, mi * 32, (const u16*)(p.ws + OFF_TB1), 64, nh * 64, 64, a1, lane);
#pragma unroll
    for (int ni = 0; ni < 2; ++ni)
#pragma unroll
      for (int i = 0; i < 16; ++i) sEx[(mi * 32 + rowmap(i, hh)) * 130 + nh * 64 + ni * 32 + r31] = a1[0][ni][i];
  }
  __syncthreads();
  {
    const float* TW = (const float*)(p.ws + OFF_TW);
    u16* XRE = (u16*)(p.ws + OFF_R1 + R1_XRE);
    u16* XIM = (u16*)(p.ws + OFF_R1 + R1_XIM);
    for (int i = 0; i < 16; ++i) {
      int e = tid + i * 256, ka = e >> 11, j = (e >> 6) & 31, k2 = e & 63;
      int s2 = grp * 32 + j;
      float a0 = sEx[j * 130 + k2], b0 = sEx[j * 130 + 64 + k2], a1v = sEx[(32 + j) * 130 + k2], b1v = sEx[(32 + j) * 130 + 64 + k2];
      float re = ka ? a0 - a1v : a0 + a1v, im = ka ? b0 - b1v : b0 + b1v;
      int idx = (ka * s2 * 32) & 8191;
      float cs = TW[2 * idx], sn = TW[2 * idx + 1];
      size_t o = ((size_t)((seq * 4 + g) * 64 + ka) * 128 + s2) * 64 + k2;
      XRE[o] = f2bf(re * cs + im * sn);
      XIM[o] = f2bf(im * cs - re * sn);
    }
  }
  __syncthreads();
}

DEV void f3_item(const P& p, int item, char* smem) {
  const int tid = ltid(), lane = tid & 63, w = tid >> 6, r31 = lane & 31, hh = lane >> 5;
  int seq, g, ka, N1, base; float scale;
  if (item < 512) { seq = item >> 8; g = (item >> 6) & 3; ka = item & 63; N1 = 64; base = seq * 8192; scale = 1.f / 724.0773439350247f; }
  else { int q = item - 512; seq = 2 + (q >> 3); g = (q >> 1) & 3; ka = q & 1; N1 = 2; base = 16384 + (seq - 2) * 256; scale = 1.f / 128.f; }
  u16* sB = (u16*)smem;
  const u16* XRE = (const u16*)(p.ws + OFF_R1 + R1_XRE) + (size_t)((seq * 4 + g) * 64 + ka) * 128 * 64;
  const u16* XIM = (const u16*)(p.ws + OFF_R1 + R1_XIM) + (size_t)((seq * 4 + g) * 64 + ka) * 128 * 64;
  {
    int s2 = tid & 127, cgh = tid >> 7;
    for (int i = 0; i < 4; ++i) {
      int cg_ = cgh * 4 + i;
      u32x4 ur = *(const u32x4*)(XRE + s2 * 64 + cg_ * 8);
      u32x4 ui = *(const u32x4*)(XIM + s2 * 64 + cg_ * 8);
#pragma unroll
      for (int e = 0; e < 4; ++e) {
        sB[(cg_ * 8 + 2 * e) * 264 + s2] = (u16)(ur[e] & 0xffff);
        sB[(cg_ * 8 + 2 * e + 1) * 264 + s2] = (u16)(ur[e] >> 16);
        sB[(cg_ * 8 + 2 * e) * 264 + 128 + s2] = (u16)(ui[e] & 0xffff);
        sB[(cg_ * 8 + 2 * e + 1) * 264 + 128 + s2] = (u16)(ui[e] >> 16);
      }
    }
  }
  __syncthreads();
  f32x16 acc[1][2];
#pragma unroll
  for (int ni = 0; ni < 2; ++ni)
#pragma unroll
    for (int i = 0; i < 16; ++i) acc[0][ni][i] = 0.f;
  mma_lds<1, 2>((const u16*)(p.ws + OFF_TCS), 256, w * 32, sB, 264, 0, 256, acc, lane);
  u16* BR = (u16*)(p.ws + OFF_R2 + R2_BR);
#pragma unroll
  for (int ni = 0; ni < 2; ++ni)
#pragma unroll
    for (int i = 0; i < 16; ++i) {
      int kb = w * 32 + rowmap(i, hh), k2 = ni * 32 + r31;
      int row = base + ka + N1 * kb;
      BR[(size_t)row * 1024 + 512 + g * 64 + k2] = f2bf(acc[0][ni][i] * scale);
    }
  __syncthreads();
}

DEV void sgu_item(const P& p, int l, int item, char* smem) {
  const int tid = ltid(), lane = tid & 63, w = tid >> 6, r31 = lane & 31, hh = lane >> 5;
  const int tl = item >> 2, g = item & 3, r0 = tl * 128;
  const u16* PS = (const u16*)(p.ws + OFF_R1 + R1_PS);
  u16* sA = (u16*)smem;
  u16* sB = (u16*)(smem + 34816);
  float* sSt = (float*)(smem + 34816 + 17408);
  {
    int tok = tid >> 1, half = tid & 1;
    const u16* src = PS + (size_t)(r0 + tok) * PSW + 2304 + half * 128;
    float s = 0, sq = 0;
    for (int j = 0; j < 16; ++j) {
      u32x4 u = *(const u32x4*)(src + j * 8);
#pragma unroll
      for (int e = 0; e < 4; ++e) { float a = geluf_(bflo(u[e])), b2 = geluf_(bfhi(u[e])); s += a + b2; sq += a * a + b2 * b2; }
    }
    s += __shfl_xor(s, 1); sq += __shfl_xor(sq, 1);
    float mean = s * (1.f / 256.f);
    float var = fmaxf(sq * (1.f / 256.f) - mean * mean, 0.f);
    if (half == 0) { sSt[tok * 2] = mean; sSt[tok * 2 + 1] = rsqrtf(var + EPSV); }
  }
  __syncthreads();
  {
    int q = tid & 127, cgh = tid >> 7;
    float mean = sSt[q * 2], rstd = sSt[q * 2 + 1];
    for (int i = 0; i < 4; ++i) {
      int cg_ = cgh * 4 + i;
      u32x4 u = *(const u32x4*)(PS + (size_t)(r0 + q) * PSW + 2304 + g * 64 + cg_ * 8);
#pragma unroll
      for (int e = 0; e < 4; ++e) {
        int d0 = cg_ * 8 + 2 * e;
        float a = (geluf_(bflo(u[e])) - mean) * rstd * p.sg_norm[l * 256 + g * 64 + d0];
        float b2 = (geluf_(bfhi(u[e])) - mean) * rstd * p.sg_norm[l * 256 + g * 64 + d0 + 1];
        sB[d0 * 136 + q] = f2bf(a);
        sB[(d0 + 1) * 136 + q] = f2bf(b2);
      }
    }
    const float* W = p.sg_w + (size_t)(l * 4 + g) * 128 * 128;
    for (int i = 0; i < 8; ++i) {
      int pr = (tid >> 4) + 16 * i, cc = (tid & 15) * 8;
      f32x4 a = *(const f32x4*)(W + pr * 128 + cc), b2 = *(const f32x4*)(W + pr * 128 + cc + 4);
      *(u32x4*)(sA + pr * 136 + cc) = u32x4{pack2(a[0], a[1]), pack2(a[2], a[3]), pack2(b2[0], b2[1]), pack2(b2[2], b2[3])};
    }
  }
  __syncthreads();
  f32x16 acc[1][2];
#pragma unroll
  for (int ni = 0; ni < 2; ++ni)
#pragma unroll
    for (int i = 0; i < 16; ++i) acc[0][ni][i] = 0.f;
  mma_lds<1, 2>(sA, 136, w * 32, sB, 136, 0, 128, acc, lane);
  u16* BR = (u16*)(p.ws + OFF_R2 + R2_BR);
#pragma unroll
  for (int ni = 0; ni < 2; ++ni)
#pragma unroll
    for (int i = 0; i < 16; ++i) {
      int pp = w * 32 + rowmap(i, hh), d = ni * 32 + r31;
      float u = geluf_(bf2f(PS[(size_t)(r0 + pp) * PSW + 2048 + g * 64 + d]));
      float val = (acc[0][ni][i] + p.sg_b[(l * 4 + g) * 128 + pp]) * u;
      BR[(size_t)(r0 + pp) * 1024 + 768 + g * 64 + d] = f2bf(val);
    }
  __syncthreads();
}

__global__ void __launch_bounds__(256, 2) mega(P p) {
  extern __shared__ __attribute__((aligned(16))) char smem[];
  cg::grid_group grid = cg::this_grid();
  __shared__ unsigned xb_st[4];
  if (threadIdx.x < 4) xb_st[threadIdx.x] = 0u;
  __syncthreads();
  XcdBarrier xb = xcd_barrier_post((unsigned*)(p.ws + OFF_BAR), (volatile LAS unsigned*)xb_st);
  int phase = 0;
  const int bid = blockIdx.x, nb = gridDim.x;
#ifndef DUP
#define DUP 0
#endif
#define PH_BEGIN if (phase >= p.ph0 && phase < p.ph1) {
#define REP_BEGIN(kind) for (int rep_ = 0; rep_ < 1 + ((DUP >> (kind)) & 1); ++rep_) { if (rep_) xcd_barrier(xb);
#define REP_END }
#define PH_END } ++phase; if (p.coop) { if (p.coop == 2 && phase == 1) grid.sync(); else xcd_barrier(xb); }

  PH_BEGIN
  for (int it = bid; it < 192 + 21 + 4320; it += nb) {
    if (it < 192) mod_item(p, it, smem);
    else if (it < 213) tab_item(p, it - 192);
    else conv_item(p, 0, it - 213, smem);
  }
  PH_END
  PH_BEGIN
  rowpass_run(p, 0, 0, bid, nb);
  PH_END

  for (int l = 0; l < 4; ++l) {
    const float lam_init = 0.8f - 0.6f * expf(-0.3f * (float)l);
    const bool last = l == 3;
    PH_BEGIN
REP_BEGIN(0)
    banded(bid, nb, 132, 21, 7, [&](int mt, int nt) { gemm1_item(p, mt, nt, smem); });
REP_END
    PH_END
    PH_BEGIN
REP_BEGIN(1)
    for (int it = bid; it < 132 + 528 + 528 + 1024 + 32; it += nb) {
      if (it < 132) attnprep_item(p, it, smem);
      else if (it < 660) mla_item(p, l, it - 132, smem);
      else if (it < 1188) { if (!(last && it - 660 >= 512)) sgu_item(p, l, it - 660, smem); }
      else if (it < 2212) f2_item(p, it - 1188, smem);
      else if (!last) f2ctx_item(p, it - 2212, smem);
    }
REP_END
    PH_END
    PH_BEGIN
    {
      float s01 = 0.f, s23 = 0.f;
      for (int i = 0; i < 32; ++i) {
        s01 += p.da_lam[l * 128 + i] * p.da_lam[l * 128 + 32 + i];
        s23 += p.da_lam[l * 128 + 64 + i] * p.da_lam[l * 128 + 96 + i];
      }
      const float lam = expf(s01) - expf(s23) + lam_init;
      {
        const int x = bid & 7, j = bid >> 3, per = nb >> 3;
        for (int r_ = 0; r_ < 1 + ((DUP >> 2) & 1); ++r_) {
          for (int q = j; q < 128; q += per) attn_item(p, l, x * 128 + q, smem, lam, lam_init);
          if (!last) for (int q = j; q < 4; q += per) attn_item(p, l, 1024 + x * 4 + q, smem, lam, lam_init);
        }
      }
      if (!last) for (int it = bid - (nb - 16); it >= 0 && it < 16; it += nb) mlc_item(p, l, 512 + it, smem);
      for (int it = bid; it < 64 + 528; it += nb) {
        if (it < 64) { for (int r_ = 0; r_ < 1 + ((DUP >> 9) & 1); ++r_) scan_item(p, it); }
        else if (!(last && it - 64 >= 512)) { for (int r_ = 0; r_ < 1 + ((DUP >> 10) & 1); ++r_) f3_item(p, it - 64, smem); }
      }
    }
    PH_END
    PH_BEGIN
REP_BEGIN(3)
    for (int it = bid; it < 512; it += nb) mlc_item(p, l, it, smem);
REP_END
    PH_END
    PH_BEGIN
REP_BEGIN(4)
    banded(bid, nb, 128, 8, 8, [&](int mt, int nt) { merge_item<2>(p, mt, nt, smem); });
    if (!last) for (int it = bid; it < 64; it += nb) merge_item<1>(p, 128 + (it >> 4), it & 15, smem);
REP_END
    PH_END
    PH_BEGIN
REP_BEGIN(5)
    banded(bid, nb, 128, 8, 8, [&](int mt, int nt) { gemm_f32_big((const u16*)(p.ws + OFF_R2 + R2_Z), 1024, (const u16*)(p.ws + OFF_WT + WT_OUT), (float*)(p.ws + OFF_R1), mt, nt, smem); });
    if (!last) for (int it = bid; it < 64; it += nb)
      gemm_f32_small((const u16*)(p.ws + OFF_R2 + R2_Z), 1024, (const u16*)(p.ws + OFF_WT + WT_OUT), (float*)(p.ws + OFF_R1), it, smem);
REP_END
    PH_END
    PH_BEGIN
    rowpass_run(p, l, 1, bid, nb);
    PH_END
    PH_BEGIN
REP_BEGIN(6)
    banded(bid, nb, 67, 44, 11, [&](int mt, int nt) { upact_item(p, l, mt, nt, smem); });
REP_END
    PH_END
    PH_BEGIN
REP_BEGIN(8)
    banded(bid, nb, 128, 8, 8, [&](int mt, int nt) { gemm_f32_big((const u16*)(p.ws + OFF_R2), 2816, (const u16*)(p.ws + OFF_WT + WT_DOWN), (float*)(p.ws + OFF_R1), mt, nt, smem); });
    if (!last) for (int it = bid; it < 64; it += nb)
      gemm_f32_small((const u16*)(p.ws + OFF_R2), 2816, (const u16*)(p.ws + OFF_WT + WT_DOWN), (float*)(p.ws + OFF_R1), it, smem);
REP_END
    PH_END
    PH_BEGIN
    {
      const int nconv = l < 3 ? 4320 : 0;
      rowpass_run(p, l, 2, bid, nb);
      for (int it = bid; it < nconv; it += nb) conv_item(p, l + 1, it, smem);
    }
    PH_END
  }
}

extern "C" void kernel_launch(void* const* d_in, const int* in_sizes, int n_in, void* d_out, int out_size, void* d_ws, size_t ws_size,
                              hipStream_t stream) {
  static int grid_blocks = 0;
  if (!grid_blocks) {
    if (hipFuncSetAttribute((const void*)mega, hipFuncAttributeMaxDynamicSharedMemorySize, LDS_BYTES) != hipSuccess) {
      fprintf(stderr, "hipFuncSetAttribute failed\n");
    }
    int dev = 0, cus = 0, per_cu = 0;
    hipGetDevice(&dev);
    hipDeviceGetAttribute(&cus, hipDeviceAttributeMultiprocessorCount, dev);
    hipOccupancyMaxActiveBlocksPerMultiprocessor(&per_cu, (const void*)mega, 256, LDS_BYTES);
    if (per_cu > 2) per_cu = 2;
    if (per_cu < 1) per_cu = 1;
    grid_blocks = cus * per_cu;
  }
  P p{};
  const float** f = (const float**)&p;
  for (int i = 0; i < 23; ++i) f[i] = (const float*)d_in[i];
  p.out = (float*)d_out;
  p.ws = (char*)d_ws;
  p.ph0 = 0; p.ph1 = 1 << 30; p.coop = 1; p.pad = 0;
  hipMemsetAsync((char*)d_ws + OFF_BAR, 0, 16384, stream);
  void* args[] = {&p};
  hipError_t e = hipLaunchCooperativeKernel((const void*)mega, dim3(grid_blocks), dim3(256), args, LDS_BYTES, stream);
  if (e != hipSuccess) fprintf(stderr, "cooperative launch failed: %s (grid %d)\n", hipGetErrorString(e), grid_blocks);
}
```

```cpp
#include <hip/hip_runtime.h>
#include <hip/hip_cooperative_groups.h>
#include <stdint.h>
#include <stdio.h>
namespace cg = cooperative_groups;

typedef unsigned short u16;
typedef short bf16x8 __attribute__((ext_vector_type(8)));
typedef float f32x16 __attribute__((ext_vector_type(16)));
typedef unsigned int u32x4 __attribute__((ext_vector_type(4)));
typedef unsigned int u32x2 __attribute__((ext_vector_type(2)));
typedef float f32x4 __attribute__((ext_vector_type(4)));
#define DEV __device__ __forceinline__

constexpr int NROW = 16896;
constexpr int PSW = 2688;
constexpr int KPOS = 8448;
constexpr int LDS_BYTES = 73728;
constexpr float EPSV = 1e-6f;

constexpr size_t OFF_MOD = 0;
constexpr size_t OFF_TB1 = 294912;
constexpr size_t OFF_TA264 = OFF_TB1 + 16384;
constexpr size_t OFF_TA22 = OFF_TA264 + 32768;
constexpr size_t OFF_TCS = OFF_TA22 + 32768;
constexpr size_t OFF_TW = OFF_TCS + 65536;
constexpr size_t OFF_RT = OFF_TW + 65536;
constexpr size_t OFF_BAR = OFF_RT + 8192;
constexpr size_t OFF_KMAX = OFF_BAR + 15360;
constexpr size_t OFF_XC = OFF_BAR + 16384;
constexpr size_t OFF_H = OFF_XC + 2097152;
constexpr size_t OFF_WT = OFF_H + 34603008;
constexpr size_t WT_IN = 0;
constexpr size_t WT_BR = (size_t)6784 * 1024 * 2;
constexpr size_t WT_OUT = WT_BR + (size_t)4 * 1024 * 256 * 2;
constexpr size_t WT_UP = WT_OUT + (size_t)1024 * 1024 * 2;
constexpr size_t WT_DOWN = WT_UP + (size_t)5632 * 1024 * 2;
constexpr size_t WT_BYTES = WT_DOWN + (size_t)1024 * 2816 * 2;
constexpr size_t OFF_R1 = OFF_WT + WT_BYTES;
constexpr size_t R1_BYTES = (size_t)NROW * 5632 * 2;
constexpr size_t R1_PS = 0;
constexpr size_t R1_QR = (size_t)NROW * PSW * 2;
constexpr size_t R1_KR = R1_QR + 8650752;
constexpr size_t R1_VT = R1_KR + 8650752;
constexpr size_t R1_XRE = R1_VT + 8650752;
constexpr size_t R1_XIM = R1_XRE + 16777216;
constexpr size_t R1_DC = R1_XIM + 16777216;
constexpr size_t R1_DEC = R1_DC + (size_t)16 * 66 * 4160 * 4;
constexpr size_t R1_CP = R1_DEC + 8192;
constexpr size_t R1_END = R1_CP + (size_t)16 * 66 * 4160 * 2;
static_assert(R1_END <= R1_BYTES, "R1 overflow");
constexpr size_t OFF_R2 = OFF_R1 + R1_BYTES;
constexpr size_t R2_BR = 0;
constexpr size_t R2_Z = 34603008;

struct P {
  const float *x, *c, *ctx, *c_ctx, *w_ada, *b_ada, *norm_g, *w_in, *ml_conv_w, *ml_conv_b, *ml_gate_b, *ml_norm,
      *da_lam, *da_subln, *sg_norm, *sg_w, *sg_b, *w_branch, *w_out, *ffn_up, *ffn_conv_w, *ffn_conv_b, *ffn_down;
  float* out;
  char* ws;
  int ph0, ph1, coop, pad;
};

DEV int ltid() { int t = threadIdx.x; asm volatile("" : "+v"(t)); return t; }

#define XB_TMO      128
#define XB_XCNT(j)  (256  + 64 * (j))
#define XB_XSUB(j)  (1280 + 64 * (j))
#define XB_XGEN(j)  (2304 + 64 * (j))
#define XB_TOP      3328
#define XB_TOPGEN   3392
#define XCD_BAR_WORDS 3456
#define XB_SPIN_CAP (1u << 23)
#define LAS __attribute__((address_space(3)))
DEV unsigned xb_ld(unsigned* p) { return __hip_atomic_load(p, __ATOMIC_RELAXED, __HIP_MEMORY_SCOPE_AGENT); }
DEV unsigned xb_add(unsigned* p, unsigned v) { return __hip_atomic_fetch_add(p, v, __ATOMIC_RELAXED, __HIP_MEMORY_SCOPE_AGENT); }
DEV unsigned xb_xcc_id() { return (unsigned)__builtin_amdgcn_s_getreg((3 << 11) | 20) & 0xFu; }
#define XB_SPIN(cond, bar) do { unsigned _sp = 0; while (cond) { __builtin_amdgcn_s_sleep(1); \
    if ((++_sp & 255u) == 0u) { if (xb_ld(&(bar)[XB_TMO])) break; if (_sp > XB_SPIN_CAP) { atomicAdd(&(bar)[XB_TMO], 1u); break; } } } } while (0)
struct XcdBarrier { unsigned* bar; unsigned x; volatile LAS unsigned* st; };
DEV XcdBarrier xcd_barrier_post(unsigned* bar, volatile LAS unsigned* st) {
  XcdBarrier b; b.bar = bar; b.x = xb_xcc_id(); b.st = st;
  if (threadIdx.x == 0) (void)xb_add(&bar[XB_XCNT(b.x)], 1u);
  return b;
}
DEV void xcd_barrier_complete(unsigned* bar, unsigned x, unsigned& nloc, unsigned& nx) {
  const unsigned G = gridDim.x * gridDim.y * gridDim.z;
  unsigned sum, cnt, mine, sp = 0u;
  for (;;) {
    sum = 0u; cnt = 0u; mine = 0u;
#pragma unroll
    for (unsigned j = 0; j < 16; ++j) { const unsigned c = xb_ld(&bar[XB_XCNT(j)]); sum += c; cnt += (c > 0u) ? 1u : 0u; mine = (j == x) ? c : mine; }
    if (sum == G) break;
    __builtin_amdgcn_s_sleep(1);
    if ((++sp & 255u) == 0u) { if (xb_ld(&bar[XB_TMO])) break; if (sp > XB_SPIN_CAP) { atomicAdd(&bar[XB_TMO], 1u); break; } }
  }
  nloc = mine > 0u ? mine : 1u; nx = cnt > 0u ? cnt : 1u;
}
DEV void xcd_barrier(const XcdBarrier& b) {
  asm volatile("s_waitcnt vmcnt(0)" ::: "memory");
  __syncthreads();
  if (threadIdx.x == 0) {
    unsigned* bar = b.bar;
    __builtin_amdgcn_s_waitcnt(0);
    unsigned nloc = b.st[0], nx = b.st[1];
    if (nloc == 0u) { xcd_barrier_complete(bar, b.x, nloc, nx); b.st[0] = nloc; b.st[1] = nx; }
    const unsigned old = xb_add(&bar[XB_XSUB(b.x)], 1u);
    const unsigned gen = old / nloc;
    if (old + 1u == (gen + 1u) * nloc) {
      __builtin_amdgcn_fence(__ATOMIC_RELEASE, "agent");
      asm volatile("s_waitcnt vmcnt(0)" ::: "memory");
      const unsigned og = xb_add(&bar[XB_TOP], 1u);
      const unsigned tg = og / nx;
      if (og + 1u == (tg + 1u) * nx) xb_add(&bar[XB_TOPGEN], 1u);
      else XB_SPIN(xb_ld(&bar[XB_TOPGEN]) == tg, bar);
      __builtin_amdgcn_fence(__ATOMIC_ACQUIRE, "agent");
      xb_add(&bar[XB_XGEN(b.x)], 1u);
      asm volatile("s_waitcnt vmcnt(0)" ::: "memory");
    } else {
      XB_SPIN(xb_ld(&bar[XB_XGEN(b.x)]) == gen, bar);
      __builtin_amdgcn_fence(__ATOMIC_ACQUIRE, "agent");
      asm volatile("s_waitcnt vmcnt(0)" ::: "memory");
    }
  }
  __syncthreads();
}

DEV float bf2f(u16 h) { return __uint_as_float(((unsigned)h) << 16); }
typedef __bf16 hwbf16x2 __attribute__((ext_vector_type(2)));
typedef float f32x2 __attribute__((ext_vector_type(2)));
DEV unsigned pack2(float a, float b) { f32x2 v = {a, b}; hwbf16x2 r = __builtin_convertvector(v, hwbf16x2); return __builtin_bit_cast(unsigned, r); }
DEV u16 f2bf(float f) { return (u16)pack2(f, f); }
DEV float bflo(unsigned u) { return __uint_as_float(u << 16); }
DEV float bfhi(unsigned u) { return __uint_as_float(u & 0xffff0000u); }
DEV float sigmoidf_(float x) { return __builtin_amdgcn_rcpf(1.f + __expf(-x)); }
DEV float siluf_(float x) { return x * __builtin_amdgcn_rcpf(1.f + __expf(-x)); }
DEV float geluf_(float x) { return x * __builtin_amdgcn_rcpf(1.f + __expf(-1.5957691216057308f * (x + 0.044715f * x * x * x))); }
DEV float xmax32(float v) { auto r = __builtin_amdgcn_permlane32_swap(__float_as_uint(v), __float_as_uint(v), false, false); return fmaxf(__uint_as_float(r[0]), __uint_as_float(r[1])); }
DEV float xsum32(float v) { auto r = __builtin_amdgcn_permlane32_swap(__float_as_uint(v), __float_as_uint(v), false, false); return __uint_as_float(r[0]) + __uint_as_float(r[1]); }
DEV int rowmap(int i, int hh) { return (i & 3) + 8 * (i >> 2) + 4 * hh; }
DEV f32x16 mfma(bf16x8 a, bf16x8 b, f32x16 c) { return __builtin_amdgcn_mfma_f32_32x32x16_bf16(a, b, c, 0, 0, 0); }

template <int MI, int NI>
DEV void mma_lds(const u16* sA, int lda, int rowA0, const u16* sB, int ldb, int rowB0, int K, f32x16 (&acc)[MI][NI], int lane) {
  const int r = lane & 31, h = lane >> 5;
  for (int k0 = 0; k0 < K; k0 += 16) {
    bf16x8 a[MI], b[NI];
#pragma unroll
    for (int mi = 0; mi < MI; ++mi) a[mi] = *(const bf16x8*)(sA + (size_t)(rowA0 + mi * 32 + r) * lda + k0 + h * 8);
#pragma unroll
    for (int ni = 0; ni < NI; ++ni) b[ni] = *(const bf16x8*)(sB + (size_t)(rowB0 + ni * 32 + r) * ldb + k0 + h * 8);
#pragma unroll
    for (int mi = 0; mi < MI; ++mi)
#pragma unroll
      for (int ni = 0; ni < NI; ++ni) acc[mi][ni] = mfma(a[mi], b[ni], acc[mi][ni]);
  }
}

DEV int rowmap16(int i, int lane) { return ((i >> 3) & 1) * 16 + (lane >> 4) * 4 + (i & 3); }
DEV int colmap16(int i, int lane) { return ((i >> 2) & 1) * 16 + (lane & 15); }
template <int NI>
DEV void gemm_main(const u16* __restrict__ A, int lda, const u16* __restrict__ Bt, int ldb, int K, f32x16 (&acc)[2][NI], char* smem, int bsplit = 0) {
  constexpr int ABYTES = 128 * 128, STG = ABYTES + NI * 64 * 128;
  const int tid = ltid(), lane = tid & 63, w = tid >> 6, wr = w >> 1, wc = w & 1;
  const int r15 = lane & 15, q4 = lane >> 4;
  const int nk = K / 64;
  const unsigned lbase = (unsigned)(size_t)smem + tid * 16;
  const int sw = (r15 >> 1) & 7;
  const int co = ((tid & 7) ^ ((tid >> 4) & 7)) * 8;
  const u16* Ap = A + (size_t)(tid >> 3) * lda + co;
  const u16* Bp = Bt + (size_t)(tid >> 3) * ldb + co;
  f32x4 c[4][NI * 2];
#pragma unroll
  for (int m = 0; m < 4; ++m)
#pragma unroll
    for (int n = 0; n < NI * 2; ++n)
#pragma unroll
      for (int j = 0; j < 4; ++j) c[m][n][j] = acc[m >> 1][n >> 1][((m & 1) * 2 + (n & 1)) * 4 + j];
#define GLDS(kt, stg)                                                                                             \
  {                                                                                                               \
    _Pragma("unroll") for (int i = 0; i < 4; ++i)                                                                 \
      __builtin_amdgcn_global_load_lds((const unsigned*)(Ap + (size_t)(i * 32) * lda + (kt) * 64), (LAS unsigned*)(lbase + (stg) * STG + i * 4096), 16, 0, 0); \
    _Pragma("unroll") for (int i = 0; i < NI * 2; ++i)                                                            \
      __builtin_amdgcn_global_load_lds((const unsigned*)(Bp + (size_t)(i * 32 + (i >= NI ? bsplit : 0)) * ldb + (kt) * 64), (LAS unsigned*)(lbase + (stg) * STG + ABYTES + i * 4096), 16, 0, 0); \
  }
  GLDS(0, 0);
  asm volatile("s_waitcnt vmcnt(0)" ::: "memory");
  __builtin_amdgcn_s_barrier();
  for (int kt = 0; kt < nk; ++kt) {
    if (kt + 1 < nk) GLDS(kt + 1, (kt + 1) & 1);
    __builtin_amdgcn_sched_barrier(0);
    const char* base = smem + (kt & 1) * STG;
#pragma unroll
    for (int kk = 0; kk < 2; ++kk) {
      bf16x8 a[4], b[NI * 2];
      const int so = ((kk * 4 + q4) ^ sw) * 16;
#pragma unroll
      for (int m = 0; m < 4; ++m) a[m] = *(const bf16x8*)(base + (wr * 64 + m * 16 + r15) * 128 + so);
#pragma unroll
      for (int n = 0; n < NI * 2; ++n) b[n] = *(const bf16x8*)(base + ABYTES + (wc * NI * 32 + n * 16 + r15) * 128 + so);
#pragma unroll
      for (int m = 0; m < 4; ++m)
#pragma unroll
        for (int n = 0; n < NI * 2; ++n) c[m][n] = __builtin_amdgcn_mfma_f32_16x16x32_bf16(a[m], b[n], c[m][n], 0, 0, 0);
    }
    __builtin_amdgcn_sched_barrier(0);
    asm volatile("s_waitcnt vmcnt(0)" ::: "memory");
    __builtin_amdgcn_s_barrier();
  }
#undef GLDS
#pragma unroll
  for (int m = 0; m < 4; ++m)
#pragma unroll
    for (int n = 0; n < NI * 2; ++n)
#pragma unroll
      for (int j = 0; j < 4; ++j) acc[m >> 1][n >> 1][((m & 1) * 2 + (n & 1)) * 4 + j] = c[m][n][j];
}

template <int NI>
DEV void zero_acc(f32x16 (&acc)[2][NI]) {
#pragma unroll
  for (int mi = 0; mi < 2; ++mi)
#pragma unroll
    for (int ni = 0; ni < NI; ++ni)
#pragma unroll
      for (int i = 0; i < 16; ++i) acc[mi][ni][i] = 0.f;
}

DEV void gemm_big_p(const u16* const (&Ap)[4], const u16* const (&Bp)[2], int K, f32x16 (&acc)[4][2], char* smem) {
  constexpr int ABYTES = 256 * 64, STG = ABYTES + 128 * 64;
  const int tid = ltid(), lane = tid & 63, w = tid >> 6, wr = w >> 1, wc = w & 1;
  const int r15 = lane & 15, q4 = lane >> 4;
  const int nk = K / 32;
  const unsigned lbase = (unsigned)(size_t)smem + tid * 16;
  const int so = (q4 ^ ((0x78 >> (((r15 >> 2) & 3) * 2)) & 3)) * 16;
  f32x4 c[8][4];
#pragma unroll
  for (int m = 0; m < 8; ++m)
#pragma unroll
    for (int n = 0; n < 4; ++n)
#pragma unroll
      for (int j = 0; j < 4; ++j) c[m][n][j] = acc[m >> 1][n >> 1][((m & 1) * 2 + (n & 1)) * 4 + j];
#define GLDS(kt, stg)                                                                                             \
  {                                                                                                               \
    _Pragma("unroll") for (int i = 0; i < 4; ++i)                                                                 \
      __builtin_amdgcn_global_load_lds((const unsigned*)(Ap[i] + (kt) * 32), (LAS unsigned*)(lbase + (stg) * STG + i * 4096), 16, 0, 0); \
    _Pragma("unroll") for (int i = 0; i < 2; ++i)                                                                 \
      __builtin_amdgcn_global_load_lds((const unsigned*)(Bp[i] + (kt) * 32), (LAS unsigned*)(lbase + (stg) * STG + ABYTES + i * 4096), 16, 0, 0); \
  }
  GLDS(0, 0);
  if (nk > 1) { GLDS(1, 1); asm volatile("s_waitcnt vmcnt(6)" ::: "memory"); }
  else asm volatile("s_waitcnt vmcnt(0)" ::: "memory");
  __builtin_amdgcn_s_barrier();
  int cur = 0;
  for (int kt = 0; kt < nk; ++kt) {
    int nxt2 = cur + 2; if (nxt2 >= 3) nxt2 -= 3;
    if (kt + 2 < nk) GLDS(kt + 2, nxt2);
    __builtin_amdgcn_sched_barrier(0);
    const char* base = smem + cur * STG;
    {
      bf16x8 a[8], b[4];
#pragma unroll
      for (int m = 0; m < 8; ++m) a[m] = *(const bf16x8*)(base + (wr * 128 + m * 16 + r15) * 64 + so);
#pragma unroll
      for (int n = 0; n < 4; ++n) b[n] = *(const bf16x8*)(base + ABYTES + (wc * 64 + n * 16 + r15) * 64 + so);
#pragma unroll
      for (int m = 0; m < 8; ++m)
#pragma unroll
        for (int n = 0; n < 4; ++n) c[m][n] = __builtin_amdgcn_mfma_f32_16x16x32_bf16(a[m], b[n], c[m][n], 0, 0, 0);
    }
    __builtin_amdgcn_sched_barrier(0);
    if (kt + 2 < nk) asm volatile("s_waitcnt vmcnt(6)" ::: "memory");
    else asm volatile("s_waitcnt vmcnt(0)" ::: "memory");
    __builtin_amdgcn_s_barrier();
    cur = cur + 1 == 3 ? 0 : cur + 1;
  }
#undef GLDS
#pragma unroll
  for (int m = 0; m < 8; ++m)
#pragma unroll
    for (int n = 0; n < 4; ++n)
#pragma unroll
      for (int j = 0; j < 4; ++j) acc[m >> 1][n >> 1][((m & 1) * 2 + (n & 1)) * 4 + j] = c[m][n][j];
}
DEV void gemm_big(const u16* __restrict__ A, int lda, const u16* __restrict__ Bt, int ldb, int K, f32x16 (&acc)[4][2], char* smem) {
  const int tid = ltid();
  const int co = ((tid & 3) ^ ((0x78 >> (((tid >> 4) & 3) * 2)) & 3)) * 8;
  const u16* a0 = A + (size_t)(tid >> 2) * lda + co;
  const u16* b0 = Bt + (size_t)(tid >> 2) * ldb + co;
  const u16* const Ap[4] = {a0, a0 + (size_t)64 * lda, a0 + (size_t)128 * lda, a0 + (size_t)192 * lda};
  const u16* const Bp[2] = {b0, b0 + (size_t)64 * ldb};
  gemm_big_p(Ap, Bp, K, acc, smem);
}
DEV void zero_big(f32x16 (&acc)[4][2]) {
#pragma unroll
  for (int mi = 0; mi < 4; ++mi)
#pragma unroll
    for (int ni = 0; ni < 2; ++ni)
#pragma unroll
      for (int i = 0; i < 16; ++i) acc[mi][ni][i] = 0.f;
}
template <class F>
DEV void banded(int bid, int nb, int MT, int NT, int W, F f) {
  const int TOT = MT * NT, x = bid & 7, j = bid >> 3, per = nb >> 3, chunk = (TOT + 7) >> 3;
  for (int q = j; q < chunk; q += per) {
    int t = x * chunk + q;
    if (t >= TOT) break;
    int band = t / (MT * W), r = t - band * MT * W;
    int mt = r / W, nt = band * W + r - mt * W;
    f(mt, nt);
  }
}

DEV void mod_item(const P& p, int item, char* smem) {
  float* sS = (float*)smem;
  float* sR = sS + 3072;
  const int tid = ltid();
  for (int i = tid; i < 3072; i += 256) {
    int v = i >> 10, k = i & 1023;
    float c = v < 2 ? p.c[v * 1024 + k] : p.c_ctx[k];
    sS[i] = c * __builtin_amdgcn_rcpf(1.f + __expf(-c));
  }
  __syncthreads();
  const int l = item / 48, cgp = item % 48, cc = tid & 31, kq = tid >> 5;
  const float* w = p.w_ada + (size_t)l * 1024 * 6144 + cgp * 128 + cc * 4;
  f32x4 a0 = {0.f, 0.f, 0.f, 0.f}, a1 = a0, a2 = a0;
#pragma unroll 8
  for (int k = kq * 128; k < kq * 128 + 128; ++k) {
    const f32x4 wv = *(const f32x4*)(w + (size_t)k * 6144);
    const float s0 = sS[k], s1 = sS[1024 + k], s2 = sS[2048 + k];
    a0 += wv * s0; a1 += wv * s1; a2 += wv * s2;
  }
#pragma unroll
  for (int e = 0; e < 4; ++e) {
    sR[(kq * 3 + 0) * 128 + cc * 4 + e] = a0[e];
    sR[(kq * 3 + 1) * 128 + cc * 4 + e] = a1[e];
    sR[(kq * 3 + 2) * 128 + cc * 4 + e] = a2[e];
  }
  __syncthreads();
  for (int o = tid; o < 384; o += 256) {
    int v = o >> 7, c2 = o & 127;
    float s_ = 0;
    for (int q = 0; q < 8; ++q) s_ += sR[(q * 3 + v) * 128 + c2];
    int col2 = cgp * 128 + c2;
    ((float*)(p.ws + OFF_MOD))[(l * 3 + v) * 6144 + col2] = s_ + p.b_ada[l * 6144 + col2];
  }
  __syncthreads();
}

DEV void tab_item(const P& p, int item) {
  u16* TB1 = (u16*)(p.ws + OFF_TB1);
  u16* TA264 = (u16*)(p.ws + OFF_TA264);
  u16* TA22 = (u16*)(p.ws + OFF_TA22);
  u16* TCS = (u16*)(p.ws + OFF_TCS);
  float* TW = (float*)(p.ws + OFF_TW);
  float* RT = (float*)(p.ws + OFF_RT);
  const int tid0 = ltid();
  for (int i = 0; i < 16; ++i) {
    int e = item * 4096 + i * 256 + tid0;
    float s, c;
    if (e < 8192) {
      int n = e >> 6, d = e & 63, m = ((n & 63) * d) & 63;
      sincospif(m / 32.f, &s, &c);
      TB1[e] = f2bf(n < 64 ? c : -s);
    } else if (e < 24576) {
      int q = e - 8192, r = q >> 7, j = q & 127, ka = r & 63, s1 = j & 63, m = (ka * s1) & 63;
      sincospif(m / 32.f, &s, &c);
      bool im = r >= 64, sec = j >= 64;
      float v = !im ? (sec ? s : c) : (sec ? c : -s);
      TA264[q] = f2bf(v);
    } else if (e < 40960) {
      int q = e - 24576, r = q >> 7, j = q & 127, ka = r & 63, s1 = j & 63;
      bool im = r >= 64, sec = j >= 64;
      float v = 0.f;
      if (ka < 2 && s1 < 2 && (im == sec)) v = (ka & s1) ? -1.f : 1.f;
      TA22[q] = f2bf(v);
    } else if (e < 73728) {
      int q = e - 40960, kb = q >> 8, j = q & 255, s2 = j & 127, m = (kb * s2) & 127;
      sincospif(m / 64.f, &s, &c);
      TCS[q] = f2bf(j < 128 ? c : s);
    } else if (e < 81920) {
      int q = e - 73728;
      sincospif(q / 4096.f, &s, &c);
      TW[2 * q] = c; TW[2 * q + 1] = s;
    } else if (e < 82944) {
      int q = e - 81920, pos = q >> 3, fi = q & 7;
      float fr = exp2f(-(float)fi * 0.125f * 13.287712379549449f);
      float ang = (float)pos * fr;
      double t = (double)ang * 0.3183098861837907;
      t -= 2.0 * floor(t * 0.5);
      sincospif((float)t, &s, &c);
      RT[2 * q] = c; RT[2 * q + 1] = s;
    }
  }
}

DEV void conv_item(const P& p, int l, int item, char* smem) {
  float* tile = (float*)smem;
  const int tid = ltid();
  char* WT = p.ws + OFF_WT;
  const float* src; u16* dst; int K, Nsrc, kt, nt, mode = 0;
  if (item < 1696) { src = p.w_in + (size_t)l * 1024 * 6672; K = 1024; Nsrc = 6672; dst = (u16*)(WT + WT_IN); kt = item % 16; nt = item / 16; mode = 1; }
  else if (item < 1952) { int q = item - 1696; int g = q >> 6; q &= 63; src = p.w_branch + (size_t)(l * 4 + g) * 256 * 1024; K = 256; Nsrc = 1024; dst = (u16*)(WT + WT_BR) + (size_t)g * 1024 * 256; kt = q % 4; nt = q / 4; }
  else if (item < 2208) { int q = item - 1952; src = p.w_out + (size_t)l * 1024 * 1024; K = 1024; Nsrc = 1024; dst = (u16*)(WT + WT_OUT); kt = q % 16; nt = q / 16; }
  else if (item < 3616) { int q = item - 2208; src = p.ffn_up + (size_t)l * 1024 * 5632; K = 1024; Nsrc = 5632; dst = (u16*)(WT + WT_UP); kt = q % 16; nt = q / 16; }
  else { int q = item - 3616; src = p.ffn_down + (size_t)l * 2816 * 1024; K = 2816; Nsrc = 1024; dst = (u16*)(WT + WT_DOWN); kt = q % 44; nt = q / 44; }
  int nd = nt * 64 + (tid & 15) * 4, ns = nd; bool valid = true;
  if (mode) {
    if (nd < 1024) ns = nd;
    else if (nd < 2560) ns = nd + 16;
    else if (nd < 2576) ns = 1024 + nd - 2560;
    else if (nd < 2688) valid = false;
    else ns = nd - 112;
  }
#pragma unroll
  for (int i = 0; i < 4; ++i) {
    int kk = (tid >> 4) + 16 * i;
    f32x4 v = {0.f, 0.f, 0.f, 0.f};
    if (valid) v = *(const f32x4*)(src + (size_t)(kt * 64 + kk) * Nsrc + ns);
    float* t = tile + kk * 65 + (tid & 15) * 4;
    t[0] = v[0]; t[1] = v[1]; t[2] = v[2]; t[3] = v[3];
  }
  __syncthreads();
  const int n = tid >> 2, kq = tid & 3;
  unsigned pk[8];
#pragma unroll
  for (int j = 0; j < 8; ++j) pk[j] = pack2(tile[(kq * 16 + 2 * j) * 65 + n], tile[(kq * 16 + 2 * j + 1) * 65 + n]);
  u32x4* d = (u32x4*)(dst + (size_t)(nt * 64 + n) * K + kt * 64 + kq * 16);
  d[0] = u32x4{pk[0], pk[1], pk[2], pk[3]};
  d[1] = u32x4{pk[4], pk[5], pk[6], pk[7]};
  __syncthreads();
}

DEV float dpp_add(float v, int ctrl_is) { return v; }
DEV float wave_sum(float v) {
  int x = __float_as_int(v);
  v += __int_as_float(__builtin_amdgcn_update_dpp(0, x, 0xB1, 0xF, 0xF, true));
  x = __float_as_int(v);
  v += __int_as_float(__builtin_amdgcn_update_dpp(0, x, 0x4E, 0xF, 0xF, true));
  x = __float_as_int(v);
  v += __int_as_float(__builtin_amdgcn_update_dpp(0, x, 0x141, 0xF, 0xF, true));
  x = __float_as_int(v);
  v += __int_as_float(__builtin_amdgcn_update_dpp(0, x, 0x140, 0xF, 0xF, true));
  x = __float_as_int(v);
  return __int_as_float(__builtin_amdgcn_readlane(x, 0)) + __int_as_float(__builtin_amdgcn_readlane(x, 16)) +
         __int_as_float(__builtin_amdgcn_readlane(x, 32)) + __int_as_float(__builtin_amdgcn_readlane(x, 48));
}

DEV void rowpass_item(const P& p, int l, int mode, int item) {
  const int tid0 = ltid(); const int w = tid0 >> 6, lane = tid0 & 63, r = item * 4 + w;
  const int vec = r < 8192 ? 0 : (r < 16384 ? 1 : 2);
  float* X = r < 16384 ? p.out + (size_t)r * 1024 : (float*)(p.ws + OFF_XC) + (size_t)(r - 16384) * 1024;
  const float* MOD = (const float*)(p.ws + OFF_MOD);
  const int lh = (mode == 2) ? l + 1 : l;
  const bool doh = lh < 4;
  const int lhc = doh ? lh : 3;
  const float* xsrc = mode == 0 ? (r < 16384 ? p.x + (size_t)r * 1024 : p.ctx + (size_t)(r - 16384) * 1024) : X;
  const float* Y = (const float*)(p.ws + OFF_R1) + (size_t)r * 1024;
  const float* gate = MOD + (size_t)(l * 3 + vec) * 6144 + (mode == 1 ? 2 : 5) * 1024;
  const float* gp = p.norm_g + (size_t)(l * 4 + (mode == 1 ? 1 : 3)) * 1024;
  const float* g = p.norm_g + (size_t)(lhc * 4 + (mode == 1 ? 2 : 0)) * 1024;
  const float* sc = MOD + (size_t)(lhc * 3 + vec) * 6144 + (mode == 1 ? 4 : 1) * 1024;
  const float* sh = MOD + (size_t)(lhc * 3 + vec) * 6144 + (mode == 1 ? 3 : 0) * 1024;
  f32x4 xq[4], yq[4], gq[4], nq[4], hq[4], s1q[4], s0q[4];
#pragma unroll
  for (int i = 0; i < 4; ++i) {
    xq[i] = *(const f32x4*)(xsrc + i * 256 + lane * 4);
    if (mode != 0) {
      yq[i] = *(const f32x4*)(Y + i * 256 + lane * 4);
      gq[i] = *(const f32x4*)(gate + i * 256 + lane * 4);
      nq[i] = *(const f32x4*)(gp + i * 256 + lane * 4);
    }
    hq[i] = *(const f32x4*)(g + i * 256 + lane * 4);
    s1q[i] = *(const f32x4*)(sc + i * 256 + lane * 4);
    s0q[i] = *(const f32x4*)(sh + i * 256 + lane * 4);
  }
  if (mode != 0) {
    float ss = 0;
#pragma unroll
    for (int i = 0; i < 4; ++i)
#pragma unroll
      for (int j = 0; j < 4; ++j) ss += yq[i][j] * yq[i][j];
    ss = wave_sum(ss);
    const float rs = rsqrtf(ss * (1.f / 1024.f) + EPSV);
#pragma unroll
    for (int i = 0; i < 4; ++i)
#pragma unroll
      for (int j = 0; j < 4; ++j) xq[i][j] += gq[i][j] * (yq[i][j] * rs * nq[i][j]);
  }
#pragma unroll
  for (int i = 0; i < 4; ++i) *(f32x4*)(X + i * 256 + lane * 4) = xq[i];
  if (doh) {
    float ss = 0;
#pragma unroll
    for (int i = 0; i < 4; ++i)
#pragma unroll
      for (int j = 0; j < 4; ++j) ss += xq[i][j] * xq[i][j];
    ss = wave_sum(ss);
    const float rs = rsqrtf(ss * (1.f / 1024.f) + EPSV);
    u16* H = (u16*)(p.ws + OFF_H) + (size_t)r * 1024;
#pragma unroll
    for (int i = 0; i < 4; ++i) {
      float h0 = xq[i][0] * rs * hq[i][0] * (1.f + s1q[i][0]) + s0q[i][0];
      float h1 = xq[i][1] * rs * hq[i][1] * (1.f + s1q[i][1]) + s0q[i][1];
      float h2 = xq[i][2] * rs * hq[i][2] * (1.f + s1q[i][2]) + s0q[i][2];
      float h3 = xq[i][3] * rs * hq[i][3] * (1.f + s1q[i][3]) + s0q[i][3];
      *(u32x2*)(H + i * 256 + lane * 4) = u32x2{pack2(h0, h1), pack2(h2, h3)};
    }
  }
}

DEV void rowpass_run(const P& p, int l, int mode, int bid, int nb) {
  const int tid0 = ltid(); const int w = tid0 >> 6, lane = tid0 & 63;
  const float* MOD = (const float*)(p.ws + OFF_MOD);
  const int lh = (mode == 2) ? l + 1 : l;
  const bool doh = lh < 4;
  const int lhc = doh ? lh : 3;
  const float* gp = p.norm_g + (size_t)(l * 4 + (mode == 1 ? 1 : 3)) * 1024;
  const float* g = p.norm_g + (size_t)(lhc * 4 + (mode == 1 ? 2 : 0)) * 1024;
  f32x4 gq[4], nq[4], hq[4], s1q[4], s0q[4];
#pragma unroll
  for (int i = 0; i < 4; ++i) {
    nq[i] = *(const f32x4*)(gp + i * 256 + lane * 4);
    hq[i] = *(const f32x4*)(g + i * 256 + lane * 4);
    gq[i] = nq[i]; s1q[i] = nq[i]; s0q[i] = nq[i];
  }
  int cur = -1;
  for (int it = bid; it < NROW / 4; it += nb) {
    const int r = it * 4 + w;
    const int vec = r < 8192 ? 0 : (r < 16384 ? 1 : 2);
    float* X = r < 16384 ? p.out + (size_t)r * 1024 : (float*)(p.ws + OFF_XC) + (size_t)(r - 16384) * 1024;
    const float* xsrc = mode == 0 ? (r < 16384 ? p.x + (size_t)r * 1024 : p.ctx + (size_t)(r - 16384) * 1024) : X;
    const float* Y = (const float*)(p.ws + OFF_R1) + (size_t)r * 1024;
    f32x4 xq[4], yq[4];
#pragma unroll
    for (int i = 0; i < 4; ++i) {
      xq[i] = *(const f32x4*)(xsrc + i * 256 + lane * 4);
      if (mode != 0) yq[i] = *(const f32x4*)(Y + i * 256 + lane * 4);
    }
    if (vec != cur) {
      cur = vec;
      const float* gate = MOD + (size_t)(l * 3 + vec) * 6144 + (mode == 1 ? 2 : 5) * 1024;
      const float* sc = MOD + (size_t)(lhc * 3 + vec) * 6144 + (mode == 1 ? 4 : 1) * 1024;
      const float* sh = MOD + (size_t)(lhc * 3 + vec) * 6144 + (mode == 1 ? 3 : 0) * 1024;
#pragma unroll
      for (int i = 0; i < 4; ++i) {
        if (mode != 0) gq[i] = *(const f32x4*)(gate + i * 256 + lane * 4);
        s1q[i] = *(const f32x4*)(sc + i * 256 + lane * 4);
        s0q[i] = *(const f32x4*)(sh + i * 256 + lane * 4);
      }
    }
    if (mode != 0) {
      float ss = 0;
#pragma unroll
      for (int i = 0; i < 4; ++i)
#pragma unroll
        for (int j = 0; j < 4; ++j) ss += yq[i][j] * yq[i][j];
      ss = wave_sum(ss);
      const float rs = rsqrtf(ss * (1.f / 1024.f) + EPSV);
#pragma unroll
      for (int i = 0; i < 4; ++i)
#pragma unroll
        for (int j = 0; j < 4; ++j) xq[i][j] += gq[i][j] * (yq[i][j] * rs * nq[i][j]);
    }
#pragma unroll
    for (int i = 0; i < 4; ++i) *(f32x4*)(X + i * 256 + lane * 4) = xq[i];
    if (doh) {
      float ss = 0;
#pragma unroll
      for (int i = 0; i < 4; ++i)
#pragma unroll
        for (int j = 0; j < 4; ++j) ss += xq[i][j] * xq[i][j];
      ss = wave_sum(ss);
      const float rs = rsqrtf(ss * (1.f / 1024.f) + EPSV);
      u16* H = (u16*)(p.ws + OFF_H) + (size_t)r * 1024;
#pragma unroll
      for (int i = 0; i < 4; ++i) {
        float h0 = xq[i][0] * rs * hq[i][0] * (1.f + s1q[i][0]) + s0q[i][0];
        float h1 = xq[i][1] * rs * hq[i][1] * (1.f + s1q[i][1]) + s0q[i][1];
        float h2 = xq[i][2] * rs * hq[i][2] * (1.f + s1q[i][2]) + s0q[i][2];
        float h3 = xq[i][3] * rs * hq[i][3] * (1.f + s1q[i][3]) + s0q[i][3];
        *(u32x2*)(H + i * 256 + lane * 4) = u32x2{pack2(h0, h1), pack2(h2, h3)};
      }
    }
  }
}

DEV void gemm1_item(const P& p, int mt, int nt, char* smem) {
  f32x16 acc[2][2]; zero_acc<2>(acc);
  gemm_main<2>((const u16*)(p.ws + OFF_H) + (size_t)mt * 128 * 1024, 1024, (const u16*)(p.ws + OFF_WT + WT_IN) + (size_t)nt * 128 * 1024, 1024, 1024, acc, smem);
  const int tid0 = ltid(); const int lane = tid0 & 63, w = tid0 >> 6, wr = w >> 1, wc = w & 1, r31 = lane & 31, hh = lane >> 5;
  u16* PS = (u16*)(p.ws + OFF_R1 + R1_PS);
#pragma unroll
  for (int mi = 0; mi < 2; ++mi)
#pragma unroll
    for (int ni = 0; ni < 2; ++ni)
#pragma unroll
      for (int i = 0; i < 16; ++i) {
        int row = mt * 128 + wr * 64 + mi * 32 + rowmap16(i, lane), col = nt * 128 + wc * 64 + ni * 32 + colmap16(i, lane);
        PS[(size_t)row * PSW + col] = f2bf(acc[mi][ni][i]);
      }
}

template <int NI>
DEV void merge_item(const P& p, int mt, int nt, char* smem) {
  f32x16 z[2][NI]; zero_acc<NI>(z);
  const u16* H = (const u16*)(p.ws + OFF_H) + (size_t)mt * 128 * 1024;
  const u16* BR = (const u16*)(p.ws + OFF_R2 + R2_BR) + (size_t)mt * 128 * 1024;
  const u16* WinT = (const u16*)(p.ws + OFF_WT + WT_IN);
  const u16* WbrT = (const u16*)(p.ws + OFF_WT + WT_BR);
#pragma unroll 1
  for (int g = 0; g < 4; ++g) {
    unsigned yp[2][NI][8];
    {
      f32x16 ay[2][NI]; zero_acc<NI>(ay);
      gemm_main<NI>(BR + g * 256, 1024, WbrT + (size_t)(g * 1024 + nt * NI * 64) * 256, 256, 256, ay, smem);
#pragma unroll
      for (int mi = 0; mi < 2; ++mi)
#pragma unroll
        for (int ni = 0; ni < NI; ++ni)
#pragma unroll
          for (int j = 0; j < 8; ++j) yp[mi][ni][j] = pack2(ay[mi][ni][2 * j], ay[mi][ni][2 * j + 1]);
      __builtin_amdgcn_sched_barrier(0);
    }
    f32x16 ag[2][NI]; zero_acc<NI>(ag);
    gemm_main<NI>(H, 1024, WinT + (size_t)(2688 + g * 1024 + nt * NI * 64) * 1024, 1024, 1024, ag, smem);
#pragma unroll
    for (int mi = 0; mi < 2; ++mi)
#pragma unroll
      for (int ni = 0; ni < NI; ++ni)
#pragma unroll
        for (int j = 0; j < 8; ++j) {
          const unsigned y2 = yp[mi][ni][j];
          z[mi][ni][2 * j] += sigmoidf_(ag[mi][ni][2 * j]) * bflo(y2);
          z[mi][ni][2 * j + 1] += sigmoidf_(ag[mi][ni][2 * j + 1]) * bfhi(y2);
        }
  }
  const int tid0 = ltid(); const int lane = tid0 & 63, w = tid0 >> 6, wr = w >> 1, wc = w & 1, r31 = lane & 31, hh = lane >> 5;
  u16* Z = (u16*)(p.ws + OFF_R2 + R2_Z);
#pragma unroll
  for (int mi = 0; mi < 2; ++mi)
#pragma unroll
    for (int ni = 0; ni < NI; ++ni)
#pragma unroll
      for (int i = 0; i < 16; ++i) {
        int row = mt * 128 + wr * 64 + mi * 32 + rowmap16(i, lane), col = nt * NI * 64 + wc * NI * 32 + ni * 32 + colmap16(i, lane);
        Z[(size_t)row * 1024 + col] = f2bf(z[mi][ni][i]);
      }
}

DEV void gemm_f32_big(const u16* A, int K, const u16* Bt, float* O, int mt, int nt, char* smem) {
  f32x16 acc[2][2]; zero_acc<2>(acc);
  gemm_main<2>(A + (size_t)mt * 128 * K, K, Bt + (size_t)nt * 128 * K, K, K, acc, smem);
  const int tid0 = ltid(); const int lane = tid0 & 63, w = tid0 >> 6, wr = w >> 1, wc = w & 1, r31 = lane & 31, hh = lane >> 5;
#pragma unroll
  for (int mi = 0; mi < 2; ++mi)
#pragma unroll
    for (int ni = 0; ni < 2; ++ni)
#pragma unroll
      for (int i = 0; i < 16; ++i) {
        int row = mt * 128 + wr * 64 + mi * 32 + rowmap16(i, lane), col = nt * 128 + wc * 64 + ni * 32 + colmap16(i, lane);
        O[(size_t)row * 1024 + col] = acc[mi][ni][i];
      }
}
DEV void gemm_f32_small(const u16* A, int K, const u16* Bt, float* O, int item, char* smem) {
  const int mt = item >> 4, nt = item & 15;
  f32x16 acc[2][1]; zero_acc<1>(acc);
  gemm_main<1>(A + (size_t)(16384 + mt * 128) * K, K, Bt + (size_t)nt * 64 * K, K, K, acc, smem);
  const int tid0 = ltid(); const int lane = tid0 & 63, w = tid0 >> 6, wr = w >> 1, wc = w & 1, r31 = lane & 31, hh = lane >> 5;
#pragma unroll
  for (int mi = 0; mi < 2; ++mi)
#pragma unroll
    for (int i = 0; i < 16; ++i) {
      int row = 16384 + mt * 128 + wr * 64 + mi * 32 + rowmap16(i, lane), col = nt * 64 + wc * 32 + colmap16(i, lane);
      O[(size_t)row * 1024 + col] = acc[mi][0][i];
    }
}

DEV void seq_bounds(int r, int& s0, int& s1) {
  if (r < 16384) { s0 = r & ~8191; s1 = s0 + 8192; } else { s0 = 16384 + ((r - 16384) & ~255); s1 = s0 + 256; }
}

DEV void upact_item(const P& p, int l, int mt, int nt, char* smem) {
  const int tid = ltid();
  const int srow = mt * 254 - 1;
  const u16* H = (const u16*)(p.ws + OFF_H);
  const u16* W = (const u16*)(p.ws + OFF_WT + WT_UP);
  const u16* Ap[4];
#pragma unroll
  for (int i = 0; i < 4; ++i) {
    int gr = srow + (tid >> 2) + 64 * i;
    gr = gr < 0 ? 0 : (gr > NROW - 1 ? NROW - 1 : gr);
    Ap[i] = H + (size_t)gr * 1024 + ((tid & 3) ^ ((0x78 >> (((tid >> 4) & 3) * 2)) & 3)) * 8;
  }
  const int co = ((tid & 3) ^ ((0x78 >> (((tid >> 4) & 3) * 2)) & 3)) * 8;
  const u16* const Bp[2] = {W + (size_t)(nt * 64 + (tid >> 2)) * 1024 + co, W + (size_t)(2816 + nt * 64 + (tid >> 2)) * 1024 + co};
  f32x16 acc[4][2]; zero_big(acc);
  {
    const u16* const Ap2[4] = {Ap[0], Ap[1], Ap[2], Ap[3]};
    gemm_big_p(Ap2, Bp, 1024, acc, smem);
  }
  const int lane = tid & 63, w = tid >> 6, wr = w >> 1, wc = w & 1, r31 = lane & 31, hh = lane >> 5;
  u16* sU = (u16*)smem;
#pragma unroll
  for (int mi = 0; mi < 4; ++mi)
#pragma unroll
    for (int ni = 0; ni < 2; ++ni)
#pragma unroll
      for (int i = 0; i < 16; ++i) sU[(wr * 128 + mi * 32 + rowmap16(i, lane)) * 136 + wc * 64 + ni * 32 + colmap16(i, lane)] = f2bf(acc[mi][ni][i]);
  __syncthreads();
  const int cg_ = tid & 7, col = nt * 64 + cg_ * 8;
  const float* cw = p.ffn_conv_w + (size_t)l * 3 * 2816 + col;
  const float* cb = p.ffn_conv_b + (size_t)l * 2816 + col;
  float w0[8], w1[8], w2[8], bb[8];
#pragma unroll
  for (int q = 0; q < 2; ++q) {
    f32x4 t0 = *(const f32x4*)(cw + q * 4), t1 = *(const f32x4*)(cw + 2816 + q * 4), t2 = *(const f32x4*)(cw + 5632 + q * 4), t3 = *(const f32x4*)(cb + q * 4);
#pragma unroll
    for (int e = 0; e < 4; ++e) { w0[q * 4 + e] = t0[e]; w1[q * 4 + e] = t1[e]; w2[q * 4 + e] = t2[e]; bb[q * 4 + e] = t3[e]; }
  }
  u16* ACT = (u16*)(p.ws + OFF_R2);
  for (int k = 0; k < 8; ++k) {
    const int idx = tid + k * 256, rr = 1 + (idx >> 3);
    const int R = srow + rr;
    if (rr <= 254 && R < NROW) {
      int s0, s1; seq_bounds(R, s0, s1);
      const u32x4 z4 = {0, 0, 0, 0};
      const u32x4 am = (R - 1 >= s0) ? *(const u32x4*)(sU + (rr - 1) * 136 + cg_ * 8) : z4;
      const u32x4 a0 = *(const u32x4*)(sU + rr * 136 + cg_ * 8);
      const u32x4 ap = (R + 1 < s1) ? *(const u32x4*)(sU + (rr + 1) * 136 + cg_ * 8) : z4;
      const u32x4 gg = *(const u32x4*)(sU + rr * 136 + 64 + cg_ * 8);
      float o[8];
#pragma unroll
      for (int j = 0; j < 4; ++j) {
        float v0 = w0[2 * j] * bflo(am[j]) + w1[2 * j] * bflo(a0[j]) + w2[2 * j] * bflo(ap[j]) + bb[2 * j];
        float v1 = w0[2 * j + 1] * bfhi(am[j]) + w1[2 * j + 1] * bfhi(a0[j]) + w2[2 * j + 1] * bfhi(ap[j]) + bb[2 * j + 1];
        o[2 * j] = siluf_(v0) * bflo(gg[j]);
        o[2 * j + 1] = siluf_(v1) * bfhi(gg[j]);
      }
      *(u32x4*)(ACT + (size_t)R * 2816 + col) = u32x4{pack2(o[0], o[1]), pack2(o[2], o[3]), pack2(o[4], o[5]), pack2(o[6], o[7])};
    }
  }
  __syncthreads();
}

DEV void attnprep_item(const P& p, int tl, char* smem) {
  const int tid = ltid();
  const u16* PS = (const u16*)(p.ws + OFF_R1 + R1_PS);
  u16* QR = (u16*)(p.ws + OFF_R1 + R1_QR);
  u16* KR = (u16*)(p.ws + OFF_R1 + R1_KR);
  u16* VT = (u16*)(p.ws + OFF_R1 + R1_VT);
  const float* RT = (const float*)(p.ws + OFF_RT);
  const int r0 = tl * 128;
  const bool lat = r0 < 16384;
  const int b = lat ? (r0 >> 13) : ((r0 - 16384) >> 8);
  const int pos0 = lat ? (r0 & 8191) : 8192 + ((r0 - 16384) & 255);
  const float QS = 0.17677669529663687f * 1.4426950408889634f;
  unsigned* sKm = (unsigned*)(smem + 70656);
  if (tid < 8) sKm[tid] = 0u;
  __syncthreads();
  for (int it = 0; it < 4; ++it) {
    int task = tid + it * 256, tok = task >> 3, hc = task & 7, h = hc >> 1, c = hc & 1;
    int r = r0 + tok, pos = pos0 + tok;
    int rowi = (pos >> 6) & 127, coli = pos & 63;
    for (int qk = 0; qk < 2; ++qk) {
      const u16* src = PS + (size_t)r * PSW + (qk ? 1280 : 1024) + h * 64 + c * 32;
      float v[32];
#pragma unroll
      for (int j = 0; j < 4; ++j) {
        u32x4 u = *(const u32x4*)(src + j * 8);
#pragma unroll
        for (int e = 0; e < 4; ++e) { v[j * 8 + 2 * e] = bflo(u[e]); v[j * 8 + 2 * e + 1] = bfhi(u[e]); }
      }
      float o[32];
      if (lat) {
#pragma unroll
        for (int a = 0; a < 2; ++a) {
          int pa = a == 0 ? rowi : coli;
          const f32x4* rp = (const f32x4*)(RT + pa * 16);
          const f32x4 rt[4] = {rp[0], rp[1], rp[2], rp[3]};
#pragma unroll
          for (int i = 0; i < 8; ++i) {
            float cs = rt[i >> 1][(i & 1) * 2], sn = rt[i >> 1][(i & 1) * 2 + 1];
            float x1 = v[a * 16 + i], x2 = v[a * 16 + 8 + i];
            o[a * 16 + i] = x1 * cs - x2 * sn;
            o[a * 16 + 8 + i] = x2 * cs + x1 * sn;
          }
        }
      } else {
#pragma unroll
        for (int i = 0; i < 32; ++i) o[i] = v[i];
      }
      const float sc = qk ? 1.f : QS;
      if (qk) {
        float ssk = 0.f;
#pragma unroll
        for (int i = 0; i < 32; ++i) { float t = bf2f(f2bf(o[i])); ssk += t * t; }
        ssk = fmaxf(ssk, __shfl_xor(ssk, 8)); ssk = fmaxf(ssk, __shfl_xor(ssk, 16)); ssk = fmaxf(ssk, __shfl_xor(ssk, 32));
        if ((tid & 63) < 8) atomicMax(&sKm[hc], __float_as_uint(ssk));
      }
      u16* dst = (qk ? KR : QR) + ((size_t)((b * 4 + h) * 2 + c) * KPOS + pos) * 32;
#pragma unroll
      for (int j = 0; j < 4; ++j)
        *(u32x4*)(dst + j * 8) = u32x4{pack2(o[j * 8] * sc, o[j * 8 + 1] * sc), pack2(o[j * 8 + 2] * sc, o[j * 8 + 3] * sc),
                                       pack2(o[j * 8 + 4] * sc, o[j * 8 + 5] * sc), pack2(o[j * 8 + 6] * sc, o[j * 8 + 7] * sc)};
    }
  }
  u16* sV = (u16*)smem;
  for (int it = 0; it < 16; ++it) {
    int ch = tid + it * 256, tok = ch & 127, cc = ch >> 7;
    u32x4 u = *(const u32x4*)(PS + (size_t)(r0 + tok) * PSW + 1536 + cc * 8);
    const int tokp = (tok & ~12) | ((tok & 4) << 1) | ((tok & 8) >> 1);
#pragma unroll
    for (int e = 0; e < 4; ++e) {
      sV[(cc * 8 + 2 * e) * 136 + tokp] = (u16)(u[e] & 0xffff);
      sV[(cc * 8 + 2 * e + 1) * 136 + tokp] = (u16)(u[e] >> 16);
    }
  }
  __syncthreads();
  if (tid < 8) atomicMax((unsigned*)(p.ws + OFF_KMAX) + (b * 4 + (tid >> 1)) * 2 + (tid & 1), sKm[tid]);
  {
    int hv = tid;
    u16* dst = VT + ((size_t)(b * 4) * 64 + hv) * KPOS + pos0;
#pragma unroll
    for (int j = 0; j < 16; ++j) *(u32x4*)(dst + j * 8) = *(const u32x4*)(sV + hv * 136 + j * 8);
  }
  __syncthreads();
}

DEV void ml_gates(const P& p, int l, int h, int r0, float* sG) {
  const int tid = ltid(), lane = tid & 63, w = tid >> 6;
  const u16* PS = (const u16*)(p.ws + OFF_R1 + R1_PS);
  {
    int t = tid & 127, d = tid >> 7;
    const u16* g = PS + (size_t)(r0 + t) * PSW + 2560 + d * 8;
    float ig = bf2f(g[h]) + p.ml_gate_b[((l * 2 + d) * 2 + 0) * 4 + h];
    float fg = bf2f(g[4 + h]) + p.ml_gate_b[((l * 2 + d) * 2 + 1) * 4 + h];
    float lf = fminf(fg, 0.f) - __logf(1.f + __expf(-fabsf(fg)));
    sG[d * 128 + t] = ig;
    sG[(4 + d) * 128 + t] = lf;
  }
  __syncthreads();
  if (w == 0) {
    float a = sG[4 * 128 + 2 * lane], b2 = sG[4 * 128 + 2 * lane + 1];
    float s = a + b2, incl = s;
#pragma unroll
    for (int off = 1; off < 64; off <<= 1) { float t = __shfl_up(incl, off); if (lane >= off) incl += t; }
    float excl = incl - s;
    sG[2 * 128 + 2 * lane] = excl + a;
    sG[2 * 128 + 2 * lane + 1] = excl + a + b2;
  } else if (w == 1) {
    float a = sG[5 * 128 + 2 * lane], b2 = sG[5 * 128 + 2 * lane + 1];
    float s = a + b2, incl = s;
#pragma unroll
    for (int off = 1; off < 64; off <<= 1) { float t = __shfl_down(incl, off); if (lane + off < 64) incl += t; }
    float excl = incl - s;
    sG[3 * 128 + 2 * lane + 1] = excl + b2;
    sG[3 * 128 + 2 * lane] = excl + b2 + a;
  }
  __syncthreads();
}

DEV void ml_conv8(const P& p, int l, const u16* PS, int r, int s0, int s1, int col, float scale, float* o) {
  u32x4 z4 = {0, 0, 0, 0};
  u32x4 am = (r - 1 >= s0) ? *(const u32x4*)(PS + (size_t)(r - 1) * PSW + col) : z4;
  u32x4 a0 = *(const u32x4*)(PS + (size_t)r * PSW + col);
  u32x4 ap = (r + 1 < s1) ? *(const u32x4*)(PS + (size_t)(r + 1) * PSW + col) : z4;
  const float* cw = p.ml_conv_w + (size_t)l * 3 * 512 + col;
  const float* cb = p.ml_conv_b + (size_t)l * 512 + col;
  f32x4 w0[2], w1[2], w2[2], bb[2];
#pragma unroll
  for (int q = 0; q < 2; ++q) {
    w0[q] = *(const f32x4*)(cw + q * 4); w1[q] = *(const f32x4*)(cw + 512 + q * 4); w2[q] = *(const f32x4*)(cw + 1024 + q * 4);
    bb[q] = *(const f32x4*)(cb + q * 4);
  }
#pragma unroll
  for (int j = 0; j < 4; ++j) {
    const int q = j >> 1, e = (j & 1) * 2;
    float v0 = w0[q][e] * bflo(am[j]) + w1[q][e] * bflo(a0[j]) + w2[q][e] * bflo(ap[j]) + bb[q][e];
    float v1 = w0[q][e + 1] * bfhi(am[j]) + w1[q][e + 1] * bfhi(a0[j]) + w2[q][e + 1] * bfhi(ap[j]) + bb[q][e + 1];
    o[2 * j] = siluf_(v0) * scale;
    o[2 * j + 1] = siluf_(v1) * scale;
  }
}

DEV void ml_decode(int item, int& b, int& h, int& cidx, int& r0) {
  if (item < 512) { b = item >> 8; h = (item >> 6) & 3; cidx = item & 63; }
  else { int q = item - 512; b = q >> 3; h = (q >> 1) & 3; cidx = 64 + (q & 1); }
  r0 = cidx < 64 ? b * 8192 + cidx * 128 : 16384 + b * 256 + (cidx - 64) * 128;
}

DEV void mla_item(const P& p, int l, int item, char* smem) {
  const int tid = ltid(), lane = tid & 63, w = tid >> 6, r31 = lane & 31, hh = lane >> 5;
  int b, h, cidx, r0; ml_decode(item, b, h, cidx, r0);
  int s0, s1; seq_bounds(r0, s0, s1);
  const u16* PS = (const u16*)(p.ws + OFF_R1 + R1_PS);
  float* sG = (float*)smem;
  float* sRed = (float*)(smem + 4096);
  u16* sB = (u16*)(smem + 5120);
  u16* sA0 = sB + 64 * 136;
  u16* sA1 = sA0 + 64 * 136;
  ml_gates(p, l, h, r0, sG);
  {
    int d = tid >> 7, s = tid & 127;
    float wd = d == 0 ? __expf(sG[2 * 128 + 127] - sG[2 * 128 + s] + sG[s]) : __expf(sG[3 * 128] - sG[3 * 128 + s] + sG[128 + s]);
    sG[(6 + d) * 128 + s] = wd;
  }
  __syncthreads();
  {
    int s = tid & 127, cgh = tid >> 7;
    float w0 = sG[6 * 128 + s], w1 = sG[7 * 128 + s];
    for (int i = 0; i < 4; ++i) {
      int cg_ = cgh * 4 + i;
      float o[8];
      ml_conv8(p, l, PS, r0 + s, s0, s1, 256 + h * 64 + cg_ * 8, 1.f, o);
#pragma unroll
      for (int j = 0; j < 8; ++j) sB[(cg_ * 8 + j) * 136 + s] = f2bf(o[j]);
      u32x4 u = *(const u32x4*)(PS + (size_t)(r0 + s) * PSW + 512 + h * 64 + cg_ * 8);
#pragma unroll
      for (int e = 0; e < 4; ++e) {
        float v0 = bflo(u[e]), v1 = bfhi(u[e]);
        sA0[(cg_ * 8 + 2 * e) * 136 + s] = f2bf(w0 * v0);
        sA0[(cg_ * 8 + 2 * e + 1) * 136 + s] = f2bf(w0 * v1);
        sA1[(cg_ * 8 + 2 * e) * 136 + s] = f2bf(w1 * v0);
        sA1[(cg_ * 8 + 2 * e + 1) * 136 + s] = f2bf(w1 * v1);
      }
    }
  }
  __syncthreads();
  const int d = w >> 1, ni = w & 1;
  f32x16 acc[2][1];
#pragma unroll
  for (int mi = 0; mi < 2; ++mi)
#pragma unroll
    for (int i = 0; i < 16; ++i) acc[mi][0][i] = 0.f;
  mma_lds<2, 1>(d ? sA1 : sA0, 136, 0, sB, 136, ni * 32, 128, acc, lane);
  float* DC = (float*)(p.ws + OFF_R1 + R1_DC);
  {
    float* dst = DC + ((size_t)(((b * 4 + h) * 2 + d) * 66 + cidx)) * 4160;
#pragma unroll
    for (int mi = 0; mi < 2; ++mi)
#pragma unroll
      for (int i = 0; i < 16; ++i) dst[(mi * 32 + rowmap(i, hh)) * 64 + ni * 32 + r31] = acc[mi][0][i];
    if (cidx >= 64) {
      u16* CPb = (u16*)(p.ws + OFF_R1 + R1_CP) + (size_t)(((b * 4 + h) * 2 + d) * 66) * 4160;
      if ((d == 0) == (cidx == 64)) {
#pragma unroll
        for (int mi = 0; mi < 2; ++mi)
#pragma unroll
          for (int i = 0; i < 16; ++i) {
            const int e_ = (mi * 32 + rowmap(i, hh)) * 64 + ni * 32 + r31;
            CPb[(size_t)(cidx ^ 1) * 4160 + e_] = f2bf(acc[mi][0][i]);
            CPb[(size_t)cidx * 4160 + e_] = (u16)0;
          }
      }
    }
  }
  {
    int k = tid & 63, dd = (tid >> 6) & 1, half = tid >> 7;
    float s = 0;
    for (int j = half * 64; j < half * 64 + 64; ++j) s += sG[(6 + dd) * 128 + j] * bf2f(sB[k * 136 + j]);
    sRed[tid] = s;
  }
  __syncthreads();
  if (tid < 128) {
    int k = tid & 63, dd = tid >> 6;
    DC[((size_t)(((b * 4 + h) * 2 + dd) * 66 + cidx)) * 4160 + 64 * 64 + k] = sRed[tid] + sRed[tid + 128];
    if (cidx >= 64) {
      u16* CPb = (u16*)(p.ws + OFF_R1 + R1_CP) + (size_t)(((b * 4 + h) * 2 + dd) * 66) * 4160;
      if ((dd == 0) == (cidx == 64)) {
        CPb[(size_t)(cidx ^ 1) * 4160 + 64 * 64 + k] = f2bf(sRed[tid] + sRed[tid + 128]);
        CPb[(size_t)cidx * 4160 + 64 * 64 + k] = (u16)0;
      }
    }
  }
  if (tid == 0) {
    float* DEC = (float*)(p.ws + OFF_R1 + R1_DEC);
    DEC[((b * 4 + h) * 2 + 0) * 66 + cidx] = expf(sG[2 * 128 + 127]);
    DEC[((b * 4 + h) * 2 + 1) * 66 + cidx] = expf(sG[3 * 128]);
  }
  __syncthreads();
}

DEV void scan_item(const P& p, int item) {
  const int seq = item >> 2, quarter = item & 3, d = seq & 1;
  const float* DC = (const float*)(p.ws + OFF_R1 + R1_DC) + (size_t)seq * 66 * 4160;
  const float* DEC = (const float*)(p.ws + OFF_R1 + R1_DEC) + seq * 66;
  u16* CP = (u16*)(p.ws + OFF_R1 + R1_CP) + (size_t)seq * 66 * 4160;
  float st[5];
  int e[5];
  const int tid0 = ltid();
#pragma unroll
  for (int i = 0; i < 5; ++i) { st[i] = 0.f; int q = tid0 + i * 256; e[i] = q < 1040 ? quarter * 1040 + q : quarter * 1040; }
  const bool last_ok = tid0 + 4 * 256 < 1040;
  for (int s0 = 0; s0 < 66; s0 += 6) {
    float dc[6][5], dec[6];
    int cx[6];
#pragma unroll
    for (int u = 0; u < 6; ++u) {
      int step = s0 + u;
      cx[u] = d == 0 ? (step < 2 ? 64 + step : step - 2) : (step < 2 ? 65 - step : 63 - (step - 2));
      dec[u] = DEC[cx[u]];
#pragma unroll
      for (int i = 0; i < 5; ++i) dc[u][i] = DC[(size_t)cx[u] * 4160 + e[i]];
    }
#pragma unroll
    for (int u = 0; u < 6; ++u) {
#pragma unroll
      for (int i = 0; i < 5; ++i) {
        if ((i < 4 || last_ok) && s0 + u >= 2) CP[(size_t)cx[u] * 4160 + e[i]] = f2bf(st[i]);
        st[i] = dec[u] * st[i] + dc[u][i];
      }
    }
  }
}

DEV void mlc_item(const P& p, int l, int item, char* smem) {
  const int tid = ltid(), lane = tid & 63, w = tid >> 6, r31 = lane & 31, hh = lane >> 5;
  int b, h, cidx, r0; ml_decode(item, b, h, cidx, r0);
  int s0, s1; seq_bounds(r0, s0, s1);
  const u16* PS = (const u16*)(p.ws + OFF_R1 + R1_PS);
  float* sG = (float*)smem;
  float* sN = (float*)(smem + 4096);
  u16* sK = (u16*)(smem + 4608);
  u16* sQ = sK + 128 * 72;
  u16* sC = sQ;
  u16* sVT = sQ + 128 * 72;
  ml_gates(p, l, h, r0, sG);
  {
    int d = tid >> 7, s = tid & 127;
    sG[(6 + d) * 128 + s] = sG[d * 128 + s] - sG[(2 + d) * 128 + s];
  }
  {
    for (int i = 0; i < 4; ++i) {
      int ch = tid + i * 256, s = ch >> 3, cg_ = ch & 7;
      float o[8];
      ml_conv8(p, l, PS, r0 + s, s0, s1, 256 + h * 64 + cg_ * 8, 1.f, o);
      *(u32x4*)(sK + s * 72 + cg_ * 8) = u32x4{pack2(o[0], o[1]), pack2(o[2], o[3]), pack2(o[4], o[5]), pack2(o[6], o[7])};
      ml_conv8(p, l, PS, r0 + s, s0, s1, h * 64 + cg_ * 8, 0.125f, o);
      *(u32x4*)(sQ + s * 72 + cg_ * 8) = u32x4{pack2(o[0], o[1]), pack2(o[2], o[3]), pack2(o[4], o[5]), pack2(o[6], o[7])};
    }
    int s = tid & 127, cgh = tid >> 7;
    for (int i = 0; i < 4; ++i) {
      int cg_ = cgh * 4 + i;
      u32x4 u = *(const u32x4*)(PS + (size_t)(r0 + s) * PSW + 512 + h * 64 + cg_ * 8);
#pragma unroll
      for (int e = 0; e < 4; ++e) {
        sVT[(cg_ * 8 + 2 * e) * 136 + s] = (u16)(u[e] & 0xffff);
        sVT[(cg_ * 8 + 2 * e + 1) * 136 + s] = (u16)(u[e] >> 16);
      }
    }
  }
  __syncthreads();
  bf16x8 qf[4];
#pragma unroll
  for (int ks = 0; ks < 4; ++ks) qf[ks] = *(const bf16x8*)(sQ + (w * 32 + r31) * 72 + ks * 16 + hh * 8);
  __syncthreads();
  {
    const u16* CP = (const u16*)(p.ws + OFF_R1 + R1_CP);
    for (int d = 0; d < 2; ++d) {
      const u16* src = CP + ((size_t)(((b * 4 + h) * 2 + d) * 66 + cidx)) * 4160;
      for (int ch = tid; ch < 64 * 8; ch += 256) {
        int rr = ch >> 3, cc = ch & 7;
        *(u32x4*)(sC + (d * 64 + rr) * 72 + cc * 8) = *(const u32x4*)(src + rr * 64 + cc * 8);
      }
      if (tid < 64) sN[d * 64 + tid] = bf2f(src[64 * 64 + tid]);
    }
  }
  __syncthreads();
  const int qloc = w * 32 + r31;
  f32x16 Hs[2];
#pragma unroll
  for (int vt = 0; vt < 2; ++vt)
#pragma unroll
    for (int i = 0; i < 16; ++i) Hs[vt][i] = 0.f;
#pragma unroll 1
  for (int d = 0; d < 2; ++d) {
    f32x16 R[2];
#pragma unroll
    for (int vt = 0; vt < 2; ++vt) {
#pragma unroll
      for (int i = 0; i < 16; ++i) R[vt][i] = 0.f;
#pragma unroll
      for (int ks = 0; ks < 4; ++ks) {
        bf16x8 a = *(const bf16x8*)(sC + (d * 64 + vt * 32 + r31) * 72 + ks * 16 + hh * 8);
        R[vt] = mfma(a, qf[ks], R[vt]);
      }
    }
    float nq = 0.f;
#pragma unroll
    for (int ks = 0; ks < 4; ++ks)
#pragma unroll
      for (int j = 0; j < 8; ++j) nq += sN[d * 64 + ks * 16 + hh * 8 + j] * bf2f((u16)qf[ks][j]);
    nq = xsum32(nq);
    const float Bq = sG[(2 + d) * 128 + qloc];
    const float eb = __expf(Bq);
    const int sgn = d == 0 ? 1 : -1;
#pragma unroll
    for (int vt = 0; vt < 2; ++vt)
#pragma unroll
      for (int i = 0; i < 16; ++i) R[vt][i] *= eb;
    float den = 0.f;
#pragma unroll 1
    for (int kt = 0; kt < 4; ++kt) {
      f32x16 X;
#pragma unroll
      for (int i = 0; i < 16; ++i) X[i] = 0.f;
#pragma unroll
      for (int ks = 0; ks < 4; ++ks) {
        bf16x8 a = *(const bf16x8*)(sK + (kt * 32 + r31) * 72 + ks * 16 + hh * 8);
        X = mfma(a, qf[ks], X);
      }
      float pv[16];
#pragma unroll
      for (int i = 0; i < 16; ++i) {
        int key = kt * 32 + rowmap(i, hh);
        int tdiff = sgn * (qloc - key);
        float wgt = __expf(Bq + sG[(6 + d) * 128 + key] + (float)min(tdiff, 0) * 1e30f);
        pv[i] = X[i] * wgt;
        den += pv[i];
      }
#pragma unroll
      for (int s = 0; s < 2; ++s) {
        u32x4 pu = {pack2(pv[8 * s], pv[8 * s + 1]), pack2(pv[8 * s + 2], pv[8 * s + 3]), pack2(pv[8 * s + 4], pv[8 * s + 5]), pack2(pv[8 * s + 6], pv[8 * s + 7])};
        bf16x8 pf = __builtin_bit_cast(bf16x8, pu);
        const int ks2 = kt * 2 + s;
#pragma unroll
        for (int vt = 0; vt < 2; ++vt) {
          const u16* vp = sVT + (vt * 32 + r31) * 136 + 16 * ks2 + 4 * hh;
          u32x2 lo = *(const u32x2*)vp, hi = *(const u32x2*)(vp + 8);
          u32x4 au = {lo[0], lo[1], hi[0], hi[1]};
          R[vt] = mfma(__builtin_bit_cast(bf16x8, au), pf, R[vt]);
        }
      }
    }
    den = xsum32(den);
    den += eb * nq;
    float inv = 1.f / fmaxf(fabsf(den), 1.f);
#pragma unroll
    for (int vt = 0; vt < 2; ++vt)
#pragma unroll
      for (int i = 0; i < 16; ++i) Hs[vt][i] += R[vt][i] * inv;
  }
  float ss = 0;
#pragma unroll
  for (int vt = 0; vt < 2; ++vt)
#pragma unroll
    for (int i = 0; i < 16; ++i) ss += Hs[vt][i] * Hs[vt][i];
  ss = xsum32(ss);
  const float rs = rsqrtf(ss * (1.f / 64.f) + EPSV);
  u16* BR = (u16*)(p.ws + OFF_R2 + R2_BR);
  const int row = r0 + qloc;
#pragma unroll
  for (int vt = 0; vt < 2; ++vt)
#pragma unroll
    for (int i = 0; i < 16; ++i) {
      int v = vt * 32 + rowmap(i, hh);
      float o = bf2f(PS[(size_t)row * PSW + 768 + h * 64 + v]);
      float val = Hs[vt][i] * rs * p.ml_norm[l * 256 + h * 64 + v] * sigmoidf_(o);
      BR[(size_t)row * 1024 + h * 64 + v] = f2bf(val);
    }
  __syncthreads();
}

DEV void attn_item(const P& p, int l, int item, char* smem, float lam, float lam_init) {
  const int tid = ltid(), lane = tid & 63, w = tid >> 6, r31 = lane & 31, hh = lane >> 5;
  const int c = w & 1, qs = w >> 1;
  int b, h, q0, key0, ntile;
  if (item < 1024) { b = item >> 9; h = (item >> 7) & 3; q0 = (item & 127) * 64; key0 = 0; ntile = 132; }
  else { int q = item - 1024; b = q >> 4; h = (q >> 2) & 3; q0 = 8192 + (q & 3) * 64; key0 = 8192; ntile = 4; }
  const int bh = b * 4 + h;
  const u16* QR = (const u16*)(p.ws + OFF_R1 + R1_QR);
  const u16* KR = (const u16*)(p.ws + OFF_R1 + R1_KR);
  const u16* VT = (const u16*)(p.ws + OFF_R1 + R1_VT);
  bf16x8 qf[2];
  {
    const u16* qb = QR + ((size_t)(bh * 2 + c) * KPOS + q0 + qs * 32 + r31) * 32;
    qf[0] = *(const bf16x8*)(qb + hh * 8);
    qf[1] = *(const bf16x8*)(qb + 16 + hh * 8);
  }
  constexpr int KB = 16384, STG = 32768;
  const unsigned lbase = (unsigned)(size_t)smem + tid * 16;
  const u16* kp0 = KR + ((size_t)(bh * 2) * KPOS + key0 + (tid >> 2)) * 32 + ((tid & 3) ^ ((tid >> 4) & 3)) * 8;
  const u16* vp0 = VT + ((size_t)bh * 64 + (tid >> 4)) * KPOS + key0 + ((tid & 15) ^ ((tid >> 4) & 15)) * 8;
#define AGLDS(kt, stg)                                                                                            \
  {                                                                                                               \
    _Pragma("unroll") for (int i = 0; i < 4; ++i)                                                                 \
      __builtin_amdgcn_global_load_lds((const unsigned*)(kp0 + (size_t)(i >> 1) * KPOS * 32 + (size_t)((i & 1) * 64 + (kt) * 128) * 32), \
                                       (LAS unsigned*)(lbase + (stg) * STG + i * 4096), 16, 0, 0);                \
    _Pragma("unroll") for (int i = 0; i < 4; ++i)                                                                 \
      __builtin_amdgcn_global_load_lds((const unsigned*)(vp0 + (size_t)(i * 16) * KPOS + (kt) * 128),             \
                                       (LAS unsigned*)(lbase + (stg) * STG + KB + i * 4096), 16, 0, 0);           \
  }
  f32x16 O[2], NEGM;
#pragma unroll
  for (int i = 0; i < 16; ++i) { O[0][i] = 0.f; O[1][i] = 0.f; }
  float lsum = 0.f;
  {
    float qq = 0.f;
#pragma unroll
    for (int ks = 0; ks < 2; ++ks)
#pragma unroll
      for (int j = 0; j < 8; ++j) { float t = bf2f((u16)qf[ks][j]); qq += t * t; }
    qq = xsum32(qq);
    const float k2 = __uint_as_float(__hip_atomic_load((unsigned*)(p.ws + OFF_KMAX) + bh * 2 + c, __ATOMIC_RELAXED, __HIP_MEMORY_SCOPE_AGENT));
    const float mref = sqrtf(qq * k2) * 1.001f;
#pragma unroll
    for (int i = 0; i < 16; ++i) NEGM[i] = -mref;
  }
  const int nt2 = ntile >> 1;
  const int swk = (r31 >> 2) & 3, swv = r31 & 15;
  AGLDS(0, 0);
  asm volatile("s_waitcnt vmcnt(0)" ::: "memory");
  __builtin_amdgcn_s_barrier();
  for (int kt = 0; kt < nt2; ++kt) {
    if (kt + 1 < nt2) AGLDS(kt + 1, (kt + 1) & 1);
    __builtin_amdgcn_sched_barrier(0);
    const char* kb = smem + (kt & 1) * STG + c * 8192;
    const char* vb = smem + (kt & 1) * STG + KB;
    f32x16 X[4];
#pragma unroll
    for (int k2 = 0; k2 < 4; ++k2) {
      const char* kp_ = kb + (k2 * 32 + r31) * 64;
      X[k2] = mfma(*(const bf16x8*)(kp_ + ((hh) ^ swk) * 16), qf[0], NEGM);
      X[k2] = mfma(*(const bf16x8*)(kp_ + ((2 + hh) ^ swk) * 16), qf[1], X[k2]);
    }
    float ps = 0.f;
#pragma unroll
    for (int k2 = 0; k2 < 4; ++k2)
#pragma unroll
      for (int i = 0; i < 16; ++i) { float e = __builtin_amdgcn_exp2f(X[k2][i]); X[k2][i] = e; ps += e; }
    lsum += ps;
#pragma unroll
    for (int ks2 = 0; ks2 < 8; ++ks2) {
      const int k2 = ks2 >> 1, s_ = ks2 & 1;
      u32x4 pu = {pack2(X[k2][8 * s_], X[k2][8 * s_ + 1]), pack2(X[k2][8 * s_ + 2], X[k2][8 * s_ + 3]),
                  pack2(X[k2][8 * s_ + 4], X[k2][8 * s_ + 5]), pack2(X[k2][8 * s_ + 6], X[k2][8 * s_ + 7])};
      bf16x8 pf = __builtin_bit_cast(bf16x8, pu);
#pragma unroll
      for (int vt = 0; vt < 2; ++vt) {
        bf16x8 av = *(const bf16x8*)(vb + (vt * 32 + r31) * 256 + ((2 * ks2 + hh) ^ swv) * 16);
        O[vt] = mfma(av, pf, O[vt]);
      }
    }
    __builtin_amdgcn_sched_barrier(0);
    asm volatile("s_waitcnt vmcnt(0)" ::: "memory");
    __builtin_amdgcn_s_barrier();
  }
#undef AGLDS
  const float ltot = xsum32(lsum);
  const float inv = 1.f / ltot;
  float* sX = (float*)smem;
  if (c == 1) {
#pragma unroll
    for (int vt = 0; vt < 2; ++vt)
#pragma unroll
      for (int i = 0; i < 16; ++i) sX[(qs * 32 + vt * 16 + i) * 64 + lane] = O[vt][i] * inv * lam;
  }
  __syncthreads();
  if (c == 0) {
    float ss = 0.f;
#pragma unroll
    for (int vt = 0; vt < 2; ++vt)
#pragma unroll
      for (int i = 0; i < 16; ++i) { float o = O[vt][i] * inv - sX[(qs * 32 + vt * 16 + i) * 64 + lane]; O[vt][i] = o; ss += o * o; }
    ss = xsum32(ss);
    const float rs = rsqrtf(ss * (1.f / 64.f) + EPSV) * (1.f - lam_init);
    const int qpos = q0 + qs * 32 + r31;
    const int row = qpos < 8192 ? b * 8192 + qpos : 16384 + b * 256 + (qpos - 8192);
    u16* BR = (u16*)(p.ws + OFF_R2 + R2_BR);
#pragma unroll
    for (int vt = 0; vt < 2; ++vt)
#pragma unroll
      for (int i = 0; i < 16; ++i) {
        int v = vt * 32 + rowmap(i, hh);
        BR[(size_t)row * 1024 + 256 + h * 64 + v] = f2bf(O[vt][i] * rs * p.da_subln[l * 64 + v]);
      }
  }
  __syncthreads();
}

DEV void f2_item(const P& p, int item, char* smem) {
  const int tid = ltid(), lane = tid & 63, w = tid >> 6, r31 = lane & 31, hh = lane >> 5;
  int seq, g, s2, N1, base;
  if (item < 1024) { seq = item >> 9; g = (item >> 7) & 3; s2 = item & 127; N1 = 64; base = seq * 8192; }
  else { int q = item - 1024; seq = 2 + (q >> 9); g = (q >> 7) & 3; s2 = q & 127; N1 = 2; base = 16384 + (seq - 2) * 256; }
  const u16* PS = (const u16*)(p.ws + OFF_R1 + R1_PS);
  u16* sT = (u16*)smem;
  u16* sAB = (u16*)(smem + 9216);
  float* sEx = (float*)(smem + 9216 + 17408);
  for (int i = 0; i < 2; ++i) {
    int ch = tid + i * 256, s1 = ch >> 3, cc = ch & 7;
    u32x4 v = {0, 0, 0, 0};
    if (s1 < N1) v = *(const u32x4*)(PS + (size_t)(base + 128 * s1 + s2) * PSW + 1792 + g * 64 + cc * 8);
    *(u32x4*)(sT + s1 * 72 + cc * 8) = v;
  }
  __syncthreads();
  {
    const int mi = w & 1, nh = w >> 1;
    f32x16 a1[1][2];
#pragma unroll
    for (int ni = 0; ni < 2; ++ni)
#pragma unroll
      for (int i = 0; i < 16; ++i) a1[0][ni][i] = 0.f;
    mma_lds<1, 2>(sT, 72, mi * 32, (const u16*)(p.ws + OFF_TB1), 64, nh * 64, 64, a1, lane);
#pragma unroll
    for (int ni = 0; ni < 2; ++ni)
#pragma unroll
      for (int i = 0; i < 16; ++i) sAB[(ni * 32 + r31) * 136 + nh * 64 + mi * 32 + rowmap(i, hh)] = f2bf(a1[0][ni][i]);
  }
  __syncthreads();
  {
    f32x16 a2[1][2];
#pragma unroll
    for (int ni = 0; ni < 2; ++ni)
#pragma unroll
      for (int i = 0; i < 16; ++i) a2[0][ni][i] = 0.f;
    mma_lds<1, 2>((const u16*)(p.ws + (N1 == 64 ? OFF_TA264 : OFF_TA22)), 128, w * 32, sAB, 136, 0, 128, a2, lane);
#pragma unroll
    for (int ni = 0; ni < 2; ++ni)
#pragma unroll
      for (int i = 0; i < 16; ++i) sEx[(w * 32 + rowmap(i, hh)) * 65 + ni * 32 + r31] = a2[0][ni][i];
  }
  __syncthreads();
  {
    const float* TW = (const float*)(p.ws + OFF_TW);
    u16* XRE = (u16*)(p.ws + OFF_R1 + R1_XRE);
    u16* XIM = (u16*)(p.ws + OFF_R1 + R1_XIM);
    for (int i = 0; i < 16; ++i) {
      int e = tid + i * 256, ka = e >> 6, k2 = e & 63;
      if (ka < N1) {
        float re = sEx[ka * 65 + k2], im = sEx[(64 + ka) * 65 + k2];
        int idx = (ka * s2 * (N1 == 64 ? 1 : 32)) & 8191;
        float cs = TW[2 * idx], sn = TW[2 * idx + 1];
        size_t o = ((size_t)((seq * 4 + g) * 64 + ka) * 128 + s2) * 64 + k2;
        XRE[o] = f2bf(re * cs + im * sn);
        XIM[o] = f2bf(im * cs - re * sn);
      }
    }
  }
  __syncthreads();
}

DEV void f2ctx_item(const P& p, int item, char* smem) {
  const int tid = ltid(), lane = tid & 63, w = tid >> 6, r31 = lane & 31, hh = lane >> 5;
  const int seq = 2 + (item >> 4), g = (item >> 2) & 3, grp = item & 3, base = 16384 + (seq - 2) * 256;
  const u16* PS = (const u16*)(p.ws + OFF_R1 + R1_PS);
  u16* sT = (u16*)smem;
  float* sEx = (float*)(smem + 9216 + 17408);
  for (int i = 0; i < 2; ++i) {
    int ch = tid + i * 256, rr = ch >> 3, cc = ch & 7, s1 = rr >> 5, j = rr & 31;
    *(u32x4*)(sT + rr * 72 + cc * 8) = *(const u32x4*)(PS + (size_t)(base + 128 * s1 + grp * 32 + j) * PSW + 1792 + g * 64 + cc * 8);
  }
  __syncthreads();
  {
    const int mi = w & 1, nh = w >> 1;
    f32x16 a1[1][2];
#pragma unroll
    for (int ni = 0; ni < 2; ++ni)
#pragma unroll
      for (int i = 0; i < 16; ++i) a1[0][ni][i] = 0.f;
    mma_lds<1, 2>(sT, 72, mi * 32, (const u16*)(p.ws + OFF_TB1), 64, nh * 64, 64, a1, lane);
#pragma unroll
    for (int ni = 0; ni < 2; ++ni)
#pragma unroll
      for (int i = 0; i < 16; ++i) sEx[(mi * 32 + rowmap(i, hh)) * 130 + nh * 64 + ni * 32 + r31] = a1[0][ni][i];
  }
  __syncthreads();
  {
    const float* TW = (const float*)(p.ws + OFF_TW);
    u16* XRE = (u16*)(p.ws + OFF_R1 + R1_XRE);
    u16* XIM = (u16*)(p.ws + OFF_R1 + R1_XIM);
    for (int i = 0; i < 16; ++i) {
      int e = tid + i * 256, ka = e >> 11, j = (e >> 6) & 31, k2 = e & 63;
      int s2 = grp * 32 + j;
      float a0 = sEx[j * 130 + k2], b0 = sEx[j * 130 + 64 + k2], a1v = sEx[(32 + j) * 130 + k2], b1v = sEx[(32 + j) * 130 + 64 + k2];
      float re = ka ? a0 - a1v : a0 + a1v, im = ka ? b0 - b1v : b0 + b1v;
      int idx = (ka * s2 * 32) & 8191;
      float cs = TW[2 * idx], sn = TW[2 * idx + 1];
      size_t o = ((size_t)((seq * 4 + g) * 64 + ka) * 128 + s2) * 64 + k2;
      XRE[o] = f2bf(re * cs + im * sn);
      XIM[o] = f2bf(im * cs - re * sn);
    }
  }
  __syncthreads();
}

DEV void f3_item(const P& p, int item, char* smem) {
  const int tid = ltid(), lane = tid & 63, w = tid >> 6, r31 = lane & 31, hh = lane >> 5;
  int seq, g, ka, N1, base; float scale;
  if (item < 512) { seq = item >> 8; g = (item >> 6) & 3; ka = item & 63; N1 = 64; base = seq * 8192; scale = 1.f / 724.0773439350247f; }
  else { int q = item - 512; seq = 2 + (q >> 3); g = (q >> 1) & 3; ka = q & 1; N1 = 2; base = 16384 + (seq - 2) * 256; scale = 1.f / 128.f; }
  u16* sB = (u16*)smem;
  const u16* XRE = (const u16*)(p.ws + OFF_R1 + R1_XRE) + (size_t)((seq * 4 + g) * 64 + ka) * 128 * 64;
  const u16* XIM = (const u16*)(p.ws + OFF_R1 + R1_XIM) + (size_t)((seq * 4 + g) * 64 + ka) * 128 * 64;
  {
    int s2 = tid & 127, cgh = tid >> 7;
    for (int i = 0; i < 4; ++i) {
      int cg_ = cgh * 4 + i;
      u32x4 ur = *(const u32x4*)(XRE + s2 * 64 + cg_ * 8);
      u32x4 ui = *(const u32x4*)(XIM + s2 * 64 + cg_ * 8);
#pragma unroll
      for (int e = 0; e < 4; ++e) {
        sB[(cg_ * 8 + 2 * e) * 264 + s2] = (u16)(ur[e] & 0xffff);
        sB[(cg_ * 8 + 2 * e + 1) * 264 + s2] = (u16)(ur[e] >> 16);
        sB[(cg_ * 8 + 2 * e) * 264 + 128 + s2] = (u16)(ui[e] & 0xffff);
        sB[(cg_ * 8 + 2 * e + 1) * 264 + 128 + s2] = (u16)(ui[e] >> 16);
      }
    }
  }
  __syncthreads();
  f32x16 acc[1][2];
#pragma unroll
  for (int ni = 0; ni < 2; ++ni)
#pragma unroll
    for (int i = 0; i < 16; ++i) acc[0][ni][i] = 0.f;
  mma_lds<1, 2>((const u16*)(p.ws + OFF_TCS), 256, w * 32, sB, 264, 0, 256, acc, lane);
  u16* BR = (u16*)(p.ws + OFF_R2 + R2_BR);
#pragma unroll
  for (int ni = 0; ni < 2; ++ni)
#pragma unroll
    for (int i = 0; i < 16; ++i) {
      int kb = w * 32 + rowmap(i, hh), k2 = ni * 32 + r31;
      int row = base + ka + N1 * kb;
      BR[(size_t)row * 1024 + 512 + g * 64 + k2] = f2bf(acc[0][ni][i] * scale);
    }
  __syncthreads();
}

DEV void sgu_item(const P& p, int l, int item, char* smem) {
  const int tid = ltid(), lane = tid & 63, w = tid >> 6, r31 = lane & 31, hh = lane >> 5;
  const int tl = item >> 2, g = item & 3, r0 = tl * 128;
  const u16* PS = (const u16*)(p.ws + OFF_R1 + R1_PS);
  u16* sA = (u16*)smem;
  u16* sB = (u16*)(smem + 34816);
  float* sSt = (float*)(smem + 34816 + 17408);
  {
    int tok = tid >> 1, half = tid & 1;
    const u16* src = PS + (size_t)(r0 + tok) * PSW + 2304 + half * 128;
    float s = 0, sq = 0;
    for (int j = 0; j < 16; ++j) {
      u32x4 u = *(const u32x4*)(src + j * 8);
#pragma unroll
      for (int e = 0; e < 4; ++e) { float a = geluf_(bflo(u[e])), b2 = geluf_(bfhi(u[e])); s += a + b2; sq += a * a + b2 * b2; }
    }
    s += __shfl_xor(s, 1); sq += __shfl_xor(sq, 1);
    float mean = s * (1.f / 256.f);
    float var = fmaxf(sq * (1.f / 256.f) - mean * mean, 0.f);
    if (half == 0) { sSt[tok * 2] = mean; sSt[tok * 2 + 1] = rsqrtf(var + EPSV); }
  }
  __syncthreads();
  {
    int q = tid & 127, cgh = tid >> 7;
    float mean = sSt[q * 2], rstd = sSt[q * 2 + 1];
    for (int i = 0; i < 4; ++i) {
      int cg_ = cgh * 4 + i;
      u32x4 u = *(const u32x4*)(PS + (size_t)(r0 + q) * PSW + 2304 + g * 64 + cg_ * 8);
#pragma unroll
      for (int e = 0; e < 4; ++e) {
        int d0 = cg_ * 8 + 2 * e;
        float a = (geluf_(bflo(u[e])) - mean) * rstd * p.sg_norm[l * 256 + g * 64 + d0];
        float b2 = (geluf_(bfhi(u[e])) - mean) * rstd * p.sg_norm[l * 256 + g * 64 + d0 + 1];
        sB[d0 * 136 + q] = f2bf(a);
        sB[(d0 + 1) * 136 + q] = f2bf(b2);
      }
    }
    const float* W = p.sg_w + (size_t)(l * 4 + g) * 128 * 128;
    for (int i = 0; i < 8; ++i) {
      int pr = (tid >> 4) + 16 * i, cc = (tid & 15) * 8;
      f32x4 a = *(const f32x4*)(W + pr * 128 + cc), b2 = *(const f32x4*)(W + pr * 128 + cc + 4);
      *(u32x4*)(sA + pr * 136 + cc) = u32x4{pack2(a[0], a[1]), pack2(a[2], a[3]), pack2(b2[0], b2[1]), pack2(b2[2], b2[3])};
    }
  }
  __syncthreads();
  f32x16 acc[1][2];
#pragma unroll
  for (int ni = 0; ni < 2; ++ni)
#pragma unroll
    for (int i = 0; i < 16; ++i) acc[0][ni][i] = 0.f;
  mma_lds<1, 2>(sA, 136, w * 32, sB, 136, 0, 128, acc, lane);
  u16* BR = (u16*)(p.ws + OFF_R2 + R2_BR);
#pragma unroll
  for (int ni = 0; ni < 2; ++ni)
#pragma unroll
    for (int i = 0; i < 16; ++i) {
      int pp = w * 32 + rowmap(i, hh), d = ni * 32 + r31;
      float u = geluf_(bf2f(PS[(size_t)(r0 + pp) * PSW + 2048 + g * 64 + d]));
      float val = (acc[0][ni][i] + p.sg_b[(l * 4 + g) * 128 + pp]) * u;
      BR[(size_t)(r0 + pp) * 1024 + 768 + g * 64 + d] = f2bf(val);
    }
  __syncthreads();
}

__global__ void __launch_bounds__(256, 2) mega(P p) {
  extern __shared__ __attribute__((aligned(16))) char smem[];
  cg::grid_group grid = cg::this_grid();
  __shared__ unsigned xb_st[4];
  if (threadIdx.x < 4) xb_st[threadIdx.x] = 0u;
  __syncthreads();
  XcdBarrier xb = xcd_barrier_post((unsigned*)(p.ws + OFF_BAR), (volatile LAS unsigned*)xb_st);
  int phase = 0;
  const int bid = blockIdx.x, nb = gridDim.x;
#ifndef DUP
#define DUP 0
#endif
#define PH_BEGIN if (phase >= p.ph0 && phase < p.ph1) {
#define REP_BEGIN(kind) for (int rep_ = 0; rep_ < 1 + ((DUP >> (kind)) & 1); ++rep_) { if (rep_) xcd_barrier(xb);
#define REP_END }
#define PH_END } ++phase; if (p.coop) { if (p.coop == 2 && phase == 1) grid.sync(); else xcd_barrier(xb); }

  PH_BEGIN
  for (int it = bid; it < 192 + 21 + 4320; it += nb) {
    if (it < 192) mod_item(p, it, smem);
    else if (it < 213) tab_item(p, it - 192);
    else conv_item(p, 0, it - 213, smem);
  }
  PH_END
  PH_BEGIN
  rowpass_run(p, 0, 0, bid, nb);
  PH_END

  for (int l = 0; l < 4; ++l) {
    const float lam_init = 0.8f - 0.6f * expf(-0.3f * (float)l);
    const bool last = l == 3;
    PH_BEGIN
REP_BEGIN(0)
    banded(bid, nb, 132, 21, 7, [&](int mt, int nt) { gemm1_item(p, mt, nt, smem); });
REP_END
    PH_END
    PH_BEGIN
REP_BEGIN(1)
    for (int it = bid; it < 132 + 528 + 528 + 1024 + 32; it += nb) {
      if (it < 132) attnprep_item(p, it, smem);
      else if (it < 660) mla_item(p, l, it - 132, smem);
      else if (it < 1188) { if (!(last && it - 660 >= 512)) sgu_item(p, l, it - 660, smem); }
      else if (it < 2212) f2_item(p, it - 1188, smem);
      else if (!last) f2ctx_item(p, it - 2212, smem);
    }
REP_END
    PH_END
    PH_BEGIN
    {
      float s01 = 0.f, s23 = 0.f;
      for (int i = 0; i < 32; ++i) {
        s01 += p.da_lam[l * 128 + i] * p.da_lam[l * 128 + 32 + i];
        s23 += p.da_lam[l * 128 + 64 + i] * p.da_lam[l * 128 + 96 + i];
      }
      const float lam = expf(s01) - expf(s23) + lam_init;
      {
        const int x = bid & 7, j = bid >> 3, per = nb >> 3;
        for (int r_ = 0; r_ < 1 + ((DUP >> 2) & 1); ++r_) {
          for (int q = j; q < 128; q += per) attn_item(p, l, x * 128 + q, smem, lam, lam_init);
          if (!last) for (int q = j; q < 4; q += per) attn_item(p, l, 1024 + x * 4 + q, smem, lam, lam_init);
        }
      }
      if (!last) for (int it = bid - (nb - 16); it >= 0 && it < 16; it += nb) mlc_item(p, l, 512 + it, smem);
      for (int it = bid; it < 64 + 528; it += nb) {
        if (it < 64) { for (int r_ = 0; r_ < 1 + ((DUP >> 9) & 1); ++r_) scan_item(p, it); }
        else if (!(last && it - 64 >= 512)) { for (int r_ = 0; r_ < 1 + ((DUP >> 10) & 1); ++r_) f3_item(p, it - 64, smem); }
      }
    }
    PH_END
    PH_BEGIN
REP_BEGIN(3)
    for (int it = bid; it < 512; it += nb) mlc_item(p, l, it, smem);
REP_END
    PH_END
    PH_BEGIN
REP_BEGIN(4)
    banded(bid, nb, 128, 8, 8, [&](int mt, int nt) { merge_item<2>(p, mt, nt, smem); });
    if (!last) for (int it = bid; it < 64; it += nb) merge_item<1>(p, 128 + (it >> 4), it & 15, smem);
REP_END
    PH_END
    PH_BEGIN
REP_BEGIN(5)
    banded(bid, nb, 128, 8, 8, [&](int mt, int nt) { gemm_f32_big((const u16*)(p.ws + OFF_R2 + R2_Z), 1024, (const u16*)(p.ws + OFF_WT + WT_OUT), (float*)(p.ws + OFF_R1), mt, nt, smem); });
    if (!last) for (int it = bid; it < 64; it += nb)
      gemm_f32_small((const u16*)(p.ws + OFF_R2 + R2_Z), 1024, (const u16*)(p.ws + OFF_WT + WT_OUT), (float*)(p.ws + OFF_R1), it, smem);
REP_END
    PH_END
    PH_BEGIN
    rowpass_run(p, l, 1, bid, nb);
    PH_END
    PH_BEGIN
REP_BEGIN(6)
    banded(bid, nb, 67, 44, 11, [&](int mt, int nt) { upact_item(p, l, mt, nt, smem); });
REP_END
    PH_END
    PH_BEGIN
REP_BEGIN(8)
    banded(bid, nb, 128, 8, 8, [&](int mt, int nt) { gemm_f32_big((const u16*)(p.ws + OFF_R2), 2816, (const u16*)(p.ws + OFF_WT + WT_DOWN), (float*)(p.ws + OFF_R1), mt, nt, smem); });
    if (!last) for (int it = bid; it < 64; it += nb)
      gemm_f32_small((const u16*)(p.ws + OFF_R2), 2816, (const u16*)(p.ws + OFF_WT + WT_DOWN), (float*)(p.ws + OFF_R1), it, smem);
REP_END
    PH_END
    PH_BEGIN
    {
      const int nconv = l < 3 ? 4320 : 0;
      rowpass_run(p, l, 2, bid, nb);
      for (int it = bid; it < nconv; it += nb) conv_item(p, l + 1, it, smem);
    }
    PH_END
  }
}

extern "C" void kernel_launch(void* const* d_in, const int* in_sizes, int n_in, void* d_out, int out_size, void* d_ws, size_t ws_size,
                              hipStream_t stream) {
  static int grid_blocks = 0;
  if (!grid_blocks) {
    if (hipFuncSetAttribute((const void*)mega, hipFuncAttributeMaxDynamicSharedMemorySize, LDS_BYTES) != hipSuccess) {
      fprintf(stderr, "hipFuncSetAttribute failed\n");
    }
    int dev = 0, cus = 0, per_cu = 0;
    hipGetDevice(&dev);
    hipDeviceGetAttribute(&cus, hipDeviceAttributeMultiprocessorCount, dev);
    hipOccupancyMaxActiveBlocksPerMultiprocessor(&per_cu, (const void*)mega, 256, LDS_BYTES);
    if (per_cu > 2) per_cu = 2;
    if (per_cu < 1) per_cu = 1;
    grid_blocks = cus * per_cu;
  }
  P p{};
  const float** f = (const float**)&p;
  for (int i = 0; i < 23; ++i) f[i] = (const float*)d_in[i];
  p.out = (float*)d_out;
  p.ws = (char*)d_ws;
  p.ph0 = 0; p.ph1 = 1 << 30; p.coop = 1; p.pad = 0;
  hipMemsetAsync((char*)d_ws + OFF_BAR, 0, 16384, stream);
  void* args[] = {&p};
  hipError_t e = hipLaunchCooperativeKernel((const void*)mega, dim3(grid_blocks), dim3(256), args, LDS_BYTES, stream);
  if (e != hipSuccess) fprintf(stderr, "cooperative launch failed: %s (grid %d)\n", hipGetErrorString(e), grid_blocks);
}
```
